# Optimizing an MI355X kernel written in HIP

```python
import jax, jax.numpy as jnp
from jax import lax
import numpy as np

D_MODEL = 1024
BATCH = 4
SEQ = 8192
DEPTH = 1

RWKV_HEAD_DIM = 64
RWKV_WIDTH = 1024
RWKV_HEADS = RWKV_WIDTH // RWKV_HEAD_DIM
DECAY_LORA = 64
ICLR_LORA = 64
GATE_LORA = 160
GN_EPS = 64e-5
GMLP_WIDTH = 1024
GMLP_GROUPS = 8
GMLP_GROUP_DIM = GMLP_WIDTH // GMLP_GROUPS
CHUNK = 128
N_EXPERTS = 256
TOP_K = 8
N_EXPERT_GROUPS = 8
TOPK_GROUPS = 4
EXPERT_FF = 256
SHARED_FF = 256
ROUTED_SCALE = 2.5
ROW_BLOCK = 128
LN_EPS = 1e-5
ALPHA = (2 * DEPTH) ** 0.25
BETA = (8 * DEPTH) ** -0.25
C_RWKV = 3 * RWKV_WIDTH + DECAY_LORA + ICLR_LORA + GATE_LORA
C_GMLP = 2 * GMLP_WIDTH
C_GATES = 2 * D_MODEL
C_IN = C_RWKV + C_GMLP + C_GATES

kernel_name = 'rwkv7_gmlp_gated_hybrid_moe_deepnorm'


def _layer_norm(x, w, b):
    xf = x.astype(jnp.float32)
    mu = jnp.mean(xf, axis=-1, keepdims=True)
    var = jnp.mean(jnp.square(xf - mu), axis=-1, keepdims=True)
    return ((xf - mu) * lax.rsqrt(var + LN_EPS) * w + b).astype(x.dtype)


def _token_shift(p):
    return jnp.pad(p[:, :-1], ((0, 0), (1, 0), (0, 0)))


def _rwkv7_scan(r, w, k, v, a, b):
    def step(state, inp):
        r_t, w_t, k_t, v_t, a_t, b_t = inp
        sa = jnp.einsum('bhij,bhj->bhi', state, a_t)
        state = (state * w_t[:, :, None, :] + sa[..., None] * b_t[:, :, None, :]
                 + v_t[..., None] * k_t[:, :, None, :])
        return state, jnp.einsum('bhij,bhj->bhi', state, r_t)
    bsz, _, nh, nd = r.shape
    xs = tuple(jnp.swapaxes(t, 0, 1) for t in (r, w, k, v, a, b))
    _, ys = lax.scan(step, jnp.zeros((bsz, nh, nd, nd), jnp.float32), xs)
    return jnp.swapaxes(ys, 0, 1)


def _rwkv7_time_mix(p, mu, w0, decay_lora, a0, iclr_lora, gate_lora, k_k, k_a, r_k, gn_w, gn_b):
    bsz, seq, _ = p.shape
    pf = p.astype(jnp.float32)
    pm = pf + mu * (_token_shift(pf) - pf)
    o = np.cumsum([0, RWKV_WIDTH, RWKV_WIDTH, RWKV_WIDTH, DECAY_LORA, ICLR_LORA, GATE_LORA])
    r, k, v, xw, xa, xg = (pm[..., o[i]:o[i + 1]] for i in range(6))
    w = -jax.nn.softplus(-(w0 + jnp.tanh(xw) @ decay_lora)) - 0.5
    decay = jnp.exp(-jnp.exp(w))
    a = jax.nn.sigmoid(a0 + xa @ iclr_lora)
    g = jax.nn.sigmoid(xg) @ gate_lora
    heads = lambda t: t.reshape(bsz, seq, RWKV_HEADS, RWKV_HEAD_DIM)
    kk = heads(k * k_k)
    kk = kk / jnp.maximum(jnp.linalg.norm(kk, axis=-1, keepdims=True), 1e-12)
    k = k * (1.0 + (a - 1.0) * k_a)
    r_h, k_h, v_h, a_h = heads(r), heads(k), heads(v), heads(a)
    y = _rwkv7_scan(r_h, heads(decay), k_h, v_h, -kk, kk * a_h)
    mean = jnp.mean(y, axis=-1, keepdims=True)
    var = jnp.mean(jnp.square(y - mean), axis=-1, keepdims=True)
    y = ((y - mean) * lax.rsqrt(var + GN_EPS)).reshape(bsz, seq, RWKV_WIDTH) * gn_w + gn_b
    bonus = (jnp.sum(r_h * k_h * r_k, axis=-1, keepdims=True) * v_h).reshape(bsz, seq, RWKV_WIDTH)
    return ((y + bonus) * g).astype(p.dtype)


def _gmlp_chunk_mix(p, ln_w, ln_b, spatial_w, spatial_b):
    bsz, seq, _ = p.shape
    z = jax.nn.gelu(p, approximate=False)
    u, v = jnp.split(z, 2, axis=-1)
    v = _layer_norm(v, ln_w, ln_b)
    v = v.reshape(bsz, seq // CHUNK, CHUNK, GMLP_GROUPS, GMLP_GROUP_DIM)
    causal = jnp.tril(jnp.ones((CHUNK, CHUNK), dtype=bool))
    w_s = jnp.where(causal, spatial_w, 0.0).astype(p.dtype)
    sv = jnp.einsum('gts,bcsgd->bctgd', w_s, v) + spatial_b.T[:, :, None].astype(p.dtype)
    return u * sv.reshape(bsz, seq, GMLP_WIDTH)


def _moe_ffn(h, w_router, router_bias, w_exp_gate_up, w_exp_down, w_sh_gate_up, w_sh_down):
    n_tok, d = h.shape
    n_assign = n_tok * TOP_K
    scores = jax.nn.sigmoid(h.astype(jnp.float32) @ w_router.astype(jnp.float32))
    choice = scores + router_bias.astype(jnp.float32)
    grp_top2 = lax.top_k(choice.reshape(n_tok, N_EXPERT_GROUPS, N_EXPERTS // N_EXPERT_GROUPS), 2)[0]
    _, top_grp = lax.top_k(jnp.sum(grp_top2, axis=-1), TOPK_GROUPS)
    grp_mask = jnp.sum(jax.nn.one_hot(top_grp, N_EXPERT_GROUPS), axis=1) > 0
    exp_mask = jnp.repeat(grp_mask, N_EXPERTS // N_EXPERT_GROUPS, axis=1)
    _, top_e = lax.top_k(jnp.where(exp_mask, choice, -jnp.inf), TOP_K)
    gate = jnp.take_along_axis(scores, top_e, axis=1)
    gate = gate / jnp.sum(gate, axis=-1, keepdims=True) * ROUTED_SCALE
    eid = top_e.reshape(-1)
    order = jnp.argsort(eid)
    e_sorted = eid[order]
    counts = jnp.bincount(eid, length=N_EXPERTS)
    padded = (counts + ROW_BLOCK - 1) // ROW_BLOCK * ROW_BLOCK
    pad_end = jnp.cumsum(padded)
    start = jnp.cumsum(counts) - counts
    dest = (pad_end - padded)[e_sorted] + jnp.arange(n_assign) - start[e_sorted]
    n_blocks = (n_assign + N_EXPERTS * (ROW_BLOCK - 1) + ROW_BLOCK - 1) // ROW_BLOCK
    n_rows = n_blocks * ROW_BLOCK
    row_tok = jnp.zeros((n_rows,), jnp.int32).at[dest].set((order // TOP_K).astype(jnp.int32))
    row_gate = jnp.zeros((n_rows,), jnp.float32).at[dest].set(gate.reshape(-1)[order])
    block_expert = jnp.minimum(
        jnp.searchsorted(pad_end, jnp.arange(n_blocks) * ROW_BLOCK, side='right'), N_EXPERTS - 1)

    def expert_block(args):
        tok, g_row, e = args
        gu = h[tok] @ w_exp_gate_up[e]
        g_, u_ = jnp.split(gu, 2, axis=-1)
        return ((jax.nn.silu(g_) * u_) @ w_exp_down[e]) * g_row[:, None].astype(h.dtype)

    rows = lax.map(expert_block, (row_tok.reshape(n_blocks, ROW_BLOCK),
                                  row_gate.reshape(n_blocks, ROW_BLOCK), block_expert))
    routed = jax.ops.segment_sum(rows.reshape(n_rows, d), row_tok, num_segments=n_tok)
    sg, su = jnp.split(h @ w_sh_gate_up, 2, axis=-1)
    return routed + (jax.nn.silu(sg) * su) @ w_sh_down


def setup_inputs(seed: int = 0) -> dict:
    key = jax.random.key(seed)
    ks = jax.random.split(key, 32)
    nrm = lambda k, shape, scale: jax.random.normal(k, shape, jnp.float32) * scale
    L = DEPTH
    return {
        'x': nrm(ks[0], (BATCH, SEQ, D_MODEL), 1.0),
        'w_in': nrm(ks[1], (L, D_MODEL, C_IN), D_MODEL ** -0.5),
        'shift_mu': jax.random.uniform(ks[2], (L, C_RWKV), jnp.float32),
        'rwkv_w0': jax.random.uniform(ks[3], (L, RWKV_WIDTH), jnp.float32, -6.0, 1.0),
        'rwkv_decay_lora': nrm(ks[4], (L, DECAY_LORA, RWKV_WIDTH), 0.1 * DECAY_LORA ** -0.5),
        'rwkv_a0': nrm(ks[5], (L, RWKV_WIDTH), 0.5),
        'rwkv_iclr_lora': nrm(ks[6], (L, ICLR_LORA, RWKV_WIDTH), ICLR_LORA ** -0.5),
        'rwkv_gate_lora': nrm(ks[7], (L, GATE_LORA, RWKV_WIDTH), GATE_LORA ** -0.5),
        'rwkv_k_k': 0.85 + nrm(ks[8], (L, RWKV_WIDTH), 0.05),
        'rwkv_k_a': 1.0 + nrm(ks[9], (L, RWKV_WIDTH), 0.05),
        'rwkv_r_k': nrm(ks[10], (L, RWKV_HEADS, RWKV_HEAD_DIM), 0.1),
        'rwkv_gn_w': 1.0 + nrm(ks[11], (L, RWKV_WIDTH), 0.05),
        'rwkv_gn_b': nrm(ks[12], (L, RWKV_WIDTH), 0.02),
        'gmlp_ln_w': 1.0 + nrm(ks[13], (L, GMLP_WIDTH), 0.05),
        'gmlp_ln_b': nrm(ks[14], (L, GMLP_WIDTH), 0.02),
        'gmlp_spatial_w': nrm(ks[15], (L, GMLP_GROUPS, CHUNK, CHUNK), 0.5 * CHUNK ** -0.5),
        'gmlp_spatial_b': 1.0 + nrm(ks[16], (L, GMLP_GROUPS, CHUNK), 0.1),
        'w_o_rwkv': nrm(ks[17], (L, RWKV_WIDTH, D_MODEL), RWKV_WIDTH ** -0.5),
        'w_o_gmlp': nrm(ks[18], (L, GMLP_WIDTH, D_MODEL), GMLP_WIDTH ** -0.5),
        'w_out': nrm(ks[19], (L, D_MODEL, D_MODEL), BETA * D_MODEL ** -0.5),
        'ln1_w': 1.0 + nrm(ks[20], (L, D_MODEL), 0.05),
        'ln1_b': nrm(ks[21], (L, D_MODEL), 0.02),
        'w_router': nrm(ks[22], (L, D_MODEL, N_EXPERTS), D_MODEL ** -0.5),
        'router_bias': nrm(ks[23], (L, N_EXPERTS), 0.01),
        'w_exp_gate_up': nrm(ks[24], (L, N_EXPERTS, D_MODEL, 2 * EXPERT_FF), D_MODEL ** -0.5),
        'w_exp_down': nrm(ks[25], (L, N_EXPERTS, EXPERT_FF, D_MODEL), BETA * EXPERT_FF ** -0.5),
        'w_sh_gate_up': nrm(ks[26], (L, D_MODEL, 2 * SHARED_FF), D_MODEL ** -0.5),
        'w_sh_down': nrm(ks[27], (L, SHARED_FF, D_MODEL), BETA * SHARED_FF ** -0.5),
        'ln2_w': 1.0 + nrm(ks[28], (L, D_MODEL), 0.05),
        'ln2_b': nrm(ks[29], (L, D_MODEL), 0.02),
    }


def reference(x, w_in, shift_mu, rwkv_w0, rwkv_decay_lora, rwkv_a0, rwkv_iclr_lora, rwkv_gate_lora,
              rwkv_k_k, rwkv_k_a, rwkv_r_k, rwkv_gn_w, rwkv_gn_b, gmlp_ln_w, gmlp_ln_b,
              gmlp_spatial_w, gmlp_spatial_b, w_o_rwkv, w_o_gmlp, w_out, ln1_w, ln1_b,
              w_router, router_bias, w_exp_gate_up, w_exp_down, w_sh_gate_up, w_sh_down,
              ln2_w, ln2_b):
    bsz, seq, d = x.shape
    h = x
    for l in range(DEPTH):
        p = h @ w_in[l]
        y_a = _rwkv7_time_mix(p[..., :C_RWKV], shift_mu[l], rwkv_w0[l], rwkv_decay_lora[l], rwkv_a0[l],
                              rwkv_iclr_lora[l], rwkv_gate_lora[l], rwkv_k_k[l], rwkv_k_a[l],
                              rwkv_r_k[l], rwkv_gn_w[l], rwkv_gn_b[l]) @ w_o_rwkv[l]
        y_b = _gmlp_chunk_mix(p[..., C_RWKV:C_RWKV + C_GMLP], gmlp_ln_w[l], gmlp_ln_b[l],
                              gmlp_spatial_w[l], gmlp_spatial_b[l]) @ w_o_gmlp[l]
        gate_a, gate_b = jnp.split(jax.nn.sigmoid(p[..., C_RWKV + C_GMLP:]), 2, axis=-1)
        mix = (gate_a * y_a + gate_b * y_b) @ w_out[l]
        h = _layer_norm(ALPHA * h + mix, ln1_w[l], ln1_b[l])
        f = _moe_ffn(h.reshape(bsz * seq, d), w_router[l], router_bias[l], w_exp_gate_up[l],
                     w_exp_down[l], w_sh_gate_up[l], w_sh_down[l]).reshape(bsz, seq, d)
        h = _layer_norm(ALPHA * h + f, ln2_w[l], ln2_b[l])
    return h
```

```cpp
#include <hip/hip_runtime.h>
#include <cstdio>
#include <cstdint>

#ifndef MK_SPLIT
#define MK_SPLIT 1
#endif

#define LAS __attribute__((address_space(3)))
#define GAS __attribute__((address_space(1)))
typedef unsigned short bf16_t;
typedef short bf16x8 __attribute__((ext_vector_type(8)));
typedef float f32x4 __attribute__((ext_vector_type(4)));
typedef float f32x2 __attribute__((ext_vector_type(2)));
typedef unsigned u32x4 __attribute__((ext_vector_type(4)));
typedef unsigned u32x2 __attribute__((ext_vector_type(2)));

constexpr int T = 32768, D = 1024, SEQ = 8192, NH = 16, HD = 64;
constexpr int C_IN = 7456, NP = 7680;
constexpr int PC_R = 0, PC_K = 1024, PC_V = 2048, PC_L = 3072, PC_U = 3584, PC_GV = 4608, PC_GA = 5632, PC_GB = 6656;
constexpr int NE = 256, TOPK = 8;
constexpr int LK = 384;
constexpr int RMAX = 360448;
constexpr int HRK = 3072;
constexpr float LN_EPS = 1e-5f, GN_EPS = 64e-5f;
constexpr float ALPHA = 1.189207115002721f;
constexpr float ROUTED_SCALE = 2.5f;

constexpr size_t MiB = 1u << 20;
constexpr size_t WS_CTL = 0, CTL_ZERO_BYTES = 1 * MiB;
constexpr size_t WS_WT_IN = 2 * MiB;
constexpr size_t WS_WT_LORA = 17 * MiB;
constexpr size_t WS_WT_OA = 20 * MiB, WS_WT_OB = 22 * MiB, WS_WT_OUT = 24 * MiB;
constexpr size_t WS_WT_R = 26 * MiB;
constexpr size_t WS_WT_GU = 28 * MiB;
constexpr size_t WS_WT_DN = 285 * MiB;
constexpr size_t WS_H1 = 414 * MiB;
constexpr size_t WS_HR = 542 * MiB;
constexpr size_t WS_LOGITS = 734 * MiB;
constexpr size_t WS_TOPE = 766 * MiB;
constexpr size_t WS_TOPG = 767 * MiB;
constexpr size_t WS_SLOT = 768 * MiB;
constexpr size_t WS_CNT = 769 * MiB;
constexpr size_t WS_ROWTOK = 770 * MiB;
constexpr size_t WS_ROWGATE = 772 * MiB;
constexpr size_t WS_XB = 774 * MiB;
constexpr size_t WS_P = 838 * MiB;
constexpr size_t WS_LORAIN = 1318 * MiB;
constexpr size_t WS_LOGW = 1342 * MiB;
constexpr size_t WS_AA = 1470 * MiB;
constexpr size_t WS_GG = 1534 * MiB;
constexpr size_t WS_YA = 1598 * MiB;
constexpr size_t WS_YB = 1662 * MiB;
constexpr size_t WS_T1 = 1726 * MiB;
constexpr size_t WS_MIXIN = 1854 * MiB;
constexpr size_t WS_H1PRE = 1918 * MiB;
constexpr size_t WS_END = 2046 * MiB;
constexpr size_t WS_ACT = 774 * MiB;
constexpr size_t WS_YR = 950 * MiB;
static_assert(WS_ACT + (size_t)RMAX * 256 * 2 <= WS_YR && WS_YR + (size_t)RMAX * 1024 * 2 <= WS_END, "moe overlay");
static_assert(WS_WT_GU + (size_t)257 * 512 * 1024 * 2 <= WS_WT_DN && WS_WT_DN + (size_t)257 * 1024 * 256 * 2 <= WS_H1, "weights");
static_assert(WS_ROWGATE + (size_t)RMAX * 4 <= WS_XB && WS_ROWTOK + (size_t)RMAX * 4 <= WS_ROWGATE, "routing");
constexpr int CW_NBLK = 16;
constexpr int CW_SHBASE = 17;
constexpr int CW_BLKE = 1024;
constexpr int CW_BAR = 8192;
static_assert((CW_BAR + 3456) * 4 <= (int)CTL_ZERO_BYTES, "ctl");

constexpr int RING_BYTES = 131072;
constexpr int MISC_OFF = RING_BYTES + 320;
constexpr int LDS_BYTES = 147456;

__device__ __forceinline__ float bf2f(unsigned b) { return __uint_as_float(b << 16); }
__device__ __forceinline__ unsigned cvt_pk_bf16(float lo, float hi) { unsigned r; asm volatile("v_cvt_pk_bf16_f32 %0, %1, %2" : "=v"(r) : "v"(lo), "v"(hi)); return r; }
__device__ __forceinline__ unsigned f2bf(float f) { return cvt_pk_bf16(f, 0.f) & 0xffffu; }
__device__ __forceinline__ float wave_sum(float v) {
#pragma unroll
    for (int o = 1; o < 64; o <<= 1) v += __shfl_xor(v, o);
    return v;
}
__device__ __forceinline__ float sigmoidf_(float x) { return 1.0f / (1.0f + __expf(-x)); }
__device__ __forceinline__ void unpack8(const u32x4 w, float (&f)[8]) {
    f[0] = bf2f(w.x & 0xffffu); f[1] = bf2f(w.x >> 16); f[2] = bf2f(w.y & 0xffffu); f[3] = bf2f(w.y >> 16);
    f[4] = bf2f(w.z & 0xffffu); f[5] = bf2f(w.z >> 16); f[6] = bf2f(w.w & 0xffffu); f[7] = bf2f(w.w >> 16);
}
__device__ __forceinline__ unsigned ld_u32_sc1(const unsigned* p) { return __hip_atomic_load(p, __ATOMIC_RELAXED, __HIP_MEMORY_SCOPE_AGENT); }

#define XB_TMO      128
#define XB_XCNT(j)  (256  + 64 * (j))
#define XB_XSUB(j)  (1280 + 64 * (j))
#define XB_XGEN(j)  (2304 + 64 * (j))
#define XB_TOP      3328
#define XB_TOPGEN   3392
#define XCD_BAR_WORDS 3456
#define XB_SPIN_CAP (1u << 18)
__device__ __forceinline__ unsigned xb_ld(unsigned* p)              { return __hip_atomic_load(p, __ATOMIC_RELAXED, __HIP_MEMORY_SCOPE_AGENT); }
__device__ __forceinline__ unsigned xb_add(unsigned* p, unsigned v) { return __hip_atomic_fetch_add(p, v, __ATOMIC_RELAXED, __HIP_MEMORY_SCOPE_AGENT); }
__device__ __forceinline__ unsigned xb_xcc_id() { return (unsigned)__builtin_amdgcn_s_getreg((3 << 11) | 20) & 0xFu; }
#define XB_SPIN(cond, bar) do { unsigned _sp = 0; while (cond) { __builtin_amdgcn_s_sleep(1); \
    if ((++_sp & 255u) == 0u) { if (xb_ld(&(bar)[XB_TMO])) break; if (_sp > XB_SPIN_CAP) { atomicAdd(&(bar)[XB_TMO], 1u); break; } } } } while (0)
struct XcdBarrier { unsigned* bar; unsigned x; volatile LAS unsigned* st; };
__device__ __forceinline__ XcdBarrier xcd_barrier_post(unsigned* bar, volatile LAS unsigned* st) {
    XcdBarrier b; b.bar = bar; b.x = xb_xcc_id(); b.st = st;
    if (threadIdx.x == 0) (void)xb_add(&bar[XB_XCNT(b.x)], 1u);
    return b;
}
__device__ __forceinline__ void xcd_barrier_complete(unsigned* bar, unsigned x, unsigned& nloc, unsigned& nx) {
    const unsigned G = gridDim.x * gridDim.y * gridDim.z;
    unsigned sum, cnt, mine, sp = 0u;
    for (;;) {
        sum = 0u; cnt = 0u; mine = 0u;
#pragma unroll
        for (unsigned j = 0; j < 16; ++j) { const unsigned c = xb_ld(&bar[XB_XCNT(j)]); sum += c; cnt += (c > 0u) ? 1u : 0u; mine = (j == x) ? c : mine; }
        if (sum == G) break;
        __builtin_amdgcn_s_sleep(1);
        if ((++sp & 255u) == 0u) { if (xb_ld(&bar[XB_TMO])) break; if (sp > XB_SPIN_CAP) { atomicAdd(&bar[XB_TMO], 1u); break; } }
    }
    nloc = mine > 0u ? mine : 1u; nx = cnt > 0u ? cnt : 1u;
}
__device__ __forceinline__ void xcd_barrier(const XcdBarrier& b) {
    asm volatile("s_waitcnt vmcnt(0)" ::: "memory");
    __syncthreads();
    if (threadIdx.x == 0) {
        unsigned* bar = b.bar;
        __builtin_amdgcn_s_waitcnt(0);
        unsigned nloc = b.st[0], nx = b.st[1];
        if (nloc == 0u) { xcd_barrier_complete(bar, b.x, nloc, nx); b.st[0] = nloc; b.st[1] = nx; }
        const unsigned old = xb_add(&bar[XB_XSUB(b.x)], 1u);
        const unsigned gen = old / nloc;
        if (old + 1u == (gen + 1u) * nloc) {
            __builtin_amdgcn_fence(__ATOMIC_RELEASE, "agent");
            asm volatile("s_waitcnt vmcnt(0)" ::: "memory");
            const unsigned og = xb_add(&bar[XB_TOP], 1u);
            const unsigned tg = og / nx;
            if (og + 1u == (tg + 1u) * nx) xb_add(&bar[XB_TOPGEN], 1u);
            else XB_SPIN(xb_ld(&bar[XB_TOPGEN]) == tg, bar);
            __builtin_amdgcn_fence(__ATOMIC_ACQUIRE, "agent");
            xb_add(&bar[XB_XGEN(b.x)], 1u);
            asm volatile("s_waitcnt vmcnt(0)" ::: "memory");
        } else {
            XB_SPIN(xb_ld(&bar[XB_XGEN(b.x)]) == gen, bar);
            __builtin_amdgcn_fence(__ATOMIC_ACQUIRE, "agent");
            asm volatile("s_waitcnt vmcnt(0)" ::: "memory");
        }
    }
    __syncthreads();
}

namespace pg8 {
constexpr int BM = 256, BK = 64, HALF = 128, HTB = HALF * BK * 2, STAGE_BYTES = 8 * HTB, NXCD = 8, WGM = 8;
__host__ __device__ __forceinline__ int lds_byte(int r, int c) { const int st = (r >> 4) * 2 + (c >> 5), rr = r & 15, cc = c & 31, ob = rr * 64 + cc * 2; return st * 1024 + (ob ^ (((ob >> 9) & 1) << 5)); }
__host__ __device__ __forceinline__ void stage_rc(int b, int& R, int& C) { const int st = b / 1024, sb = b % 1024, swz = sb ^ (((sb >> 9) & 1) << 5); R = (st >> 1) * 16 + swz / 64; C = (st & 1) * 32 + (swz % 64) / 2; }
__host__ __device__ __forceinline__ int perm32(int rho) { const int n = rho >> 4, i = rho & 15; return 8 * (i >> 2) + 4 * n + (i & 3); }

struct Unit { int pm, pn, aux; };
struct Gemm { const bf16_t* A; const bf16_t* Bt; int K, lda, ldb; };

struct StaticOrder {
    static constexpr bool GATHER = false;
    int nM, nN, nwg, G, c;
    __device__ void init(int M, int N, int G_, int c_) { nM = M / BM; nN = N / BM; nwg = nM * nN; G = G_; c = c_; }
    __device__ bool next(int i, Unit& u) const {
        const long L = (long)i * G + c; if (L >= nwg) return false;
        int wgid = (int)L; { const int q = nwg / NXCD, r = nwg % NXCD, xcd = wgid % NXCD, off = wgid / NXCD; wgid = (xcd < r ? xcd * (q + 1) : r * (q + 1) + (xcd - r) * q) + off; }
        const int nig = WGM * nN, gid = wgid / nig, fm = gid * WGM, gsz = (nM - fm) < WGM ? (nM - fm) : WGM;
        u.pm = fm + ((wgid % nig) % gsz); u.pn = (wgid % nig) / gsz; u.aux = 0; return true;
    }
    __device__ __forceinline__ const char* a_base(const Gemm& g, const Unit& u) const { return (const char*)g.A + (size_t)u.pm * BM * g.lda * 2; }
    __device__ __forceinline__ const char* b_base(const Gemm& g, const Unit& u) const { return (const char*)g.Bt + (size_t)u.pn * BM * g.ldb * 2; }
    __device__ __forceinline__ unsigned a_rowoff(const Gemm&, const Unit&, int) const { return 0u; }
};
template <bool GATH> struct GroupedOrder {
    static constexpr bool GATHER = GATH;
    const unsigned* blk_e; const int* row_tok; int nblk, nN, G, c; size_t wstride;
    __device__ bool next(int i, Unit& u) const {
        const long L = (long)i * G + c; if (L >= (long)nblk * nN) return false;
        u.pm = (int)(L / nN); u.pn = (int)(L % nN);
        u.aux = (int)__builtin_amdgcn_readfirstlane(ld_u32_sc1(blk_e + u.pm)); return true;
    }
    __device__ __forceinline__ const char* a_base(const Gemm& g, const Unit& u) const { return (const char*)g.A + (size_t)u.pm * BM * g.lda * 2; }
    __device__ __forceinline__ const char* b_base(const Gemm& g, const Unit& u) const { return (const char*)g.Bt + (size_t)u.aux * wstride + (size_t)u.pn * BM * g.ldb * 2; }
    __device__ __forceinline__ unsigned a_rowoff(const Gemm& g, const Unit& u, int r) const { return (unsigned)row_tok[u.pm * BM + r] * (unsigned)(g.lda * 2); }
};

template <class Epi, class Sched>
__device__ __forceinline__ void gemm_phase(LAS unsigned char* lds, const Gemm g, const Sched& S, const Epi& E) {
    int tid_o = threadIdx.x; asm volatile("" : "+v"(tid_o));
    const int tid = tid_o, wid = __builtin_amdgcn_readfirstlane(tid >> 6), lane = tid & 63, wr = wid >> 2, wc = wid & 3, fr = lane & 15, fq = lane >> 4;
    const int K = g.K, nt = K / BK;
    unsigned voffA[2], voffB[2]; int RA[2]; unsigned CA2[2];
#pragma unroll
    for (int i = 0; i < 2; ++i) { int R, C; stage_rc(tid * 16 + i * 8192, R, C); const int Rb = (R & ~31) + perm32(R & 31);
        voffA[i] = (unsigned)(R * g.lda + C) * 2u; voffB[i] = (unsigned)(Rb * g.ldb + C) * 2u; RA[i] = R; CA2[i] = (unsigned)C * 2u; }
    const size_t kstep = (size_t)(BK * 2);
    const size_t hstepA = (size_t)HALF * g.lda * 2, hstepB = (size_t)HALF * g.ldb * 2;
    const unsigned ldsw = (unsigned)wid * 1024u;
    const int aoff = lds_byte(wr * 64 + fr, fq * 8), boff = lds_byte(wc * 32 + fr, fq * 8);
#define PG8_SA(b, h) (((b) * 2 + (h)) * HTB)
#define PG8_SB(b, h) ((4 + (b) * 2 + (h)) * HTB)
#define PG8_STAGE(bufoff, gbase, voff) do { _Pragma("unroll") for (int _i = 0; _i < 2; ++_i) \
        __builtin_amdgcn_global_load_lds((const unsigned*)((const char*)(gbase) + (voff)[_i]), (LAS unsigned*)(lds + (bufoff) + ldsw + _i * 8192), 16, 0, 0); } while (0)
#define PG8_LDA(dst, b, h) do { _Pragma("unroll") for (int m = 0; m < 4; ++m) _Pragma("unroll") for (int k = 0; k < 2; ++k) dst[m][k] = *(const LAS bf16x8*)(lds + PG8_SA(b, h) + aoff + m * 2048 + k * 1024); } while (0)
#define PG8_LDB(dst, b, h) do { _Pragma("unroll") for (int n = 0; n < 2; ++n) _Pragma("unroll") for (int k = 0; k < 2; ++k) dst[n][k] = *(const LAS bf16x8*)(lds + PG8_SB(b, h) + boff + n * 2048 + k * 1024); } while (0)
#define PG8_MMA(ai, bj, At, Bt) do { __builtin_amdgcn_s_setprio(1); _Pragma("unroll") for (int m = 0; m < 4; ++m) _Pragma("unroll") for (int n = 0; n < 2; ++n) _Pragma("unroll") for (int k = 0; k < 2; ++k) \
        acc[ai][bj][m][n] = __builtin_amdgcn_mfma_f32_16x16x32_bf16(Bt[n][k], At[m][k], acc[ai][bj][m][n], 0, 0, 0); __builtin_amdgcn_s_setprio(0); } while (0)
#define PG8_WAIT_V(n) asm volatile("s_waitcnt vmcnt(" #n ")" ::: "memory")
#define PG8_WAIT_L(n) asm volatile("s_waitcnt lgkmcnt(" #n ")" ::: "memory")
#define PG8_BAR __builtin_amdgcn_s_barrier()
#define PG8_SCHED __builtin_amdgcn_sched_barrier(0)
    Unit cur, nxt; int ui = 0;
    if (!S.next(0, cur)) return;
    f32x4 acc[2][2][4][2];
#pragma unroll
    for (int a = 0; a < 2; ++a)
#pragma unroll
        for (int b = 0; b < 2; ++b)
#pragma unroll
            for (int m = 0; m < 4; ++m)
#pragma unroll
                for (int n = 0; n < 2; ++n) acc[a][b][m][n] = (f32x4){0.f, 0.f, 0.f, 0.f};
    bf16x8 At[4][2], B0[2][2], B1[2][2];
    unsigned gcur[2][2], gnxt[2][2];
    const char* cA = Sched::GATHER ? (const char*)g.A : S.a_base(g, cur); const char* cB = S.b_base(g, cur);
    if constexpr (Sched::GATHER) {
#pragma unroll
        for (int h = 0; h < 2; ++h)
#pragma unroll
            for (int i = 0; i < 2; ++i) { gcur[h][i] = S.a_rowoff(g, cur, h * HALF + RA[i]) + CA2[i]; gnxt[h][i] = gcur[h][i]; }
    }
#define PG8_STAGE_A(bufoff, base, h, GO) do { if constexpr (Sched::GATHER) { PG8_STAGE(bufoff, base, GO[h]); } else { PG8_STAGE(bufoff, (base) + (h) * hstepA, voffA); } } while (0)
    PG8_STAGE(PG8_SB(0, 0), cB, voffB); PG8_STAGE_A(PG8_SA(0, 0), cA, 0, gcur); PG8_STAGE(PG8_SB(0, 1), cB + hstepB, voffB); PG8_STAGE_A(PG8_SA(0, 1), cA, 1, gcur);
    if (wr == 1) PG8_BAR;
    PG8_WAIT_V(4); PG8_BAR;
    PG8_STAGE(PG8_SB(1, 0), cB + kstep, voffB); PG8_STAGE_A(PG8_SA(1, 0), cA + kstep, 0, gcur); PG8_STAGE(PG8_SB(1, 1), cB + hstepB + kstep, voffB);
    PG8_WAIT_V(6); PG8_BAR;
    for (;;) {
        const bool has_next = S.next(ui + 1, nxt);
        const char* nA = has_next ? (Sched::GATHER ? (const char*)g.A : S.a_base(g, nxt)) : cA; const char* nB = has_next ? S.b_base(g, nxt) : cB;
        if constexpr (Sched::GATHER) {
            if (has_next) {
#pragma unroll
                for (int h = 0; h < 2; ++h)
#pragma unroll
                    for (int i = 0; i < 2; ++i) gnxt[h][i] = S.a_rowoff(g, nxt, h * HALF + RA[i]) + CA2[i];
            }
        }
#pragma unroll 1
        for (int t = 0; t < nt; t += 2) {
            const bool last = (t == nt - 2);
            const char* a1 = cA + (size_t)(t + 1) * kstep;
            const char* a2 = last ? nA : cA + (size_t)(t + 2) * kstep; const char* b2 = last ? nB : cB + (size_t)(t + 2) * kstep;
            const char* a3 = a2 + kstep; const char* b3 = b2 + kstep;
            unsigned g2[2][2];
            if constexpr (Sched::GATHER) {
#pragma unroll
                for (int h = 0; h < 2; ++h)
#pragma unroll
                    for (int i = 0; i < 2; ++i) g2[h][i] = last ? gnxt[h][i] : gcur[h][i];
            }
            PG8_LDB(B0, 0, 0); PG8_SCHED; PG8_LDA(At, 0, 0); PG8_STAGE_A(PG8_SA(1, 1), a1, 1, gcur);
            PG8_WAIT_L(8); PG8_BAR; PG8_WAIT_L(0); PG8_MMA(0, 0, At, B0); PG8_BAR; PG8_SCHED;
            PG8_LDB(B1, 0, 1); PG8_STAGE(PG8_SB(0, 0), b2, voffB);
            PG8_BAR; PG8_WAIT_L(0); PG8_MMA(0, 1, At, B1); PG8_BAR;
            PG8_LDA(At, 0, 1); PG8_STAGE_A(PG8_SA(0, 0), a2, 0, g2);
            PG8_BAR; PG8_WAIT_L(0); PG8_MMA(1, 0, At, B0); PG8_BAR; PG8_SCHED;
            PG8_STAGE(PG8_SB(0, 1), b2 + hstepB, voffB);
            PG8_WAIT_V(6); PG8_BAR; PG8_MMA(1, 1, At, B1); PG8_BAR;
            PG8_LDB(B0, 1, 0); PG8_SCHED; PG8_LDA(At, 1, 0); PG8_STAGE_A(PG8_SA(0, 1), a2, 1, g2);
            PG8_WAIT_L(8); PG8_BAR; PG8_WAIT_L(0); PG8_MMA(0, 0, At, B0); PG8_BAR; PG8_SCHED;
            PG8_LDB(B1, 1, 1); PG8_STAGE(PG8_SB(1, 0), b3, voffB);
            PG8_BAR; PG8_WAIT_L(0); PG8_MMA(0, 1, At, B1); PG8_BAR;
            PG8_LDA(At, 1, 1); PG8_STAGE_A(PG8_SA(1, 0), a3, 0, g2);
            PG8_BAR; PG8_WAIT_L(0); PG8_MMA(1, 0, At, B0); PG8_BAR; PG8_SCHED;
            PG8_STAGE(PG8_SB(1, 1), b3 + hstepB, voffB);
            PG8_WAIT_V(6); PG8_BAR; PG8_MMA(1, 1, At, B1); PG8_BAR;
        }
        E(acc, cur, wr, wc, fr, fq);
        if (!has_next) break;
#pragma unroll
        for (int a = 0; a < 2; ++a)
#pragma unroll
            for (int b = 0; b < 2; ++b)
#pragma unroll
                for (int m = 0; m < 4; ++m)
#pragma unroll
                    for (int n = 0; n < 2; ++n) acc[a][b][m][n] = (f32x4){0.f, 0.f, 0.f, 0.f};
        cur = nxt; cA = nA; cB = nB; ++ui;
        if constexpr (Sched::GATHER) {
#pragma unroll
            for (int h = 0; h < 2; ++h)
#pragma unroll
                for (int i = 0; i < 2; ++i) gcur[h][i] = gnxt[h][i];
        }
    }
    PG8_WAIT_V(0);
    if (wr == 0) PG8_BAR;
    PG8_BAR;
#undef PG8_SA
#undef PG8_SB
#undef PG8_STAGE
#undef PG8_STAGE_A
#undef PG8_LDA
#undef PG8_LDB
#undef PG8_MMA
#undef PG8_WAIT_V
#undef PG8_WAIT_L
#undef PG8_BAR
#undef PG8_SCHED
}

__device__ __forceinline__ f32x2 gelu_pk(f32x2 v) {
    const f32x2 av = __builtin_elementwise_abs(v), d = av * 0.2316418882f + 1.0f;
    f32x2 t; t.x = __builtin_amdgcn_rcpf(d.x); t.y = __builtin_amdgcn_rcpf(d.y);
    f32x2 q = t * 0.5307027145f + (-0.7265760135f); q = q * t + 0.7107068705f; q = q * t + (-0.142248368f); q = q * t + 0.127414796f; q = q * t;
    const f32x2 s = (v * v) * (-0.72134752044f);
    f32x2 e; e.x = __builtin_amdgcn_exp2f(s.x); e.y = __builtin_amdgcn_exp2f(s.y);
    const f32x2 m = v * (q * e), r = v - m;
    f32x2 o; o.x = v.x < 0.f ? m.x : r.x; o.y = v.y < 0.f ? m.y : r.y; return o;
}
}
using pg8::Unit;

__device__ __forceinline__ u32x4 pack8(const f32x4 v0, const f32x4 v1) { u32x4 w; w.x = cvt_pk_bf16(v0[0], v0[1]); w.y = cvt_pk_bf16(v0[2], v0[3]); w.z = cvt_pk_bf16(v1[0], v1[1]); w.w = cvt_pk_bf16(v1[2], v1[3]); return w; }

struct EpiP {
    bf16_t* P;
    __device__ __forceinline__ void operator()(const f32x4 (&acc)[2][2][4][2], const Unit& u, int wr, int wc, int fr, int fq) const {
        const int row0 = u.pm * 256 + wr * 64 + fr, col0 = u.pn * 256 + wc * 32 + 8 * fq;
        const int act = u.pn < 14 ? 0 : (u.pn < 22 ? 1 : 2);
#pragma unroll
        for (int ai = 0; ai < 2; ++ai)
#pragma unroll
            for (int m = 0; m < 4; ++m) { const int row = row0 + ai * 128 + m * 16;
#pragma unroll
                for (int bj = 0; bj < 2; ++bj) { f32x4 v0 = acc[ai][bj][m][0], v1 = acc[ai][bj][m][1];
                    if (act == 1) { f32x2 a = pg8::gelu_pk((f32x2){v0[0], v0[1]}), b = pg8::gelu_pk((f32x2){v0[2], v0[3]}), c = pg8::gelu_pk((f32x2){v1[0], v1[1]}), d = pg8::gelu_pk((f32x2){v1[2], v1[3]});
                        v0 = (f32x4){a.x, a.y, b.x, b.y}; v1 = (f32x4){c.x, c.y, d.x, d.y}; }
                    else if (act == 2) {
#pragma unroll
                        for (int j = 0; j < 4; ++j) { v0[j] = sigmoidf_(v0[j]); v1[j] = sigmoidf_(v1[j]); } }
                    *(u32x4*)(P + (size_t)row * NP + col0 + bj * 128) = pack8(v0, v1); } }
    }
};
struct EpiLora {
    float* LOGW; bf16_t* AA; bf16_t* GG; const float* w0; const float* a0;
    __device__ __forceinline__ void operator()(const f32x4 (&acc)[2][2][4][2], const Unit& u, int wr, int wc, int fr, int fq) const {
        const int row0 = u.pm * 256 + wr * 64 + fr, seg = u.pn >> 2, colt = (u.pn & 3) * 256 + wc * 32 + 8 * fq;
        const float* bsrc = seg == 0 ? w0 : a0;
        f32x4 bb[2][2];
#pragma unroll
        for (int bj = 0; bj < 2; ++bj) { bb[bj][0] = *(const f32x4*)(bsrc + colt + bj * 128); bb[bj][1] = *(const f32x4*)(bsrc + colt + bj * 128 + 4); }
#pragma unroll
        for (int ai = 0; ai < 2; ++ai)
#pragma unroll
            for (int m = 0; m < 4; ++m) { const int row = row0 + ai * 128 + m * 16;
#pragma unroll
                for (int bj = 0; bj < 2; ++bj) { f32x4 v0 = acc[ai][bj][m][0], v1 = acc[ai][bj][m][1];
                    const int col = colt + bj * 128;
                    if (seg == 0) {
#pragma unroll
                        for (int j = 0; j < 4; ++j) {
                            { const float z = bb[bj][0][j] + v0[j]; const float sp = fmaxf(-z, 0.f) + __logf(1.0f + __expf(-fabsf(z))); v0[j] = -__expf(-sp - 0.5f); }
                            { const float z = bb[bj][1][j] + v1[j]; const float sp = fmaxf(-z, 0.f) + __logf(1.0f + __expf(-fabsf(z))); v1[j] = -__expf(-sp - 0.5f); } }
                        float* o = LOGW + (size_t)row * D + col; *(f32x4*)o = v0; *(f32x4*)(o + 4) = v1;
                    } else if (seg == 1) {
#pragma unroll
                        for (int j = 0; j < 4; ++j) { v0[j] = sigmoidf_(bb[bj][0][j] + v0[j]); v1[j] = sigmoidf_(bb[bj][1][j] + v1[j]); }
                        *(u32x4*)(AA + (size_t)row * D + col) = pack8(v0, v1);
                    } else {
                        *(u32x4*)(GG + (size_t)row * D + col) = pack8(v0, v1);
                    }
                    __builtin_amdgcn_sched_barrier(0); } }
    }
};
template <int MODE> struct EpiMix {
    const bf16_t* P; float* F; bf16_t* Bo; const float* X; int ldc;
    __device__ __forceinline__ void operator()(const f32x4 (&acc)[2][2][4][2], const Unit& u, int wr, int wc, int fr, int fq) const {
        const int row0 = u.pm * 256 + wr * 64 + fr, col0 = u.pn * 256 + wc * 32 + 8 * fq;
#pragma unroll
        for (int ai = 0; ai < 2; ++ai)
#pragma unroll
            for (int m = 0; m < 4; ++m) { const int row = row0 + ai * 128 + m * 16;
#pragma unroll
                for (int bj = 0; bj < 2; ++bj) { f32x4 v0 = acc[ai][bj][m][0], v1 = acc[ai][bj][m][1];
                    const int col = col0 + bj * 128;
                    if (MODE == 0 || MODE == 1) {
                        const u32x4 gw = *(const u32x4*)(P + (size_t)row * NP + (MODE == 0 ? PC_GA : PC_GB) + col); float gf[8]; unpack8(gw, gf);
#pragma unroll
                        for (int j = 0; j < 4; ++j) { v0[j] *= gf[j]; v1[j] *= gf[4 + j]; }
                    }
                    if (MODE == 0) { float* o = F + (size_t)row * D + col; *(f32x4*)o = v0; *(f32x4*)(o + 4) = v1; }
                    if (MODE == 1) { const float* t1 = F + (size_t)row * D + col; v0 = v0 + *(const f32x4*)t1; v1 = v1 + *(const f32x4*)(t1 + 4); *(u32x4*)(Bo + (size_t)row * D + col) = pack8(v0, v1); }
                    if (MODE == 2) { const float* xr = X + (size_t)row * D + col; v0 = v0 + ALPHA * *(const f32x4*)xr; v1 = v1 + ALPHA * *(const f32x4*)(xr + 4);
                        float* o = F + (size_t)row * D + col; *(f32x4*)o = v0; *(f32x4*)(o + 4) = v1; }
                    if (MODE == 3) { float* o = F + (size_t)row * ldc + col; *(f32x4*)o = v0; *(f32x4*)(o + 4) = v1; } } }
    }
};
struct EpiAct {
    bf16_t* ACT;
    __device__ __forceinline__ void operator()(const f32x4 (&acc)[2][2][4][2], const Unit& u, int wr, int wc, int fr, int fq) const {
        const int row0 = u.pm * 256 + wr * 64 + fr, col = u.pn * 128 + wc * 32 + 8 * fq;
#pragma unroll
        for (int ai = 0; ai < 2; ++ai)
#pragma unroll
            for (int m = 0; m < 4; ++m) { const int row = row0 + ai * 128 + m * 16;
                f32x4 g0 = acc[ai][0][m][0], g1 = acc[ai][0][m][1]; const f32x4 u0 = acc[ai][1][m][0], u1 = acc[ai][1][m][1];
#pragma unroll
                for (int j = 0; j < 4; ++j) { g0[j] = g0[j] * sigmoidf_(g0[j]) * u0[j]; g1[j] = g1[j] * sigmoidf_(g1[j]) * u1[j]; }
                *(u32x4*)(ACT + (size_t)row * 256 + col) = pack8(g0, g1); }
    }
};
struct EpiDown {
    bf16_t* YR; const float* row_gate;
    __device__ __forceinline__ void operator()(const f32x4 (&acc)[2][2][4][2], const Unit& u, int wr, int wc, int fr, int fq) const {
        const int row0 = u.pm * 256 + wr * 64 + fr, col0 = u.pn * 256 + wc * 32 + 8 * fq;
#pragma unroll
        for (int ai = 0; ai < 2; ++ai)
#pragma unroll
            for (int m = 0; m < 4; ++m) { const int row = row0 + ai * 128 + m * 16; const float gt = row_gate[row];
#pragma unroll
                for (int bj = 0; bj < 2; ++bj) { const f32x4 v0 = acc[ai][bj][m][0] * gt, v1 = acc[ai][bj][m][1] * gt;
                    *(u32x4*)(YR + (size_t)row * D + col0 + bj * 128) = pack8(v0, v1); } }
    }
};

struct Args { const float* in[30]; float* out; unsigned char* ws; int ph_lo, ph_hi; };
struct Frame {
    LAS unsigned char* lds;
    int tid, lane, wave, G, gw, NGW;
    const struct Args& A; float* out; unsigned char* ws; unsigned* ctl;
};
#define WSP(T_, off) ((T_*)(F.ws + (off)))

__device__ __forceinline__ void tr_item(const float* W, int N, int k0, int n0, bf16_t* WT, int ldo, int drow0, LAS float* scr, int lane) {
#pragma unroll 8
    for (int i = 0; i < 32; ++i) { const int kk = 2 * i + (lane >> 5); scr[kk * 33 + (lane & 31)] = W[(size_t)(k0 + kk) * N + n0 + (lane & 31)]; }
    asm volatile("s_waitcnt lgkmcnt(0)" ::: "memory");
    const int c = lane & 7;
#pragma unroll
    for (int j = 0; j < 4; ++j) { const int n = (lane >> 3) + 8 * j; const LAS float* s = scr + (8 * c) * 33 + n;
        u32x4 o; o.x = cvt_pk_bf16(s[0 * 33], s[1 * 33]); o.y = cvt_pk_bf16(s[2 * 33], s[3 * 33]); o.z = cvt_pk_bf16(s[4 * 33], s[5 * 33]); o.w = cvt_pk_bf16(s[6 * 33], s[7 * 33]);
        *(u32x4*)(WT + (size_t)(drow0 + n) * ldo + k0 + 8 * c) = o; }
    asm volatile("s_waitcnt lgkmcnt(0)" ::: "memory");
}
__device__ __forceinline__ void p0_prologue(Frame& F) {
    LAS float* scr = (LAS float*)(F.lds + F.wave * 8448);
    constexpr int I_IN = 16 * 233, I_SQ = 16 * 32, I_GU = 16 * 16, I_DN = 4 * 32;
    constexpr int NITEMS = I_IN + 3 * I_SQ + 257 * I_GU + 257 * I_DN;
    for (int it = F.gw; it < NITEMS; it += F.NGW) {
        int r = it;
        if (r < I_IN) { const int kb = r / 233, nb = r % 233, n0 = nb * 32; tr_item(F.A.in[1], C_IN, kb * 64, n0, WSP(bf16_t, WS_WT_IN), D, n0 < 3360 ? n0 : n0 + 224, scr, F.lane); continue; } r -= I_IN;
        if (r < 3 * I_SQ) { const int w = r / I_SQ, q = r % I_SQ, kb = q / 32, nb = q % 32;
            tr_item(w == 0 ? F.A.in[17] : (w == 1 ? F.A.in[18] : F.A.in[19]), D, kb * 64, nb * 32, WSP(bf16_t, w == 0 ? WS_WT_OA : (w == 1 ? WS_WT_OB : WS_WT_OUT)), D, nb * 32, scr, F.lane); continue; } r -= 3 * I_SQ;
        if (r < 257 * I_GU) { const int e = r / I_GU, q = r % I_GU, kb = q / 16, nb = q % 16, n0 = nb * 32;
            const float* src = e < 256 ? F.A.in[24] + (size_t)e * 1024 * 512 : F.A.in[26];
            const int half = n0 >> 8, idx = n0 & 255, drow = (idx >> 7) * 256 + half * 128 + (idx & 127);
            tr_item(src, 512, kb * 64, n0, WSP(bf16_t, WS_WT_GU) + (size_t)e * 512 * 1024, 1024, drow, scr, F.lane); continue; } r -= 257 * I_GU;
        { const int e = r / I_DN, q = r % I_DN, kb = q / 32, nb = q % 32;
            const float* src = e < 256 ? F.A.in[25] + (size_t)e * 256 * 1024 : F.A.in[27];
            tr_item(src, 1024, kb * 64, nb * 32, WSP(bf16_t, WS_WT_DN) + (size_t)e * 1024 * 256, 256, nb * 32, scr, F.lane); }
    }
    const size_t gt = (size_t)blockIdx.x * 512 + F.tid, NT = (size_t)F.G * 512;
    { bf16_t* w = WSP(bf16_t, WS_WT_IN) + (size_t)3360 * D; for (size_t i = gt; i < (size_t)224 * D / 8; i += NT) ((u32x4*)w)[i] = (u32x4){0u, 0u, 0u, 0u}; }
    { bf16_t* w = WSP(bf16_t, WS_WT_LORA);
      for (size_t i = gt; i < (size_t)3072 * LK; i += NT) { const int n = (int)(i / LK), k = (int)(i % LK); float v = 0.f;
          if (n < 1024) { if (k < 64) v = F.A.in[4][(size_t)k * D + n]; }
          else if (n < 2048) { if (k >= 64 && k < 128) v = F.A.in[6][(size_t)(k - 64) * D + (n - 1024)]; }
          else { if (k >= 128 && k < 288) v = F.A.in[7][(size_t)(k - 128) * D + (n - 2048)]; }
          w[i] = (bf16_t)f2bf(v); } }
    { bf16_t* w = WSP(bf16_t, WS_WT_R);
      for (size_t i = gt; i < (size_t)256 * HRK; i += NT) { const int n = (int)(i / HRK), k = (int)(i % HRK), kk = k & 1023, seg = k >> 10;
          const float v = F.A.in[22][(size_t)kk * NE + n]; const unsigned hi = f2bf(v); const float lo = v - bf2f(hi);
          w[i] = (bf16_t)(seg == 2 ? f2bf(lo) : hi); } }
    { const f32x4* x = (const f32x4*)F.A.in[0]; u32x2* xb = WSP(u32x2, WS_XB);
      for (size_t i = gt; i < (size_t)T * D / 4; i += NT) { const f32x4 v = x[i]; u32x2 o; o.x = cvt_pk_bf16(v[0], v[1]); o.y = cvt_pk_bf16(v[2], v[3]); xb[i] = o; } }
}

__device__ __forceinline__ void p2_lora_in(Frame& F) {
    const bf16_t* P = WSP(bf16_t, WS_P); bf16_t* L = WSP(bf16_t, WS_LORAIN); const float* mu = F.A.in[2];
    for (int t = F.gw; t < T; t += F.NGW) {
        const bool first = (t % SEQ) == 0;
#pragma unroll
        for (int j = 0; j < 6; ++j) { const int c = F.lane + 64 * j; float v = 0.f;
            if (c < 288) { const float cur = bf2f(P[(size_t)t * NP + PC_L + c]); const float prev = first ? 0.f : bf2f(P[(size_t)(t - 1) * NP + PC_L + c]);
                const float m = cur + mu[3072 + c] * (prev - cur);
                v = c < 64 ? tanhf(m) : (c < 128 ? m : sigmoidf_(m)); }
            L[(size_t)t * LK + c] = (bf16_t)f2bf(v); }
    }
}

__device__ __forceinline__ void p2_gmlp(Frame& F) {
    const bf16_t* P = WSP(bf16_t, WS_P); bf16_t* YB = WSP(bf16_t, WS_YB);
    const float* lnw = F.A.in[13]; const float* lnb = F.A.in[14]; const float* sw = F.A.in[15]; const float* sb = F.A.in[16];
    LAS bf16_t* VT = (LAS bf16_t*)F.lds;
    LAS float* ST = (LAS float*)(F.lds + 36864);
    const int lane = F.lane, wave = F.wave, fr = lane & 15, fq = lane >> 4;
    for (int ch = blockIdx.x; ch < T / 128; ch += F.G) {
        const int t0 = ch * 128;
        for (int i = 0; i < 16; ++i) { const int tl = wave * 16 + i; const bf16_t* vr = P + (size_t)(t0 + tl) * NP + PC_GV;
            float f0[8], f1[8]; unpack8(*(const u32x4*)(vr + lane * 8), f0); unpack8(*(const u32x4*)(vr + 512 + lane * 8), f1);
            float s = 0.f;
#pragma unroll
            for (int j = 0; j < 8; ++j) s += f0[j] + f1[j];
            const float mean = wave_sum(s) * (1.f / 1024.f); float q = 0.f;
#pragma unroll
            for (int j = 0; j < 8; ++j) { const float a = f0[j] - mean, b = f1[j] - mean; q += a * a + b * b; }
            const float rstd = 1.0f / sqrtf(wave_sum(q) * (1.f / 1024.f) + LN_EPS);
            if (lane == 0) { ST[tl * 2] = mean; ST[tl * 2 + 1] = rstd; } }
        __syncthreads();
        for (int g = 0; g < 8; ++g) {
            { const int s = F.tid >> 2, d0 = (F.tid & 3) * 32; const float mean = ST[s * 2], rstd = ST[s * 2 + 1];
              const bf16_t* vr = P + (size_t)(t0 + s) * NP + PC_GV + g * 128 + d0;
#pragma unroll
              for (int q4 = 0; q4 < 4; ++q4) { float f[8]; unpack8(*(const u32x4*)(vr + q4 * 8), f);
#pragma unroll
                  for (int j = 0; j < 8; ++j) { const int d = d0 + q4 * 8 + j; const float v = (f[j] - mean) * rstd * lnw[g * 128 + d] + lnb[g * 128 + d];
                      VT[d * 136 + s] = (bf16_t)f2bf(v); } } }
            __syncthreads();
            f32x4 acc[8];
#pragma unroll
            for (int n = 0; n < 8; ++n) acc[n] = (f32x4){0.f, 0.f, 0.f, 0.f};
            const int tl = wave * 16 + fr;
            const float* wrow = sw + ((size_t)g * 128 + tl) * 128;
#pragma unroll
            for (int ks = 0; ks < 4; ++ks) {
                if (ks * 32 <= wave * 16 + 15) {
                    const int s0 = ks * 32 + fq * 8;
                    const f32x4 w0 = *(const f32x4*)(wrow + s0), w1 = *(const f32x4*)(wrow + s0 + 4);
                    float wf[8] = {w0[0], w0[1], w0[2], w0[3], w1[0], w1[1], w1[2], w1[3]};
#pragma unroll
                    for (int j = 0; j < 8; ++j) wf[j] = (s0 + j <= tl) ? wf[j] : 0.f;
                    u32x4 aw; aw.x = cvt_pk_bf16(wf[0], wf[1]); aw.y = cvt_pk_bf16(wf[2], wf[3]); aw.z = cvt_pk_bf16(wf[4], wf[5]); aw.w = cvt_pk_bf16(wf[6], wf[7]);
                    const bf16x8 af = __builtin_bit_cast(bf16x8, aw);
#pragma unroll
                    for (int n = 0; n < 8; ++n) { const bf16x8 bfrag = *(const LAS bf16x8*)(VT + (n * 16 + fr) * 136 + s0);
                        acc[n] = __builtin_amdgcn_mfma_f32_16x16x32_bf16(bfrag, af, acc[n], 0, 0, 0); }
                }
            }
            const float bias = sb[g * 128 + tl];
            const bf16_t* ur = P + (size_t)(t0 + tl) * NP + PC_U + g * 128; bf16_t* yr = YB + (size_t)(t0 + tl) * D + g * 128;
#pragma unroll
            for (int n = 0; n < 8; ++n) { const int d = n * 16 + 4 * fq; const u32x2 uw = *(const u32x2*)(ur + d);
                const float o0 = bf2f(uw.x & 0xffffu) * (acc[n][0] + bias), o1 = bf2f(uw.x >> 16) * (acc[n][1] + bias), o2 = bf2f(uw.y & 0xffffu) * (acc[n][2] + bias), o3 = bf2f(uw.y >> 16) * (acc[n][3] + bias);
                u32x2 o; o.x = cvt_pk_bf16(o0, o1); o.y = cvt_pk_bf16(o2, o3); *(u32x2*)(yr + d) = o; }
            __syncthreads();
        }
    }
}

__device__ __forceinline__ void p4_scan_seq(Frame& F) {
    if (F.wave != 0) return;
    const bf16_t* P = WSP(bf16_t, WS_P); const float* LOGW = WSP(float, WS_LOGW); const bf16_t* AA = WSP(bf16_t, WS_AA); const bf16_t* GG = WSP(bf16_t, WS_GG); bf16_t* YA = WSP(bf16_t, WS_YA);
    LAS float* V = (LAS float*)F.lds;
    const int lane = F.lane;
    for (int bh = blockIdx.x; bh < 4 * NH; bh += F.G) {
        const int b = bh / NH, h = bh % NH, c = h * HD + lane;
        const float mu_r = F.A.in[2][c], mu_k = F.A.in[2][1024 + c], mu_v = F.A.in[2][2048 + c];
        const float k_k = F.A.in[8][c], k_a = F.A.in[9][c], r_k = F.A.in[10][c], gn_w = F.A.in[11][c], gn_b = F.A.in[12][c];
        float S[64];
#pragma unroll
        for (int j = 0; j < 64; ++j) S[j] = 0.f;
        float pr = 0.f, pk = 0.f, pv = 0.f;
        const size_t row0 = (size_t)b * SEQ;
        float cr = bf2f(P[row0 * NP + PC_R + c]), ck = bf2f(P[row0 * NP + PC_K + c]), cv = bf2f(P[row0 * NP + PC_V + c]);
        float cw = LOGW[row0 * D + c], ca = bf2f(AA[row0 * D + c]), cg = bf2f(GG[row0 * D + c]);
#pragma unroll 1
        for (int t = 0; t < SEQ; ++t) {
            const size_t rown = row0 + (t + 1 < SEQ ? t + 1 : t);
            const float nr = bf2f(P[rown * NP + PC_R + c]), nk = bf2f(P[rown * NP + PC_K + c]), nv = bf2f(P[rown * NP + PC_V + c]);
            const float nw = LOGW[rown * D + c], na = bf2f(AA[rown * D + c]), ng = bf2f(GG[rown * D + c]);
            const float r = cr + mu_r * (pr - cr), k = ck + mu_k * (pk - ck), v = cv + mu_v * (pv - cv);
            pr = cr; pk = ck; pv = cv;
            const float a = ca;
            float kk = k * k_k; const float nrm = sqrtf(wave_sum(kk * kk)); kk = kk / fmaxf(nrm, 1e-12f);
            const float kp = k * (1.0f + (a - 1.0f) * k_a);
            const float w = __expf(cw);
            V[lane] = w; V[64 + lane] = -kk; V[128 + lane] = kk * a; V[192 + lane] = kp; V[256 + lane] = r;
            asm volatile("s_waitcnt lgkmcnt(0)" ::: "memory");
            float sa = 0.f;
#pragma unroll
            for (int j = 0; j < 64; j += 4) { const f32x4 av = *(const LAS f32x4*)(V + 64 + j); sa += S[j] * av[0] + S[j + 1] * av[1] + S[j + 2] * av[2] + S[j + 3] * av[3]; }
            float y = 0.f;
#pragma unroll
            for (int j = 0; j < 64; j += 4) { const f32x4 wv = *(const LAS f32x4*)(V + j), bv = *(const LAS f32x4*)(V + 128 + j), kv = *(const LAS f32x4*)(V + 192 + j), rv = *(const LAS f32x4*)(V + 256 + j);
#pragma unroll
                for (int q = 0; q < 4; ++q) { S[j + q] = S[j + q] * wv[q] + sa * bv[q] + v * kv[q]; y += S[j + q] * rv[q]; }
                if ((j & 12) == 12) asm volatile("" ::: "memory"); }
            const float mean = wave_sum(y) * (1.f / 64.f); const float dy = y - mean; const float var = wave_sum(dy * dy) * (1.f / 64.f);
            const float yn = dy * (1.0f / sqrtf(var + GN_EPS)) * gn_w + gn_b;
            const float bonus = wave_sum(r * kp * r_k) * v;
            YA[(row0 + t) * D + c] = (bf16_t)f2bf((yn + bonus) * cg);
            asm volatile("s_waitcnt lgkmcnt(0)" ::: "memory");
            cr = nr; ck = nk; cv = nv; cw = nw; ca = na; cg = ng;
        }
    }
}

__device__ __forceinline__ void p8_ln1(Frame& F) {
    const float* HP = WSP(float, WS_H1PRE); float* H1 = WSP(float, WS_H1); bf16_t* HR = WSP(bf16_t, WS_HR);
    const float* lw = F.A.in[20]; const float* lb = F.A.in[21];
    for (int t = F.gw; t < T; t += F.NGW) {
        const f32x4* xr = (const f32x4*)(HP + (size_t)t * D) + F.lane; f32x4 v[4]; float s = 0.f;
#pragma unroll
        for (int j = 0; j < 4; ++j) { v[j] = xr[64 * j]; s += (v[j][0] + v[j][1]) + (v[j][2] + v[j][3]); }
        const float mean = wave_sum(s) * (1.f / D); float q = 0.f;
#pragma unroll
        for (int j = 0; j < 4; ++j) { v[j] = v[j] - mean; q += (v[j][0] * v[j][0] + v[j][1] * v[j][1]) + (v[j][2] * v[j][2] + v[j][3] * v[j][3]); }
        const float rstd = 1.0f / sqrtf(wave_sum(q) * (1.f / D) + LN_EPS);
#pragma unroll
        for (int j = 0; j < 4; ++j) { const int col = 4 * F.lane + 256 * j; const f32x4 w = *(const f32x4*)(lw + col), bb = *(const f32x4*)(lb + col);
            const f32x4 o = v[j] * rstd * w + bb; *(f32x4*)(H1 + (size_t)t * D + col) = o;
            const unsigned h01 = cvt_pk_bf16(o[0], o[1]), h23 = cvt_pk_bf16(o[2], o[3]);
            const float l0 = o[0] - bf2f(h01 & 0xffffu), l1 = o[1] - bf2f(h01 >> 16), l2 = o[2] - bf2f(h23 & 0xffffu), l3 = o[3] - bf2f(h23 >> 16);
            u32x2 hi; hi.x = h01; hi.y = h23; u32x2 lo; lo.x = cvt_pk_bf16(l0, l1); lo.y = cvt_pk_bf16(l2, l3);
            bf16_t* hr = HR + (size_t)t * HRK + col; *(u32x2*)hr = hi; *(u32x2*)(hr + 1024) = lo; *(u32x2*)(hr + 2048) = hi; }
    }
}

__device__ __forceinline__ void p10_route(Frame& F) {
    const float* LG = WSP(float, WS_LOGITS); const float* rb = F.A.in[23];
    int* TE = WSP(int, WS_TOPE); float* TG = WSP(float, WS_TOPG); int* CNT = WSP(int, WS_CNT);
    LAS int* hist = (LAS int*)F.lds;
    if (F.tid < 256) hist[F.tid] = 0;
    __syncthreads();
    const int TPB = (T + F.G - 1) / F.G, tb = blockIdx.x * TPB, te = (tb + TPB < T) ? tb + TPB : T;
    const int lane = F.lane; const float NINF = -__builtin_inff();
    const f32x4 bias = *(const f32x4*)(rb + 4 * lane);
    for (int t = tb + F.wave; t < te; t += 8) {
        const f32x4 lg = *(const f32x4*)(LG + (size_t)t * NE + 4 * lane);
        float sc[4], chv[4];
#pragma unroll
        for (int j = 0; j < 4; ++j) { sc[j] = 1.0f / (1.0f + expf(-lg[j])); chv[j] = sc[j] + bias[j]; }
        float m1 = NINF, m2 = NINF;
#pragma unroll
        for (int j = 0; j < 4; ++j) { if (chv[j] > m1) { m2 = m1; m1 = chv[j]; } else if (chv[j] > m2) m2 = chv[j]; }
#pragma unroll
        for (int o = 1; o < 8; o <<= 1) { const float b1 = __shfl_xor(m1, o), b2 = __shfl_xor(m2, o); const float n1 = fmaxf(m1, b1), n2 = fmaxf(fminf(m1, b1), fmaxf(m2, b2)); m1 = n1; m2 = n2; }
        const float gs = m1 + m2; const int g = lane >> 3; int rank = 0;
#pragma unroll
        for (int gg = 0; gg < 8; ++gg) { const float o = __shfl(gs, gg * 8); rank += (o > gs || (o == gs && gg < g)) ? 1 : 0; }
        const bool sel = rank < 4;
#pragma unroll
        for (int j = 0; j < 4; ++j) chv[j] = sel ? chv[j] : NINF;
        int my_e = 0; float my_s = 0.f, ssum = 0.f;
#pragma unroll
        for (int k = 0; k < TOPK; ++k) {
            float bv = chv[0]; int bi = 4 * lane;
#pragma unroll
            for (int j = 1; j < 4; ++j) if (chv[j] > bv) { bv = chv[j]; bi = 4 * lane + j; }
#pragma unroll
            for (int o = 1; o < 64; o <<= 1) { const float ov = __shfl_xor(bv, o); const int oi = __shfl_xor(bi, o); if (ov > bv || (ov == bv && oi < bi)) { bv = ov; bi = oi; } }
            const int j = bi & 3; const float scs = j == 0 ? sc[0] : (j == 1 ? sc[1] : (j == 2 ? sc[2] : sc[3]));
            const float sk = __shfl(scs, bi >> 2);
            if (lane == (bi >> 2)) { if (j == 0) chv[0] = NINF; else if (j == 1) chv[1] = NINF; else if (j == 2) chv[2] = NINF; else chv[3] = NINF; }
            ssum += sk; if (lane == k) { my_e = bi; my_s = sk; }
        }
        if (lane < TOPK) { TE[(size_t)t * TOPK + lane] = my_e; TG[(size_t)t * TOPK + lane] = my_s / ssum * ROUTED_SCALE; __hip_atomic_fetch_add(&hist[my_e], 1, __ATOMIC_RELAXED, __HIP_MEMORY_SCOPE_WORKGROUP); }
    }
    __syncthreads();
    if (F.tid < 256) CNT[(size_t)blockIdx.x * NE + F.tid] = hist[F.tid];
}

__device__ __forceinline__ void p11_place(Frame& F) {
    const int* TE = WSP(int, WS_TOPE); const float* TG = WSP(float, WS_TOPG); const int* CNT = WSP(int, WS_CNT);
    int* SLOT = WSP(int, WS_SLOT); int* RT = WSP(int, WS_ROWTOK); float* RG = WSP(float, WS_ROWGATE);
    LAS int* tot = (LAS int*)F.lds; LAS int* mine = tot + 256; LAS int* start = tot + 512; LAS int* cursor = tot + 1024;
    const int b = blockIdx.x;
    if (F.tid < 256) { int s = 0, m = 0; for (int bb = 0; bb < F.G; ++bb) { const int c = CNT[(size_t)bb * NE + F.tid]; s += c; if (bb < b) m += c; } tot[F.tid] = s; mine[F.tid] = m; cursor[F.tid] = 0; }
    __syncthreads();
    if (F.tid == 0) { int s = 0; for (int e = 0; e < NE; ++e) { start[e] = s; s += (tot[e] + 255) & ~255; } start[NE] = s; start[NE + 1] = s + T; }
    __syncthreads();
    const int TPB = (T + F.G - 1) / F.G, tb = b * TPB, te = (tb + TPB < T) ? tb + TPB : T;
    for (int i = tb * TOPK + F.tid; i < te * TOPK; i += 512) { const int e = TE[i]; const int pos = __hip_atomic_fetch_add(&cursor[e], 1, __ATOMIC_RELAXED, __HIP_MEMORY_SCOPE_WORKGROUP); const int row = start[e] + mine[e] + pos;
        RT[row] = i / TOPK; RG[row] = TG[i]; SLOT[i] = row; }
    const int shb = start[NE];
    for (int t = tb + F.tid; t < te; t += 512) { RT[shb + t] = t; RG[shb + t] = 1.0f; }
    for (int e = b; e < NE; e += F.G) { for (int r = start[e] + tot[e] + F.tid; r < start[e + 1]; r += 512) { RT[r] = 0; RG[r] = 0.f; } }
    if (b == 0) {
        if (F.tid < 257) { for (int pm = start[F.tid] >> 8; pm < (start[F.tid + 1] >> 8); ++pm) F.ctl[CW_BLKE + pm] = (unsigned)F.tid; }
        if (F.tid == 0) { F.ctl[CW_NBLK] = (unsigned)(start[NE + 1] >> 8); F.ctl[CW_SHBASE] = (unsigned)shb; }
    }
}

__device__ __forceinline__ void p14_combine(Frame& F) {
    const float* H1 = WSP(float, WS_H1); const bf16_t* YR = WSP(bf16_t, WS_YR); const int* SLOT = WSP(int, WS_SLOT);
    const float* lw = F.A.in[28]; const float* lb = F.A.in[29];
    const int shb = (int)__builtin_amdgcn_readfirstlane(ld_u32_sc1(F.ctl + CW_SHBASE));
    for (int t = F.gw; t < T; t += F.NGW) {
        f32x4 v[4];
#pragma unroll
        for (int j = 0; j < 4; ++j) v[j] = ALPHA * *(const f32x4*)(H1 + (size_t)t * D + 4 * F.lane + 256 * j);
#pragma unroll
        for (int k = 0; k <= TOPK; ++k) { const int row = k < TOPK ? SLOT[(size_t)t * TOPK + k] : shb + t; const bf16_t* yr = YR + (size_t)row * D + 4 * F.lane;
#pragma unroll
            for (int j = 0; j < 4; ++j) { const u32x2 w = *(const u32x2*)(yr + 256 * j); v[j][0] += bf2f(w.x & 0xffffu); v[j][1] += bf2f(w.x >> 16); v[j][2] += bf2f(w.y & 0xffffu); v[j][3] += bf2f(w.y >> 16); } }
        float s = 0.f;
#pragma unroll
        for (int j = 0; j < 4; ++j) s += (v[j][0] + v[j][1]) + (v[j][2] + v[j][3]);
        const float mean = wave_sum(s) * (1.f / D); float q = 0.f;
#pragma unroll
        for (int j = 0; j < 4; ++j) { v[j] = v[j] - mean; q += (v[j][0] * v[j][0] + v[j][1] * v[j][1]) + (v[j][2] * v[j][2] + v[j][3] * v[j][3]); }
        const float rstd = 1.0f / sqrtf(wave_sum(q) * (1.f / D) + LN_EPS);
#pragma unroll
        for (int j = 0; j < 4; ++j) { const int col = 4 * F.lane + 256 * j; const f32x4 w = *(const f32x4*)(lw + col), bb = *(const f32x4*)(lb + col);
            *(f32x4*)(F.out + (size_t)t * D + col) = v[j] * rstd * w + bb; }
    }
}

constexpr int N_PHASES = 15;
__global__ void __launch_bounds__(512, 2) mk_fwd(Args args) {
    extern __shared__ __attribute__((aligned(16))) unsigned char lds_raw[];
    const int tid_ = threadIdx.x, wave_ = __builtin_amdgcn_readfirstlane(tid_ >> 6);
    Frame F{(LAS unsigned char*)lds_raw, tid_, tid_ & 63, wave_, (int)gridDim.x, (int)blockIdx.x * 8 + wave_, (int)gridDim.x * 8, args, args.out, args.ws, (unsigned*)(args.ws + WS_CTL)};
    volatile LAS unsigned* MISC = (volatile LAS unsigned*)(F.lds + MISC_OFF);
    for (int u = F.tid; u < (LDS_BYTES - RING_BYTES) / 4; u += 512) ((LAS unsigned*)(F.lds + RING_BYTES))[u] = 0u;
    __syncthreads();
    XcdBarrier bar; bar.bar = F.ctl + CW_BAR; bar.x = 0; bar.st = nullptr;
    if (!MK_SPLIT) bar = xcd_barrier_post(F.ctl + CW_BAR, MISC + 8);
    const int lo = args.ph_lo, hi = args.ph_hi;
#ifndef PH_MASK
#define PH_MASK 0x7fff
#endif
#define IN(k) (((PH_MASK >> (k)) & 1) && lo <= (k) && (k) < hi)
#define SEAM(k) do { if (IN(k) && IN((k) + 1)) xcd_barrier(bar); } while (0)

    if (IN(0)) { p0_prologue(F); } SEAM(0);
    if (IN(1)) { pg8::Gemm g{WSP(bf16_t, WS_XB), WSP(bf16_t, WS_WT_IN), D, D, D}; pg8::StaticOrder S; S.init(T, NP, F.G, (int)blockIdx.x);
        EpiP E{WSP(bf16_t, WS_P)}; pg8::gemm_phase(F.lds, g, S, E); } SEAM(1);
    if (IN(2)) { p2_lora_in(F); p2_gmlp(F); } SEAM(2);
    if (IN(3)) { pg8::Gemm g{WSP(bf16_t, WS_LORAIN), WSP(bf16_t, WS_WT_LORA), LK, LK, LK}; pg8::StaticOrder S; S.init(T, 3072, F.G, (int)blockIdx.x);
        EpiLora E{WSP(float, WS_LOGW), WSP(bf16_t, WS_AA), WSP(bf16_t, WS_GG), F.A.in[3], F.A.in[5]}; pg8::gemm_phase(F.lds, g, S, E); } SEAM(3);
    if (IN(4)) { p4_scan_seq(F); } SEAM(4);
    if (IN(5)) { pg8::Gemm g{WSP(bf16_t, WS_YA), WSP(bf16_t, WS_WT_OA), D, D, D}; pg8::StaticOrder S; S.init(T, D, F.G, (int)blockIdx.x);
        EpiMix<0> E{WSP(bf16_t, WS_P), WSP(float, WS_T1), nullptr, nullptr, D}; pg8::gemm_phase(F.lds, g, S, E); } SEAM(5);
    if (IN(6)) { pg8::Gemm g{WSP(bf16_t, WS_YB), WSP(bf16_t, WS_WT_OB), D, D, D}; pg8::StaticOrder S; S.init(T, D, F.G, (int)blockIdx.x);
        EpiMix<1> E{WSP(bf16_t, WS_P), WSP(float, WS_T1), WSP(bf16_t, WS_MIXIN), nullptr, D}; pg8::gemm_phase(F.lds, g, S, E); } SEAM(6);
    if (IN(7)) { pg8::Gemm g{WSP(bf16_t, WS_MIXIN), WSP(bf16_t, WS_WT_OUT), D, D, D}; pg8::StaticOrder S; S.init(T, D, F.G, (int)blockIdx.x);
        EpiMix<2> E{nullptr, WSP(float, WS_H1PRE), nullptr, F.A.in[0], D}; pg8::gemm_phase(F.lds, g, S, E); } SEAM(7);
    if (IN(8)) { p8_ln1(F); } SEAM(8);
    if (IN(9)) { pg8::Gemm g{WSP(bf16_t, WS_HR), WSP(bf16_t, WS_WT_R), HRK, HRK, HRK}; pg8::StaticOrder S; S.init(T, NE, F.G, (int)blockIdx.x);
        EpiMix<3> E{nullptr, WSP(float, WS_LOGITS), nullptr, nullptr, NE}; pg8::gemm_phase(F.lds, g, S, E); } SEAM(9);
    if (IN(10)) { p10_route(F); } SEAM(10);
    if (IN(11)) { p11_place(F); } SEAM(11);
    if (IN(12)) { pg8::Gemm g{WSP(bf16_t, WS_HR), WSP(bf16_t, WS_WT_GU), D, HRK, D};
        pg8::GroupedOrder<true> S{F.ctl + CW_BLKE, WSP(int, WS_ROWTOK), (int)__builtin_amdgcn_readfirstlane(ld_u32_sc1(F.ctl + CW_NBLK)), 2, F.G, (int)blockIdx.x, (size_t)512 * 1024 * 2};
        EpiAct E{WSP(bf16_t, WS_ACT)}; pg8::gemm_phase(F.lds, g, S, E); } SEAM(12);
    if (IN(13)) { pg8::Gemm g{WSP(bf16_t, WS_ACT), WSP(bf16_t, WS_WT_DN), 256, 256, 256};
        pg8::GroupedOrder<false> S{F.ctl + CW_BLKE, WSP(int, WS_ROWTOK), (int)__builtin_amdgcn_readfirstlane(ld_u32_sc1(F.ctl + CW_NBLK)), 4, F.G, (int)blockIdx.x, (size_t)1024 * 256 * 2};
        EpiDown E{WSP(bf16_t, WS_YR), WSP(float, WS_ROWGATE)}; pg8::gemm_phase(F.lds, g, S, E); } SEAM(13);
    if (IN(14)) { p14_combine(F); }
#undef IN
#undef SEAM
}

extern "C" void kernel_launch(void* const* d_in, const int* in_sizes, int n_in, void* d_out, int out_size, void* d_ws, size_t ws_size, hipStream_t stream) {
    static int grid = 0;
    if (grid == 0) {
        if (n_in != 30 || out_size != T * D || ws_size < WS_END) { fprintf(stderr, "kernel_launch: unexpected shapes: n_in %d out %d ws %zu (need %zu)\n", n_in, out_size, ws_size, (size_t)WS_END); grid = -1; return; }
        int dev = 0, cus = 0, per_cu = 0;
        if (hipGetDevice(&dev) != hipSuccess || hipDeviceGetAttribute(&cus, hipDeviceAttributeMultiprocessorCount, dev) != hipSuccess) { grid = -1; return; }
        if (hipFuncSetAttribute((const void*)mk_fwd, hipFuncAttributeMaxDynamicSharedMemorySize, LDS_BYTES) != hipSuccess) { fprintf(stderr, "kernel_launch: hipFuncSetAttribute failed\n"); grid = -1; return; }
        if (hipOccupancyMaxActiveBlocksPerMultiprocessor(&per_cu, (const void*)mk_fwd, 512, LDS_BYTES) != hipSuccess || per_cu < 1) { fprintf(stderr, "kernel_launch: occupancy query says %d\n", per_cu); }
        (void)hipGetLastError();
        grid = cus;
        if (grid > 1024) grid = 1024;
    }
    if (grid < 0) return;
    (void)hipMemsetAsync((char*)d_ws + WS_CTL, 0, CTL_ZERO_BYTES, stream);
    Args a{};
    for (int i = 0; i < 30; ++i) a.in[i] = (const float*)d_in[i];
    a.out = (float*)d_out; a.ws = (unsigned char*)d_ws;
#if MK_SPLIT
    for (int p = 0; p < N_PHASES; ++p) { a.ph_lo = p; a.ph_hi = p + 1; hipLaunchKernelGGL(mk_fwd, dim3(grid), dim3(512), LDS_BYTES, stream, a); }
#else
    a.ph_lo = 0; a.ph_hi = N_PHASES; hipLaunchKernelGGL(mk_fwd, dim3(grid), dim3(512), LDS_BYTES, stream, a);
#endif
}
```

```cpp
#include <hip/hip_runtime.h>
#include <cstdio>
#include <cstdint>

#ifndef MK_SPLIT
#define MK_SPLIT 0
#endif

#define LAS __attribute__((address_space(3)))
#define GAS __attribute__((address_space(1)))
typedef unsigned short bf16_t;
typedef short bf16x8 __attribute__((ext_vector_type(8)));
typedef float f32x4 __attribute__((ext_vector_type(4)));
typedef float f32x2 __attribute__((ext_vector_type(2)));
typedef unsigned u32x4 __attribute__((ext_vector_type(4)));
typedef unsigned u32x2 __attribute__((ext_vector_type(2)));

constexpr int T = 32768, D = 1024, SEQ = 8192, NH = 16, HD = 64;
constexpr int C_IN = 7456, NP = 7680;
constexpr int PC_R = 0, PC_K = 1024, PC_V = 2048, PC_L = 3072, PC_U = 3584, PC_GV = 4608, PC_GA = 5632, PC_GB = 6656;
constexpr int NE = 256, TOPK = 8;
constexpr int LK = 384;
constexpr int RMAX = 360448;
constexpr int HRK = 3072;
constexpr float LN_EPS = 1e-5f, GN_EPS = 64e-5f;
constexpr float ALPHA = 1.189207115002721f;
constexpr float ROUTED_SCALE = 2.5f;

constexpr size_t MiB = 1u << 20;
constexpr size_t WS_CTL = 0, CTL_ZERO_BYTES = 1 * MiB;
constexpr size_t WS_WT_IN = 2 * MiB;
constexpr size_t WS_WT_LORA = 17 * MiB;
constexpr size_t WS_WT_OA = 20 * MiB, WS_WT_OB = 22 * MiB, WS_WT_OUT = 24 * MiB;
constexpr size_t WS_WT_R = 26 * MiB;
constexpr size_t WS_WT_GU = 28 * MiB;
constexpr size_t WS_WT_DN = 285 * MiB;
constexpr size_t WS_H1 = 414 * MiB;
constexpr size_t WS_HR = 542 * MiB;
constexpr size_t WS_LOGITS = 734 * MiB;
constexpr size_t WS_TOPE = 766 * MiB;
constexpr size_t WS_TOPG = 767 * MiB;
constexpr size_t WS_SLOT = 768 * MiB;
constexpr size_t WS_CNT = 769 * MiB;
constexpr size_t WS_ROWTOK = 770 * MiB;
constexpr size_t WS_ROWGATE = 772 * MiB;
constexpr size_t WS_XB = 774 * MiB;
constexpr size_t WS_P = 838 * MiB;
constexpr size_t WS_LORAIN = 1318 * MiB;
constexpr size_t WS_LOGW = 1342 * MiB;
constexpr size_t WS_AA = 1470 * MiB;
constexpr size_t WS_GG = 1534 * MiB;
constexpr size_t WS_YA = 1598 * MiB;
constexpr size_t WS_YB = 1662 * MiB;
constexpr size_t WS_T1 = 1726 * MiB;
constexpr size_t WS_MIXIN = 1854 * MiB;
constexpr size_t WS_H1PRE = 1918 * MiB;
constexpr size_t WS_END = 2046 * MiB;
constexpr size_t WS_ACT = 774 * MiB;
constexpr size_t WS_YR = 950 * MiB;
static_assert(WS_ACT + (size_t)RMAX * 256 * 2 <= WS_YR && WS_YR + (size_t)RMAX * 1024 * 2 <= WS_END, "moe overlay");
static_assert(WS_WT_GU + (size_t)257 * 512 * 1024 * 2 <= WS_WT_DN && WS_WT_DN + (size_t)257 * 1024 * 256 * 2 <= WS_H1, "weights");
static_assert(WS_ROWGATE + (size_t)RMAX * 4 <= WS_XB && WS_ROWTOK + (size_t)RMAX * 4 <= WS_ROWGATE, "routing");
constexpr int CW_NBLK = 16;
constexpr int CW_SHBASE = 17;
constexpr int CW_BLKE = 1024;
constexpr int CW_BAR = 8192;
static_assert((CW_BAR + 3456) * 4 <= (int)CTL_ZERO_BYTES, "ctl");

constexpr int RING_BYTES = 131072;
constexpr int MISC_OFF = RING_BYTES + 320;
constexpr int LDS_BYTES = 147456;

__device__ __forceinline__ float bf2f(unsigned b) { return __uint_as_float(b << 16); }
__device__ __forceinline__ unsigned cvt_pk_bf16(float lo, float hi) { unsigned r; asm volatile("v_cvt_pk_bf16_f32 %0, %1, %2" : "=v"(r) : "v"(lo), "v"(hi)); return r; }
__device__ __forceinline__ unsigned f2bf(float f) { return cvt_pk_bf16(f, 0.f) & 0xffffu; }
__device__ __forceinline__ float wave_sum(float v) {
#pragma unroll
    for (int o = 1; o < 64; o <<= 1) v += __shfl_xor(v, o);
    return v;
}
__device__ __forceinline__ float sigmoidf_(float x) { return 1.0f / (1.0f + __expf(-x)); }
__device__ __forceinline__ void unpack8(const u32x4 w, float (&f)[8]) {
    f[0] = bf2f(w.x & 0xffffu); f[1] = bf2f(w.x >> 16); f[2] = bf2f(w.y & 0xffffu); f[3] = bf2f(w.y >> 16);
    f[4] = bf2f(w.z & 0xffffu); f[5] = bf2f(w.z >> 16); f[6] = bf2f(w.w & 0xffffu); f[7] = bf2f(w.w >> 16);
}
__device__ __forceinline__ unsigned ld_u32_sc1(const unsigned* p) { return __hip_atomic_load(p, __ATOMIC_RELAXED, __HIP_MEMORY_SCOPE_AGENT); }

#define XB_TMO      128
#define XB_XCNT(j)  (256  + 64 * (j))
#define XB_XSUB(j)  (1280 + 64 * (j))
#define XB_XGEN(j)  (2304 + 64 * (j))
#define XB_TOP      3328
#define XB_TOPGEN   3392
#define XCD_BAR_WORDS 3456
#define XB_SPIN_CAP (1u << 18)
__device__ __forceinline__ unsigned xb_ld(unsigned* p)              { return __hip_atomic_load(p, __ATOMIC_RELAXED, __HIP_MEMORY_SCOPE_AGENT); }
__device__ __forceinline__ unsigned xb_add(unsigned* p, unsigned v) { return __hip_atomic_fetch_add(p, v, __ATOMIC_RELAXED, __HIP_MEMORY_SCOPE_AGENT); }
__device__ __forceinline__ unsigned xb_xcc_id() { return (unsigned)__builtin_amdgcn_s_getreg((3 << 11) | 20) & 0xFu; }
#define XB_SPIN(cond, bar) do { unsigned _sp = 0; while (cond) { __builtin_amdgcn_s_sleep(1); \
    if ((++_sp & 255u) == 0u) { if (xb_ld(&(bar)[XB_TMO])) break; if (_sp > XB_SPIN_CAP) { atomicAdd(&(bar)[XB_TMO], 1u); break; } } } } while (0)
struct XcdBarrier { unsigned* bar; unsigned x; volatile LAS unsigned* st; };
__device__ __forceinline__ XcdBarrier xcd_barrier_post(unsigned* bar, volatile LAS unsigned* st) {
    XcdBarrier b; b.bar = bar; b.x = xb_xcc_id(); b.st = st;
    if (threadIdx.x == 0) (void)xb_add(&bar[XB_XCNT(b.x)], 1u);
    return b;
}
__device__ __forceinline__ void xcd_barrier_complete(unsigned* bar, unsigned x, unsigned& nloc, unsigned& nx) {
    const unsigned G = gridDim.x * gridDim.y * gridDim.z;
    unsigned sum, cnt, mine, sp = 0u;
    for (;;) {
        sum = 0u; cnt = 0u; mine = 0u;
#pragma unroll
        for (unsigned j = 0; j < 16; ++j) { const unsigned c = xb_ld(&bar[XB_XCNT(j)]); sum += c; cnt += (c > 0u) ? 1u : 0u; mine = (j == x) ? c : mine; }
        if (sum == G) break;
        __builtin_amdgcn_s_sleep(1);
        if ((++sp & 255u) == 0u) { if (xb_ld(&bar[XB_TMO])) break; if (sp > XB_SPIN_CAP) { atomicAdd(&bar[XB_TMO], 1u); break; } }
    }
    nloc = mine > 0u ? mine : 1u; nx = cnt > 0u ? cnt : 1u;
}
__device__ __forceinline__ void xcd_barrier(const XcdBarrier& b) {
    asm volatile("s_waitcnt vmcnt(0)" ::: "memory");
    __syncthreads();
    if (threadIdx.x == 0) {
        unsigned* bar = b.bar;
        __builtin_amdgcn_s_waitcnt(0);
        unsigned nloc = b.st[0], nx = b.st[1];
        if (nloc == 0u) { xcd_barrier_complete(bar, b.x, nloc, nx); b.st[0] = nloc; b.st[1] = nx; }
        const unsigned old = xb_add(&bar[XB_XSUB(b.x)], 1u);
        const unsigned gen = old / nloc;
        if (old + 1u == (gen + 1u) * nloc) {
            __builtin_amdgcn_fence(__ATOMIC_RELEASE, "agent");
            asm volatile("s_waitcnt vmcnt(0)" ::: "memory");
            const unsigned og = xb_add(&bar[XB_TOP], 1u);
            const unsigned tg = og / nx;
            if (og + 1u == (tg + 1u) * nx) xb_add(&bar[XB_TOPGEN], 1u);
            else XB_SPIN(xb_ld(&bar[XB_TOPGEN]) == tg, bar);
            __builtin_amdgcn_fence(__ATOMIC_ACQUIRE, "agent");
            xb_add(&bar[XB_XGEN(b.x)], 1u);
            asm volatile("s_waitcnt vmcnt(0)" ::: "memory");
        } else {
            XB_SPIN(xb_ld(&bar[XB_XGEN(b.x)]) == gen, bar);
            __builtin_amdgcn_fence(__ATOMIC_ACQUIRE, "agent");
            asm volatile("s_waitcnt vmcnt(0)" ::: "memory");
        }
    }
    __syncthreads();
}

namespace pg8 {
constexpr int BM = 256, BK = 64, HALF = 128, HTB = HALF * BK * 2, STAGE_BYTES = 8 * HTB, NXCD = 8, WGM = 8;
__host__ __device__ __forceinline__ int lds_byte(int r, int c) { const int st = (r >> 4) * 2 + (c >> 5), rr = r & 15, cc = c & 31, ob = rr * 64 + cc * 2; return st * 1024 + (ob ^ (((ob >> 9) & 1) << 5)); }
__host__ __device__ __forceinline__ void stage_rc(int b, int& R, int& C) { const int st = b / 1024, sb = b % 1024, swz = sb ^ (((sb >> 9) & 1) << 5); R = (st >> 1) * 16 + swz / 64; C = (st & 1) * 32 + (swz % 64) / 2; }
__host__ __device__ __forceinline__ int perm32(int rho) { const int n = rho >> 4, i = rho & 15; return 8 * (i >> 2) + 4 * n + (i & 3); }

struct Unit { int pm, pn, aux; };
struct Gemm { const bf16_t* A; const bf16_t* Bt; int K, lda, ldb; };

struct StaticOrder {
    static constexpr bool GATHER = false;
    int nM, nN, nwg, G, c;
    __device__ void init(int M, int N, int G_, int c_) { nM = M / BM; nN = N / BM; nwg = nM * nN; G = G_; c = c_; }
    __device__ bool next(int i, Unit& u) const {
        const long L = (long)i * G + c; if (L >= nwg) return false;
        int wgid = (int)L; { const int q = nwg / NXCD, r = nwg % NXCD, xcd = wgid % NXCD, off = wgid / NXCD; wgid = (xcd < r ? xcd * (q + 1) : r * (q + 1) + (xcd - r) * q) + off; }
        const int nig = WGM * nN, gid = wgid / nig, fm = gid * WGM, gsz = (nM - fm) < WGM ? (nM - fm) : WGM;
        u.pm = fm + ((wgid % nig) % gsz); u.pn = (wgid % nig) / gsz; u.aux = 0; return true;
    }
    __device__ __forceinline__ const char* a_base(const Gemm& g, const Unit& u) const { return (const char*)g.A + (size_t)u.pm * BM * g.lda * 2; }
    __device__ __forceinline__ const char* b_base(const Gemm& g, const Unit& u) const { return (const char*)g.Bt + (size_t)u.pn * BM * g.ldb * 2; }
    __device__ __forceinline__ unsigned a_rowoff(const Gemm&, const Unit&, int) const { return 0u; }
};
template <bool GATH> struct GroupedOrder {
    static constexpr bool GATHER = GATH;
    const unsigned* blk_e; const int* row_tok; int nblk, nN, G, c; size_t wstride;
    __device__ bool next(int i, Unit& u) const {
        const long L = (long)i * G + c; if (L >= (long)nblk * nN) return false;
        u.pm = (int)(L / nN); u.pn = (int)(L % nN);
        u.aux = (int)__builtin_amdgcn_readfirstlane(ld_u32_sc1(blk_e + u.pm)); return true;
    }
    __device__ __forceinline__ const char* a_base(const Gemm& g, const Unit& u) const { return (const char*)g.A + (size_t)u.pm * BM * g.lda * 2; }
    __device__ __forceinline__ const char* b_base(const Gemm& g, const Unit& u) const { return (const char*)g.Bt + (size_t)u.aux * wstride + (size_t)u.pn * BM * g.ldb * 2; }
    __device__ __forceinline__ unsigned a_rowoff(const Gemm& g, const Unit& u, int r) const { return (unsigned)row_tok[u.pm * BM + r] * (unsigned)(g.lda * 2); }
};

template <class Epi, class Sched>
__device__ __forceinline__ void gemm_phase(LAS unsigned char* lds, const Gemm g, const Sched& S, const Epi& E) {
    int tid_o = threadIdx.x; asm volatile("" : "+v"(tid_o));
    const int tid = tid_o, wid = __builtin_amdgcn_readfirstlane(tid >> 6), lane = tid & 63, wr = wid >> 2, wc = wid & 3, fr = lane & 15, fq = lane >> 4;
    const int K = g.K, nt = K / BK;
    unsigned voffA[2], voffB[2]; int RA[2]; unsigned CA2[2];
#pragma unroll
    for (int i = 0; i < 2; ++i) { int R, C; stage_rc(tid * 16 + i * 8192, R, C); const int Rb = (R & ~31) + perm32(R & 31);
        voffA[i] = (unsigned)(R * g.lda + C) * 2u; voffB[i] = (unsigned)(Rb * g.ldb + C) * 2u; RA[i] = R; CA2[i] = (unsigned)C * 2u; }
    const size_t kstep = (size_t)(BK * 2);
    const size_t hstepA = (size_t)HALF * g.lda * 2, hstepB = (size_t)HALF * g.ldb * 2;
    const unsigned ldsw = (unsigned)wid * 1024u;
    const int aoff = lds_byte(wr * 64 + fr, fq * 8), boff = lds_byte(wc * 32 + fr, fq * 8);
#define PG8_SA(b, h) (((b) * 2 + (h)) * HTB)
#define PG8_SB(b, h) ((4 + (b) * 2 + (h)) * HTB)
#define PG8_STAGE(bufoff, gbase, voff) do { _Pragma("unroll") for (int _i = 0; _i < 2; ++_i) \
        __builtin_amdgcn_global_load_lds((const unsigned*)((const char*)(gbase) + (voff)[_i]), (LAS unsigned*)(lds + (bufoff) + ldsw + _i * 8192), 16, 0, 0); } while (0)
#define PG8_LDA(dst, b, h) do { _Pragma("unroll") for (int m = 0; m < 4; ++m) _Pragma("unroll") for (int k = 0; k < 2; ++k) dst[m][k] = *(const LAS bf16x8*)(lds + PG8_SA(b, h) + aoff + m * 2048 + k * 1024); } while (0)
#define PG8_LDB(dst, b, h) do { _Pragma("unroll") for (int n = 0; n < 2; ++n) _Pragma("unroll") for (int k = 0; k < 2; ++k) dst[n][k] = *(const LAS bf16x8*)(lds + PG8_SB(b, h) + boff + n * 2048 + k * 1024); } while (0)
#define PG8_MMA(ai, bj, At, Bt) do { __builtin_amdgcn_s_setprio(1); _Pragma("unroll") for (int m = 0; m < 4; ++m) _Pragma("unroll") for (int n = 0; n < 2; ++n) _Pragma("unroll") for (int k = 0; k < 2; ++k) \
        acc[ai][bj][m][n] = __builtin_amdgcn_mfma_f32_16x16x32_bf16(Bt[n][k], At[m][k], acc[ai][bj][m][n], 0, 0, 0); __builtin_amdgcn_s_setprio(0); } while (0)
#define PG8_WAIT_V(n) asm volatile("s_waitcnt vmcnt(" #n ")" ::: "memory")
#define PG8_WAIT_L(n) asm volatile("s_waitcnt lgkmcnt(" #n ")" ::: "memory")
#define PG8_BAR __builtin_amdgcn_s_barrier()
#define PG8_SCHED __builtin_amdgcn_sched_barrier(0)
    Unit cur, nxt; int ui = 0;
    if (!S.next(0, cur)) return;
    f32x4 acc[2][2][4][2];
#pragma unroll
    for (int a = 0; a < 2; ++a)
#pragma unroll
        for (int b = 0; b < 2; ++b)
#pragma unroll
            for (int m = 0; m < 4; ++m)
#pragma unroll
                for (int n = 0; n < 2; ++n) acc[a][b][m][n] = (f32x4){0.f, 0.f, 0.f, 0.f};
    bf16x8 At[4][2], B0[2][2], B1[2][2];
    unsigned gcur[2][2], gnxt[2][2];
    const char* cA = Sched::GATHER ? (const char*)g.A : S.a_base(g, cur); const char* cB = S.b_base(g, cur);
    if constexpr (Sched::GATHER) {
#pragma unroll
        for (int h = 0; h < 2; ++h)
#pragma unroll
            for (int i = 0; i < 2; ++i) { gcur[h][i] = S.a_rowoff(g, cur, h * HALF + RA[i]) + CA2[i]; gnxt[h][i] = gcur[h][i]; }
    }
#define PG8_STAGE_A(bufoff, base, h, GO) do { if constexpr (Sched::GATHER) { PG8_STAGE(bufoff, base, GO[h]); } else { PG8_STAGE(bufoff, (base) + (h) * hstepA, voffA); } } while (0)
    PG8_STAGE(PG8_SB(0, 0), cB, voffB); PG8_STAGE_A(PG8_SA(0, 0), cA, 0, gcur); PG8_STAGE(PG8_SB(0, 1), cB + hstepB, voffB); PG8_STAGE_A(PG8_SA(0, 1), cA, 1, gcur);
    if (wr == 1) PG8_BAR;
    PG8_WAIT_V(4); PG8_BAR;
    PG8_STAGE(PG8_SB(1, 0), cB + kstep, voffB); PG8_STAGE_A(PG8_SA(1, 0), cA + kstep, 0, gcur); PG8_STAGE(PG8_SB(1, 1), cB + hstepB + kstep, voffB);
    PG8_WAIT_V(6); PG8_BAR;
    for (;;) {
        const bool has_next = S.next(ui + 1, nxt);
        const char* nA = has_next ? (Sched::GATHER ? (const char*)g.A : S.a_base(g, nxt)) : cA; const char* nB = has_next ? S.b_base(g, nxt) : cB;
        if constexpr (Sched::GATHER) {
            if (has_next) {
#pragma unroll
                for (int h = 0; h < 2; ++h)
#pragma unroll
                    for (int i = 0; i < 2; ++i) gnxt[h][i] = S.a_rowoff(g, nxt, h * HALF + RA[i]) + CA2[i];
            }
        }
#pragma unroll 1
        for (int t = 0; t < nt; t += 2) {
            const bool last = (t == nt - 2);
            const char* a1 = cA + (size_t)(t + 1) * kstep;
            const char* a2 = last ? nA : cA + (size_t)(t + 2) * kstep; const char* b2 = last ? nB : cB + (size_t)(t + 2) * kstep;
            const char* a3 = a2 + kstep; const char* b3 = b2 + kstep;
            unsigned g2[2][2];
            if constexpr (Sched::GATHER) {
#pragma unroll
                for (int h = 0; h < 2; ++h)
#pragma unroll
                    for (int i = 0; i < 2; ++i) g2[h][i] = last ? gnxt[h][i] : gcur[h][i];
            }
            PG8_LDB(B0, 0, 0); PG8_SCHED; PG8_LDA(At, 0, 0); PG8_STAGE_A(PG8_SA(1, 1), a1, 1, gcur);
            PG8_WAIT_L(8); PG8_BAR; PG8_WAIT_L(0); PG8_MMA(0, 0, At, B0); PG8_BAR; PG8_SCHED;
            PG8_LDB(B1, 0, 1); PG8_STAGE(PG8_SB(0, 0), b2, voffB);
            PG8_BAR; PG8_WAIT_L(0); PG8_MMA(0, 1, At, B1); PG8_BAR;
            PG8_LDA(At, 0, 1); PG8_STAGE_A(PG8_SA(0, 0), a2, 0, g2);
            PG8_BAR; PG8_WAIT_L(0); PG8_MMA(1, 0, At, B0); PG8_BAR; PG8_SCHED;
            PG8_STAGE(PG8_SB(0, 1), b2 + hstepB, voffB);
            PG8_WAIT_V(6); PG8_BAR; PG8_MMA(1, 1, At, B1); PG8_BAR;
            PG8_LDB(B0, 1, 0); PG8_SCHED; PG8_LDA(At, 1, 0); PG8_STAGE_A(PG8_SA(0, 1), a2, 1, g2);
            PG8_WAIT_L(8); PG8_BAR; PG8_WAIT_L(0); PG8_MMA(0, 0, At, B0); PG8_BAR; PG8_SCHED;
            PG8_LDB(B1, 1, 1); PG8_STAGE(PG8_SB(1, 0), b3, voffB);
            PG8_BAR; PG8_WAIT_L(0); PG8_MMA(0, 1, At, B1); PG8_BAR;
            PG8_LDA(At, 1, 1); PG8_STAGE_A(PG8_SA(1, 0), a3, 0, g2);
            PG8_BAR; PG8_WAIT_L(0); PG8_MMA(1, 0, At, B0); PG8_BAR; PG8_SCHED;
            PG8_STAGE(PG8_SB(1, 1), b3 + hstepB, voffB);
            PG8_WAIT_V(6); PG8_BAR; PG8_MMA(1, 1, At, B1); PG8_BAR;
        }
        E(acc, cur, wr, wc, fr, fq);
        if (!has_next) break;
#pragma unroll
        for (int a = 0; a < 2; ++a)
#pragma unroll
            for (int b = 0; b < 2; ++b)
#pragma unroll
                for (int m = 0; m < 4; ++m)
#pragma unroll
                    for (int n = 0; n < 2; ++n) acc[a][b][m][n] = (f32x4){0.f, 0.f, 0.f, 0.f};
        cur = nxt; cA = nA; cB = nB; ++ui;
        if constexpr (Sched::GATHER) {
#pragma unroll
            for (int h = 0; h < 2; ++h)
#pragma unroll
                for (int i = 0; i < 2; ++i) gcur[h][i] = gnxt[h][i];
        }
    }
    PG8_WAIT_V(0);
    if (wr == 0) PG8_BAR;
    PG8_BAR;
#undef PG8_SA
#undef PG8_SB
#undef PG8_STAGE
#undef PG8_STAGE_A
#undef PG8_LDA
#undef PG8_LDB
#undef PG8_MMA
#undef PG8_WAIT_V
#undef PG8_WAIT_L
#undef PG8_BAR
#undef PG8_SCHED
}

__device__ __forceinline__ f32x2 gelu_pk(f32x2 v) {
    const f32x2 av = __builtin_elementwise_abs(v), d = av * 0.2316418882f + 1.0f;
    f32x2 t; t.x = __builtin_amdgcn_rcpf(d.x); t.y = __builtin_amdgcn_rcpf(d.y);
    f32x2 q = t * 0.5307027145f + (-0.7265760135f); q = q * t + 0.7107068705f; q = q * t + (-0.142248368f); q = q * t + 0.127414796f; q = q * t;
    const f32x2 s = (v * v) * (-0.72134752044f);
    f32x2 e; e.x = __builtin_amdgcn_exp2f(s.x); e.y = __builtin_amdgcn_exp2f(s.y);
    const f32x2 m = v * (q * e), r = v - m;
    f32x2 o; o.x = v.x < 0.f ? m.x : r.x; o.y = v.y < 0.f ? m.y : r.y; return o;
}
}
using pg8::Unit;

__device__ __forceinline__ u32x4 pack8(const f32x4 v0, const f32x4 v1) { u32x4 w; w.x = cvt_pk_bf16(v0[0], v0[1]); w.y = cvt_pk_bf16(v0[2], v0[3]); w.z = cvt_pk_bf16(v1[0], v1[1]); w.w = cvt_pk_bf16(v1[2], v1[3]); return w; }

struct EpiP {
    bf16_t* P;
    __device__ __forceinline__ void operator()(const f32x4 (&acc)[2][2][4][2], const Unit& u, int wr, int wc, int fr, int fq) const {
        const int row0 = u.pm * 256 + wr * 64 + fr, col0 = u.pn * 256 + wc * 32 + 8 * fq;
        const int act = u.pn < 14 ? 0 : (u.pn < 22 ? 1 : 2);
#pragma unroll
        for (int ai = 0; ai < 2; ++ai)
#pragma unroll
            for (int m = 0; m < 4; ++m) { const int row = row0 + ai * 128 + m * 16;
#pragma unroll
                for (int bj = 0; bj < 2; ++bj) { f32x4 v0 = acc[ai][bj][m][0], v1 = acc[ai][bj][m][1];
                    if (act == 1) { f32x2 a = pg8::gelu_pk((f32x2){v0[0], v0[1]}), b = pg8::gelu_pk((f32x2){v0[2], v0[3]}), c = pg8::gelu_pk((f32x2){v1[0], v1[1]}), d = pg8::gelu_pk((f32x2){v1[2], v1[3]});
                        v0 = (f32x4){a.x, a.y, b.x, b.y}; v1 = (f32x4){c.x, c.y, d.x, d.y}; }
                    else if (act == 2) {
#pragma unroll
                        for (int j = 0; j < 4; ++j) { v0[j] = sigmoidf_(v0[j]); v1[j] = sigmoidf_(v1[j]); } }
                    *(u32x4*)(P + (size_t)row * NP + col0 + bj * 128) = pack8(v0, v1); } }
    }
};
struct EpiLora {
    float* LOGW; bf16_t* AA; bf16_t* GG; const float* w0; const float* a0;
    __device__ __forceinline__ void operator()(const f32x4 (&acc)[2][2][4][2], const Unit& u, int wr, int wc, int fr, int fq) const {
        const int row0 = u.pm * 256 + wr * 64 + fr, seg = u.pn >> 2, colt = (u.pn & 3) * 256 + wc * 32 + 8 * fq;
        const float* bsrc = seg == 0 ? w0 : a0;
        f32x4 bb[2][2];
#pragma unroll
        for (int bj = 0; bj < 2; ++bj) { bb[bj][0] = *(const f32x4*)(bsrc + colt + bj * 128); bb[bj][1] = *(const f32x4*)(bsrc + colt + bj * 128 + 4); }
#pragma unroll
        for (int ai = 0; ai < 2; ++ai)
#pragma unroll
            for (int m = 0; m < 4; ++m) { const int row = row0 + ai * 128 + m * 16;
#pragma unroll
                for (int bj = 0; bj < 2; ++bj) { f32x4 v0 = acc[ai][bj][m][0], v1 = acc[ai][bj][m][1];
                    const int col = colt + bj * 128;
                    if (seg == 0) {
#pragma unroll
                        for (int j = 0; j < 4; ++j) {
                            { const float z = bb[bj][0][j] + v0[j]; const float sp = fmaxf(-z, 0.f) + __logf(1.0f + __expf(-fabsf(z))); v0[j] = -__expf(-sp - 0.5f); }
                            { const float z = bb[bj][1][j] + v1[j]; const float sp = fmaxf(-z, 0.f) + __logf(1.0f + __expf(-fabsf(z))); v1[j] = -__expf(-sp - 0.5f); } }
                        float* o = LOGW + (size_t)row * D + col; *(f32x4*)o = v0; *(f32x4*)(o + 4) = v1;
                    } else if (seg == 1) {
#pragma unroll
                        for (int j = 0; j < 4; ++j) { v0[j] = sigmoidf_(bb[bj][0][j] + v0[j]); v1[j] = sigmoidf_(bb[bj][1][j] + v1[j]); }
                        *(u32x4*)(AA + (size_t)row * D + col) = pack8(v0, v1);
                    } else {
                        *(u32x4*)(GG + (size_t)row * D + col) = pack8(v0, v1);
                    }
                    __builtin_amdgcn_sched_barrier(0); } }
    }
};
template <int MODE> struct EpiMix {
    const bf16_t* P; float* F; bf16_t* Bo; const float* X; int ldc;
    __device__ __forceinline__ void operator()(const f32x4 (&acc)[2][2][4][2], const Unit& u, int wr, int wc, int fr, int fq) const {
        const int row0 = u.pm * 256 + wr * 64 + fr, col0 = u.pn * 256 + wc * 32 + 8 * fq;
#pragma unroll
        for (int ai = 0; ai < 2; ++ai)
#pragma unroll
            for (int m = 0; m < 4; ++m) { const int row = row0 + ai * 128 + m * 16;
#pragma unroll
                for (int bj = 0; bj < 2; ++bj) { f32x4 v0 = acc[ai][bj][m][0], v1 = acc[ai][bj][m][1];
                    const int col = col0 + bj * 128;
                    if (MODE == 0 || MODE == 1) {
                        const u32x4 gw = *(const u32x4*)(P + (size_t)row * NP + (MODE == 0 ? PC_GA : PC_GB) + col); float gf[8]; unpack8(gw, gf);
#pragma unroll
                        for (int j = 0; j < 4; ++j) { v0[j] *= gf[j]; v1[j] *= gf[4 + j]; }
                    }
                    if (MODE == 0) { float* o = F + (size_t)row * D + col; *(f32x4*)o = v0; *(f32x4*)(o + 4) = v1; }
                    if (MODE == 1) { const float* t1 = F + (size_t)row * D + col; v0 = v0 + *(const f32x4*)t1; v1 = v1 + *(const f32x4*)(t1 + 4); *(u32x4*)(Bo + (size_t)row * D + col) = pack8(v0, v1); }
                    if (MODE == 2) { const float* xr = X + (size_t)row * D + col; v0 = v0 + ALPHA * *(const f32x4*)xr; v1 = v1 + ALPHA * *(const f32x4*)(xr + 4);
                        float* o = F + (size_t)row * D + col; *(f32x4*)o = v0; *(f32x4*)(o + 4) = v1; }
                    if (MODE == 3) { float* o = F + (size_t)row * ldc + col; *(f32x4*)o = v0; *(f32x4*)(o + 4) = v1; } } }
    }
};
struct EpiAct {
    bf16_t* ACT;
    __device__ __forceinline__ void operator()(const f32x4 (&acc)[2][2][4][2], const Unit& u, int wr, int wc, int fr, int fq) const {
        const int row0 = u.pm * 256 + wr * 64 + fr, col = u.pn * 128 + wc * 32 + 8 * fq;
#pragma unroll
        for (int ai = 0; ai < 2; ++ai)
#pragma unroll
            for (int m = 0; m < 4; ++m) { const int row = row0 + ai * 128 + m * 16;
                f32x4 g0 = acc[ai][0][m][0], g1 = acc[ai][0][m][1]; const f32x4 u0 = acc[ai][1][m][0], u1 = acc[ai][1][m][1];
#pragma unroll
                for (int j = 0; j < 4; ++j) { g0[j] = g0[j] * sigmoidf_(g0[j]) * u0[j]; g1[j] = g1[j] * sigmoidf_(g1[j]) * u1[j]; }
                *(u32x4*)(ACT + (size_t)row * 256 + col) = pack8(g0, g1); }
    }
};
struct EpiDown {
    bf16_t* YR; const float* row_gate;
    __device__ __forceinline__ void operator()(const f32x4 (&acc)[2][2][4][2], const Unit& u, int wr, int wc, int fr, int fq) const {
        const int row0 = u.pm * 256 + wr * 64 + fr, col0 = u.pn * 256 + wc * 32 + 8 * fq;
#pragma unroll
        for (int ai = 0; ai < 2; ++ai)
#pragma unroll
            for (int m = 0; m < 4; ++m) { const int row = row0 + ai * 128 + m * 16; const float gt = row_gate[row];
#pragma unroll
                for (int bj = 0; bj < 2; ++bj) { const f32x4 v0 = acc[ai][bj][m][0] * gt, v1 = acc[ai][bj][m][1] * gt;
                    *(u32x4*)(YR + (size_t)row * D + col0 + bj * 128) = pack8(v0, v1); } }
    }
};

struct Args { const float* in[30]; float* out; unsigned char* ws; int ph_lo, ph_hi; };
struct Frame {
    LAS unsigned char* lds;
    int tid, lane, wave, G, gw, NGW;
    const struct Args& A; float* out; unsigned char* ws; unsigned* ctl;
};
#define WSP(T_, off) ((T_*)(F.ws + (off)))

__device__ __forceinline__ void tr_item(const float* W, int N, int k0, int n0, bf16_t* WT, int ldo, int drow0, LAS float* scr, int lane) {
#pragma unroll 8
    for (int i = 0; i < 32; ++i) { const int kk = 2 * i + (lane >> 5); scr[kk * 33 + (lane & 31)] = W[(size_t)(k0 + kk) * N + n0 + (lane & 31)]; }
    asm volatile("s_waitcnt lgkmcnt(0)" ::: "memory");
    const int c = lane & 7;
#pragma unroll
    for (int j = 0; j < 4; ++j) { const int n = (lane >> 3) + 8 * j; const LAS float* s = scr + (8 * c) * 33 + n;
        u32x4 o; o.x = cvt_pk_bf16(s[0 * 33], s[1 * 33]); o.y = cvt_pk_bf16(s[2 * 33], s[3 * 33]); o.z = cvt_pk_bf16(s[4 * 33], s[5 * 33]); o.w = cvt_pk_bf16(s[6 * 33], s[7 * 33]);
        *(u32x4*)(WT + (size_t)(drow0 + n) * ldo + k0 + 8 * c) = o; }
    asm volatile("s_waitcnt lgkmcnt(0)" ::: "memory");
}
__device__ __forceinline__ void p0_prologue(Frame& F) {
    LAS float* scr = (LAS float*)(F.lds + F.wave * 8448);
    constexpr int I_IN = 16 * 233, I_SQ = 16 * 32, I_GU = 16 * 16, I_DN = 4 * 32;
    constexpr int NITEMS = I_IN + 3 * I_SQ + 257 * I_GU + 257 * I_DN;
    for (int it = F.gw; it < NITEMS; it += F.NGW) {
        int r = it;
        if (r < I_IN) { const int kb = r / 233, nb = r % 233, n0 = nb * 32; tr_item(F.A.in[1], C_IN, kb * 64, n0, WSP(bf16_t, WS_WT_IN), D, n0 < 3360 ? n0 : n0 + 224, scr, F.lane); continue; } r -= I_IN;
        if (r < 3 * I_SQ) { const int w = r / I_SQ, q = r % I_SQ, kb = q / 32, nb = q % 32;
            tr_item(w == 0 ? F.A.in[17] : (w == 1 ? F.A.in[18] : F.A.in[19]), D, kb * 64, nb * 32, WSP(bf16_t, w == 0 ? WS_WT_OA : (w == 1 ? WS_WT_OB : WS_WT_OUT)), D, nb * 32, scr, F.lane); continue; } r -= 3 * I_SQ;
        if (r < 257 * I_GU) { const int e = r / I_GU, q = r % I_GU, kb = q / 16, nb = q % 16, n0 = nb * 32;
            const float* src = e < 256 ? F.A.in[24] + (size_t)e * 1024 * 512 : F.A.in[26];
            const int half = n0 >> 8, idx = n0 & 255, drow = (idx >> 7) * 256 + half * 128 + (idx & 127);
            tr_item(src, 512, kb * 64, n0, WSP(bf16_t, WS_WT_GU) + (size_t)e * 512 * 1024, 1024, drow, scr, F.lane); continue; } r -= 257 * I_GU;
        { const int e = r / I_DN, q = r % I_DN, kb = q / 32, nb = q % 32;
            const float* src = e < 256 ? F.A.in[25] + (size_t)e * 256 * 1024 : F.A.in[27];
            tr_item(src, 1024, kb * 64, nb * 32, WSP(bf16_t, WS_WT_DN) + (size_t)e * 1024 * 256, 256, nb * 32, scr, F.lane); }
    }
    const size_t gt = (size_t)blockIdx.x * 512 + F.tid, NT = (size_t)F.G * 512;
    { bf16_t* w = WSP(bf16_t, WS_WT_IN) + (size_t)3360 * D; for (size_t i = gt; i < (size_t)224 * D / 8; i += NT) ((u32x4*)w)[i] = (u32x4){0u, 0u, 0u, 0u}; }
    { bf16_t* w = WSP(bf16_t, WS_WT_LORA);
      for (size_t i = gt; i < (size_t)3072 * LK; i += NT) { const int n = (int)(i / LK), k = (int)(i % LK); float v = 0.f;
          if (n < 1024) { if (k < 64) v = F.A.in[4][(size_t)k * D + n]; }
          else if (n < 2048) { if (k >= 64 && k < 128) v = F.A.in[6][(size_t)(k - 64) * D + (n - 1024)]; }
          else { if (k >= 128 && k < 288) v = F.A.in[7][(size_t)(k - 128) * D + (n - 2048)]; }
          w[i] = (bf16_t)f2bf(v); } }
    { bf16_t* w = WSP(bf16_t, WS_WT_R);
      for (size_t i = gt; i < (size_t)256 * HRK; i += NT) { const int n = (int)(i / HRK), k = (int)(i % HRK), kk = k & 1023, seg = k >> 10;
          const float v = F.A.in[22][(size_t)kk * NE + n]; const unsigned hi = f2bf(v); const float lo = v - bf2f(hi);
          w[i] = (bf16_t)(seg == 2 ? f2bf(lo) : hi); } }
    { const f32x4* x = (const f32x4*)F.A.in[0]; u32x2* xb = WSP(u32x2, WS_XB);
      for (size_t i = gt; i < (size_t)T * D / 4; i += NT) { const f32x4 v = x[i]; u32x2 o; o.x = cvt_pk_bf16(v[0], v[1]); o.y = cvt_pk_bf16(v[2], v[3]); xb[i] = o; } }
}

__device__ __forceinline__ void p2_lora_in(Frame& F) {
    const bf16_t* P = WSP(bf16_t, WS_P); bf16_t* L = WSP(bf16_t, WS_LORAIN); const float* mu = F.A.in[2];
    for (int t = F.gw; t < T; t += F.NGW) {
        const bool first = (t % SEQ) == 0;
#pragma unroll
        for (int j = 0; j < 6; ++j) { const int c = F.lane + 64 * j; float v = 0.f;
            if (c < 288) { const float cur = bf2f(P[(size_t)t * NP + PC_L + c]); const float prev = first ? 0.f : bf2f(P[(size_t)(t - 1) * NP + PC_L + c]);
                const float m = cur + mu[3072 + c] * (prev - cur);
                v = c < 64 ? tanhf(m) : (c < 128 ? m : sigmoidf_(m)); }
            L[(size_t)t * LK + c] = (bf16_t)f2bf(v); }
    }
}

__device__ __forceinline__ void p2_gmlp(Frame& F) {
    const bf16_t* P = WSP(bf16_t, WS_P); bf16_t* YB = WSP(bf16_t, WS_YB);
    const float* lnw = F.A.in[13]; const float* lnb = F.A.in[14]; const float* sw = F.A.in[15]; const float* sb = F.A.in[16];
    LAS bf16_t* VT = (LAS bf16_t*)F.lds;
    LAS float* ST = (LAS float*)(F.lds + 36864);
    const int lane = F.lane, wave = F.wave, fr = lane & 15, fq = lane >> 4;
    for (int ch = blockIdx.x; ch < T / 128; ch += F.G) {
        const int t0 = ch * 128;
        for (int i = 0; i < 16; ++i) { const int tl = wave * 16 + i; const bf16_t* vr = P + (size_t)(t0 + tl) * NP + PC_GV;
            float f0[8], f1[8]; unpack8(*(const u32x4*)(vr + lane * 8), f0); unpack8(*(const u32x4*)(vr + 512 + lane * 8), f1);
            float s = 0.f;
#pragma unroll
            for (int j = 0; j < 8; ++j) s += f0[j] + f1[j];
            const float mean = wave_sum(s) * (1.f / 1024.f); float q = 0.f;
#pragma unroll
            for (int j = 0; j < 8; ++j) { const float a = f0[j] - mean, b = f1[j] - mean; q += a * a + b * b; }
            const float rstd = 1.0f / sqrtf(wave_sum(q) * (1.f / 1024.f) + LN_EPS);
            if (lane == 0) { ST[tl * 2] = mean; ST[tl * 2 + 1] = rstd; } }
        __syncthreads();
        for (int g = 0; g < 8; ++g) {
            { const int s = F.tid >> 2, d0 = (F.tid & 3) * 32; const float mean = ST[s * 2], rstd = ST[s * 2 + 1];
              const bf16_t* vr = P + (size_t)(t0 + s) * NP + PC_GV + g * 128 + d0;
#pragma unroll
              for (int q4 = 0; q4 < 4; ++q4) { float f[8]; unpack8(*(const u32x4*)(vr + q4 * 8), f);
#pragma unroll
                  for (int j = 0; j < 8; ++j) { const int d = d0 + q4 * 8 + j; const float v = (f[j] - mean) * rstd * lnw[g * 128 + d] + lnb[g * 128 + d];
                      VT[d * 136 + s] = (bf16_t)f2bf(v); } } }
            __syncthreads();
            f32x4 acc[8];
#pragma unroll
            for (int n = 0; n < 8; ++n) acc[n] = (f32x4){0.f, 0.f, 0.f, 0.f};
            const int tl = wave * 16 + fr;
            const float* wrow = sw + ((size_t)g * 128 + tl) * 128;
#pragma unroll
            for (int ks = 0; ks < 4; ++ks) {
                if (ks * 32 <= wave * 16 + 15) {
                    const int s0 = ks * 32 + fq * 8;
                    const f32x4 w0 = *(const f32x4*)(wrow + s0), w1 = *(const f32x4*)(wrow + s0 + 4);
                    float wf[8] = {w0[0], w0[1], w0[2], w0[3], w1[0], w1[1], w1[2], w1[3]};
#pragma unroll
                    for (int j = 0; j < 8; ++j) wf[j] = (s0 + j <= tl) ? wf[j] : 0.f;
                    u32x4 aw; aw.x = cvt_pk_bf16(wf[0], wf[1]); aw.y = cvt_pk_bf16(wf[2], wf[3]); aw.z = cvt_pk_bf16(wf[4], wf[5]); aw.w = cvt_pk_bf16(wf[6], wf[7]);
                    const bf16x8 af = __builtin_bit_cast(bf16x8, aw);
#pragma unroll
                    for (int n = 0; n < 8; ++n) { const bf16x8 bfrag = *(const LAS bf16x8*)(VT + (n * 16 + fr) * 136 + s0);
                        acc[n] = __builtin_amdgcn_mfma_f32_16x16x32_bf16(bfrag, af, acc[n], 0, 0, 0); }
                }
            }
            const float bias = sb[g * 128 + tl];
            const bf16_t* ur = P + (size_t)(t0 + tl) * NP + PC_U + g * 128; bf16_t* yr = YB + (size_t)(t0 + tl) * D + g * 128;
#pragma unroll
            for (int n = 0; n < 8; ++n) { const int d = n * 16 + 4 * fq; const u32x2 uw = *(const u32x2*)(ur + d);
                const float o0 = bf2f(uw.x & 0xffffu) * (acc[n][0] + bias), o1 = bf2f(uw.x >> 16) * (acc[n][1] + bias), o2 = bf2f(uw.y & 0xffffu) * (acc[n][2] + bias), o3 = bf2f(uw.y >> 16) * (acc[n][3] + bias);
                u32x2 o; o.x = cvt_pk_bf16(o0, o1); o.y = cvt_pk_bf16(o2, o3); *(u32x2*)(yr + d) = o; }
            __syncthreads();
        }
    }
}

__device__ __forceinline__ void p4_scan_seq(Frame& F) {
    if (F.wave != 0) return;
    const bf16_t* P = WSP(bf16_t, WS_P); const float* LOGW = WSP(float, WS_LOGW); const bf16_t* AA = WSP(bf16_t, WS_AA); const bf16_t* GG = WSP(bf16_t, WS_GG); bf16_t* YA = WSP(bf16_t, WS_YA);
    LAS float* V = (LAS float*)F.lds;
    const int lane = F.lane;
    for (int bh = blockIdx.x; bh < 4 * NH; bh += F.G) {
        const int b = bh / NH, h = bh % NH, c = h * HD + lane;
        const float mu_r = F.A.in[2][c], mu_k = F.A.in[2][1024 + c], mu_v = F.A.in[2][2048 + c];
        const float k_k = F.A.in[8][c], k_a = F.A.in[9][c], r_k = F.A.in[10][c], gn_w = F.A.in[11][c], gn_b = F.A.in[12][c];
        float S[64];
#pragma unroll
        for (int j = 0; j < 64; ++j) S[j] = 0.f;
        float pr = 0.f, pk = 0.f, pv = 0.f;
        const size_t row0 = (size_t)b * SEQ;
        float cr = bf2f(P[row0 * NP + PC_R + c]), ck = bf2f(P[row0 * NP + PC_K + c]), cv = bf2f(P[row0 * NP + PC_V + c]);
        float cw = LOGW[row0 * D + c], ca = bf2f(AA[row0 * D + c]), cg = bf2f(GG[row0 * D + c]);
#pragma unroll 1
        for (int t = 0; t < SEQ; ++t) {
            const size_t rown = row0 + (t + 1 < SEQ ? t + 1 : t);
            const float nr = bf2f(P[rown * NP + PC_R + c]), nk = bf2f(P[rown * NP + PC_K + c]), nv = bf2f(P[rown * NP + PC_V + c]);
            const float nw = LOGW[rown * D + c], na = bf2f(AA[rown * D + c]), ng = bf2f(GG[rown * D + c]);
            const float r = cr + mu_r * (pr - cr), k = ck + mu_k * (pk - ck), v = cv + mu_v * (pv - cv);
            pr = cr; pk = ck; pv = cv;
            const float a = ca;
            float kk = k * k_k; const float nrm = sqrtf(wave_sum(kk * kk)); kk = kk / fmaxf(nrm, 1e-12f);
            const float kp = k * (1.0f + (a - 1.0f) * k_a);
            const float w = __expf(cw);
            V[lane] = w; V[64 + lane] = -kk; V[128 + lane] = kk * a; V[192 + lane] = kp; V[256 + lane] = r;
            asm volatile("s_waitcnt lgkmcnt(0)" ::: "memory");
            float sa = 0.f;
#pragma unroll
            for (int j = 0; j < 64; j += 4) { const f32x4 av = *(const LAS f32x4*)(V + 64 + j); sa += S[j] * av[0] + S[j + 1] * av[1] + S[j + 2] * av[2] + S[j + 3] * av[3]; }
            float y = 0.f;
#pragma unroll
            for (int j = 0; j < 64; j += 4) { const f32x4 wv = *(const LAS f32x4*)(V + j), bv = *(const LAS f32x4*)(V + 128 + j), kv = *(const LAS f32x4*)(V + 192 + j), rv = *(const LAS f32x4*)(V + 256 + j);
#pragma unroll
                for (int q = 0; q < 4; ++q) { S[j + q] = S[j + q] * wv[q] + sa * bv[q] + v * kv[q]; y += S[j + q] * rv[q]; }
                if ((j & 12) == 12) asm volatile("" ::: "memory"); }
            const float mean = wave_sum(y) * (1.f / 64.f); const float dy = y - mean; const float var = wave_sum(dy * dy) * (1.f / 64.f);
            const float yn = dy * (1.0f / sqrtf(var + GN_EPS)) * gn_w + gn_b;
            const float bonus = wave_sum(r * kp * r_k) * v;
            YA[(row0 + t) * D + c] = (bf16_t)f2bf((yn + bonus) * cg);
            asm volatile("s_waitcnt lgkmcnt(0)" ::: "memory");
            cr = nr; ck = nk; cv = nv; cw = nw; ca = na; cg = ng;
        }
    }
}

__device__ __forceinline__ void p8_ln1(Frame& F) {
    const float* HP = WSP(float, WS_H1PRE); float* H1 = WSP(float, WS_H1); bf16_t* HR = WSP(bf16_t, WS_HR);
    const float* lw = F.A.in[20]; const float* lb = F.A.in[21];
    for (int t = F.gw; t < T; t += F.NGW) {
        const f32x4* xr = (const f32x4*)(HP + (size_t)t * D) + F.lane; f32x4 v[4]; float s = 0.f;
#pragma unroll
        for (int j = 0; j < 4; ++j) { v[j] = xr[64 * j]; s += (v[j][0] + v[j][1]) + (v[j][2] + v[j][3]); }
        const float mean = wave_sum(s) * (1.f / D); float q = 0.f;
#pragma unroll
        for (int j = 0; j < 4; ++j) { v[j] = v[j] - mean; q += (v[j][0] * v[j][0] + v[j][1] * v[j][1]) + (v[j][2] * v[j][2] + v[j][3] * v[j][3]); }
        const float rstd = 1.0f / sqrtf(wave_sum(q) * (1.f / D) + LN_EPS);
#pragma unroll
        for (int j = 0; j < 4; ++j) { const int col = 4 * F.lane + 256 * j; const f32x4 w = *(const f32x4*)(lw + col), bb = *(const f32x4*)(lb + col);
            const f32x4 o = v[j] * rstd * w + bb; *(f32x4*)(H1 + (size_t)t * D + col) = o;
            const unsigned h01 = cvt_pk_bf16(o[0], o[1]), h23 = cvt_pk_bf16(o[2], o[3]);
            const float l0 = o[0] - bf2f(h01 & 0xffffu), l1 = o[1] - bf2f(h01 >> 16), l2 = o[2] - bf2f(h23 & 0xffffu), l3 = o[3] - bf2f(h23 >> 16);
            u32x2 hi; hi.x = h01; hi.y = h23; u32x2 lo; lo.x = cvt_pk_bf16(l0, l1); lo.y = cvt_pk_bf16(l2, l3);
            bf16_t* hr = HR + (size_t)t * HRK + col; *(u32x2*)hr = hi; *(u32x2*)(hr + 1024) = lo; *(u32x2*)(hr + 2048) = hi; }
    }
}

__device__ __forceinline__ void p10_route(Frame& F) {
    const float* LG = WSP(float, WS_LOGITS); const float* rb = F.A.in[23];
    int* TE = WSP(int, WS_TOPE); float* TG = WSP(float, WS_TOPG); int* CNT = WSP(int, WS_CNT);
    LAS int* hist = (LAS int*)F.lds;
    if (F.tid < 256) hist[F.tid] = 0;
    __syncthreads();
    const int TPB = (T + F.G - 1) / F.G, tb = blockIdx.x * TPB, te = (tb + TPB < T) ? tb + TPB : T;
    const int lane = F.lane; const float NINF = -__builtin_inff();
    const f32x4 bias = *(const f32x4*)(rb + 4 * lane);
    for (int t = tb + F.wave; t < te; t += 8) {
        const f32x4 lg = *(const f32x4*)(LG + (size_t)t * NE + 4 * lane);
        float sc[4], chv[4];
#pragma unroll
        for (int j = 0; j < 4; ++j) { sc[j] = 1.0f / (1.0f + expf(-lg[j])); chv[j] = sc[j] + bias[j]; }
        float m1 = NINF, m2 = NINF;
#pragma unroll
        for (int j = 0; j < 4; ++j) { if (chv[j] > m1) { m2 = m1; m1 = chv[j]; } else if (chv[j] > m2) m2 = chv[j]; }
#pragma unroll
        for (int o = 1; o < 8; o <<= 1) { const float b1 = __shfl_xor(m1, o), b2 = __shfl_xor(m2, o); const float n1 = fmaxf(m1, b1), n2 = fmaxf(fminf(m1, b1), fmaxf(m2, b2)); m1 = n1; m2 = n2; }
        const float gs = m1 + m2; const int g = lane >> 3; int rank = 0;
#pragma unroll
        for (int gg = 0; gg < 8; ++gg) { const float o = __shfl(gs, gg * 8); rank += (o > gs || (o == gs && gg < g)) ? 1 : 0; }
        const bool sel = rank < 4;
#pragma unroll
        for (int j = 0; j < 4; ++j) chv[j] = sel ? chv[j] : NINF;
        int my_e = 0; float my_s = 0.f, ssum = 0.f;
#pragma unroll
        for (int k = 0; k < TOPK; ++k) {
            float bv = chv[0]; int bi = 4 * lane;
#pragma unroll
            for (int j = 1; j < 4; ++j) if (chv[j] > bv) { bv = chv[j]; bi = 4 * lane + j; }
#pragma unroll
            for (int o = 1; o < 64; o <<= 1) { const float ov = __shfl_xor(bv, o); const int oi = __shfl_xor(bi, o); if (ov > bv || (ov == bv && oi < bi)) { bv = ov; bi = oi; } }
            const int j = bi & 3; const float scs = j == 0 ? sc[0] : (j == 1 ? sc[1] : (j == 2 ? sc[2] : sc[3]));
            const float sk = __shfl(scs, bi >> 2);
            if (lane == (bi >> 2)) { if (j == 0) chv[0] = NINF; else if (j == 1) chv[1] = NINF; else if (j == 2) chv[2] = NINF; else chv[3] = NINF; }
            ssum += sk; if (lane == k) { my_e = bi; my_s = sk; }
        }
        if (lane < TOPK) { TE[(size_t)t * TOPK + lane] = my_e; TG[(size_t)t * TOPK + lane] = my_s / ssum * ROUTED_SCALE; __hip_atomic_fetch_add(&hist[my_e], 1, __ATOMIC_RELAXED, __HIP_MEMORY_SCOPE_WORKGROUP); }
    }
    __syncthreads();
    if (F.tid < 256) CNT[(size_t)blockIdx.x * NE + F.tid] = hist[F.tid];
}

__device__ __forceinline__ void p11_place(Frame& F) {
    const int* TE = WSP(int, WS_TOPE); const float* TG = WSP(float, WS_TOPG); const int* CNT = WSP(int, WS_CNT);
    int* SLOT = WSP(int, WS_SLOT); int* RT = WSP(int, WS_ROWTOK); float* RG = WSP(float, WS_ROWGATE);
    LAS int* tot = (LAS int*)F.lds; LAS int* mine = tot + 256; LAS int* start = tot + 512; LAS int* cursor = tot + 1024;
    const int b = blockIdx.x;
    if (F.tid < 256) { int s = 0, m = 0; for (int bb = 0; bb < F.G; ++bb) { const int c = CNT[(size_t)bb * NE + F.tid]; s += c; if (bb < b) m += c; } tot[F.tid] = s; mine[F.tid] = m; cursor[F.tid] = 0; }
    __syncthreads();
    if (F.tid == 0) { int s = 0; for (int e = 0; e < NE; ++e) { start[e] = s; s += (tot[e] + 255) & ~255; } start[NE] = s; start[NE + 1] = s + T; }
    __syncthreads();
    const int TPB = (T + F.G - 1) / F.G, tb = b * TPB, te = (tb + TPB < T) ? tb + TPB : T;
    for (int i = tb * TOPK + F.tid; i < te * TOPK; i += 512) { const int e = TE[i]; const int pos = __hip_atomic_fetch_add(&cursor[e], 1, __ATOMIC_RELAXED, __HIP_MEMORY_SCOPE_WORKGROUP); const int row = start[e] + mine[e] + pos;
        RT[row] = i / TOPK; RG[row] = TG[i]; SLOT[i] = row; }
    const int shb = start[NE];
    for (int t = tb + F.tid; t < te; t += 512) { RT[shb + t] = t; RG[shb + t] = 1.0f; }
    for (int e = b; e < NE; e += F.G) { for (int r = start[e] + tot[e] + F.tid; r < start[e + 1]; r += 512) { RT[r] = 0; RG[r] = 0.f; } }
    if (b == 0) {
        if (F.tid < 257) { for (int pm = start[F.tid] >> 8; pm < (start[F.tid + 1] >> 8); ++pm) F.ctl[CW_BLKE + pm] = (unsigned)F.tid; }
        if (F.tid == 0) { F.ctl[CW_NBLK] = (unsigned)(start[NE + 1] >> 8); F.ctl[CW_SHBASE] = (unsigned)shb; }
    }
}

__device__ __forceinline__ void p14_combine(Frame& F) {
    const float* H1 = WSP(float, WS_H1); const bf16_t* YR = WSP(bf16_t, WS_YR); const int* SLOT = WSP(int, WS_SLOT);
    const float* lw = F.A.in[28]; const float* lb = F.A.in[29];
    const int shb = (int)__builtin_amdgcn_readfirstlane(ld_u32_sc1(F.ctl + CW_SHBASE));
    for (int t = F.gw; t < T; t += F.NGW) {
        f32x4 v[4];
#pragma unroll
        for (int j = 0; j < 4; ++j) v[j] = ALPHA * *(const f32x4*)(H1 + (size_t)t * D + 4 * F.lane + 256 * j);
#pragma unroll
        for (int k = 0; k <= TOPK; ++k) { const int row = k < TOPK ? SLOT[(size_t)t * TOPK + k] : shb + t; const bf16_t* yr = YR + (size_t)row * D + 4 * F.lane;
#pragma unroll
            for (int j = 0; j < 4; ++j) { const u32x2 w = *(const u32x2*)(yr + 256 * j); v[j][0] += bf2f(w.x & 0xffffu); v[j][1] += bf2f(w.x >> 16); v[j][2] += bf2f(w.y & 0xffffu); v[j][3] += bf2f(w.y >> 16); } }
        float s = 0.f;
#pragma unroll
        for (int j = 0; j < 4; ++j) s += (v[j][0] + v[j][1]) + (v[j][2] + v[j][3]);
        const float mean = wave_sum(s) * (1.f / D); float q = 0.f;
#pragma unroll
        for (int j = 0; j < 4; ++j) { v[j] = v[j] - mean; q += (v[j][0] * v[j][0] + v[j][1] * v[j][1]) + (v[j][2] * v[j][2] + v[j][3] * v[j][3]); }
        const float rstd = 1.0f / sqrtf(wave_sum(q) * (1.f / D) + LN_EPS);
#pragma unroll
        for (int j = 0; j < 4; ++j) { const int col = 4 * F.lane + 256 * j; const f32x4 w = *(const f32x4*)(lw + col), bb = *(const f32x4*)(lb + col);
            *(f32x4*)(F.out + (size_t)t * D + col) = v[j] * rstd * w + bb; }
    }
}

constexpr int N_PHASES = 15;
__global__ void __launch_bounds__(512, 2) mk_fwd(Args args) {
    extern __shared__ __attribute__((aligned(16))) unsigned char lds_raw[];
    const int tid_ = threadIdx.x, wave_ = __builtin_amdgcn_readfirstlane(tid_ >> 6);
    Frame F{(LAS unsigned char*)lds_raw, tid_, tid_ & 63, wave_, (int)gridDim.x, (int)blockIdx.x * 8 + wave_, (int)gridDim.x * 8, args, args.out, args.ws, (unsigned*)(args.ws + WS_CTL)};
    volatile LAS unsigned* MISC = (volatile LAS unsigned*)(F.lds + MISC_OFF);
    for (int u = F.tid; u < (LDS_BYTES - RING_BYTES) / 4; u += 512) ((LAS unsigned*)(F.lds + RING_BYTES))[u] = 0u;
    __syncthreads();
    XcdBarrier bar; bar.bar = F.ctl + CW_BAR; bar.x = 0; bar.st = nullptr;
    if (!MK_SPLIT) bar = xcd_barrier_post(F.ctl + CW_BAR, MISC + 8);
    const int lo = args.ph_lo, hi = args.ph_hi;
#ifndef PH_MASK
#define PH_MASK 0x7fff
#endif
#define IN(k) (((PH_MASK >> (k)) & 1) && lo <= (k) && (k) < hi)
#define SEAM(k) do { if (IN(k) && IN((k) + 1)) xcd_barrier(bar); } while (0)

    if (IN(0)) { p0_prologue(F); } SEAM(0);
    if (IN(1)) { pg8::Gemm g{WSP(bf16_t, WS_XB), WSP(bf16_t, WS_WT_IN), D, D, D}; pg8::StaticOrder S; S.init(T, NP, F.G, (int)blockIdx.x);
        EpiP E{WSP(bf16_t, WS_P)}; pg8::gemm_phase(F.lds, g, S, E); } SEAM(1);
    if (IN(2)) { p2_lora_in(F); p2_gmlp(F); } SEAM(2);
    if (IN(3)) { pg8::Gemm g{WSP(bf16_t, WS_LORAIN), WSP(bf16_t, WS_WT_LORA), LK, LK, LK}; pg8::StaticOrder S; S.init(T, 3072, F.G, (int)blockIdx.x);
        EpiLora E{WSP(float, WS_LOGW), WSP(bf16_t, WS_AA), WSP(bf16_t, WS_GG), F.A.in[3], F.A.in[5]}; pg8::gemm_phase(F.lds, g, S, E); } SEAM(3);
    if (IN(4)) { p4_scan_seq(F); } SEAM(4);
    if (IN(5)) { pg8::Gemm g{WSP(bf16_t, WS_YA), WSP(bf16_t, WS_WT_OA), D, D, D}; pg8::StaticOrder S; S.init(T, D, F.G, (int)blockIdx.x);
        EpiMix<0> E{WSP(bf16_t, WS_P), WSP(float, WS_T1), nullptr, nullptr, D}; pg8::gemm_phase(F.lds, g, S, E); } SEAM(5);
    if (IN(6)) { pg8::Gemm g{WSP(bf16_t, WS_YB), WSP(bf16_t, WS_WT_OB), D, D, D}; pg8::StaticOrder S; S.init(T, D, F.G, (int)blockIdx.x);
        EpiMix<1> E{WSP(bf16_t, WS_P), WSP(float, WS_T1), WSP(bf16_t, WS_MIXIN), nullptr, D}; pg8::gemm_phase(F.lds, g, S, E); } SEAM(6);
    if (IN(7)) { pg8::Gemm g{WSP(bf16_t, WS_MIXIN), WSP(bf16_t, WS_WT_OUT), D, D, D}; pg8::StaticOrder S; S.init(T, D, F.G, (int)blockIdx.x);
        EpiMix<2> E{nullptr, WSP(float, WS_H1PRE), nullptr, F.A.in[0], D}; pg8::gemm_phase(F.lds, g, S, E); } SEAM(7);
    if (IN(8)) { p8_ln1(F); } SEAM(8);
    if (IN(9)) { pg8::Gemm g{WSP(bf16_t, WS_HR), WSP(bf16_t, WS_WT_R), HRK, HRK, HRK}; pg8::StaticOrder S; S.init(T, NE, F.G, (int)blockIdx.x);
        EpiMix<3> E{nullptr, WSP(float, WS_LOGITS), nullptr, nullptr, NE}; pg8::gemm_phase(F.lds, g, S, E); } SEAM(9);
    if (IN(10)) { p10_route(F); } SEAM(10);
    if (IN(11)) { p11_place(F); } SEAM(11);
    if (IN(12)) { pg8::Gemm g{WSP(bf16_t, WS_HR), WSP(bf16_t, WS_WT_GU), D, HRK, D};
        pg8::GroupedOrder<true> S{F.ctl + CW_BLKE, WSP(int, WS_ROWTOK), (int)__builtin_amdgcn_readfirstlane(ld_u32_sc1(F.ctl + CW_NBLK)), 2, F.G, (int)blockIdx.x, (size_t)512 * 1024 * 2};
        EpiAct E{WSP(bf16_t, WS_ACT)}; pg8::gemm_phase(F.lds, g, S, E); } SEAM(12);
    if (IN(13)) { pg8::Gemm g{WSP(bf16_t, WS_ACT), WSP(bf16_t, WS_WT_DN), 256, 256, 256};
        pg8::GroupedOrder<false> S{F.ctl + CW_BLKE, WSP(int, WS_ROWTOK), (int)__builtin_amdgcn_readfirstlane(ld_u32_sc1(F.ctl + CW_NBLK)), 4, F.G, (int)blockIdx.x, (size_t)1024 * 256 * 2};
        EpiDown E{WSP(bf16_t, WS_YR), WSP(float, WS_ROWGATE)}; pg8::gemm_phase(F.lds, g, S, E); } SEAM(13);
    if (IN(14)) { p14_combine(F); }
#undef IN
#undef SEAM
}

extern "C" void kernel_launch(void* const* d_in, const int* in_sizes, int n_in, void* d_out, int out_size, void* d_ws, size_t ws_size, hipStream_t stream) {
    static int grid = 0;
    if (grid == 0) {
        if (n_in != 30 || out_size != T * D || ws_size < WS_END) { fprintf(stderr, "kernel_launch: unexpected shapes: n_in %d out %d ws %zu (need %zu)\n", n_in, out_size, ws_size, (size_t)WS_END); grid = -1; return; }
        int dev = 0, cus = 0, per_cu = 0;
        if (hipGetDevice(&dev) != hipSuccess || hipDeviceGetAttribute(&cus, hipDeviceAttributeMultiprocessorCount, dev) != hipSuccess) { grid = -1; return; }
        if (hipFuncSetAttribute((const void*)mk_fwd, hipFuncAttributeMaxDynamicSharedMemorySize, LDS_BYTES) != hipSuccess) { fprintf(stderr, "kernel_launch: hipFuncSetAttribute failed\n"); grid = -1; return; }
        if (hipOccupancyMaxActiveBlocksPerMultiprocessor(&per_cu, (const void*)mk_fwd, 512, LDS_BYTES) != hipSuccess || per_cu < 1) { fprintf(stderr, "kernel_launch: occupancy query says %d\n", per_cu); }
        (void)hipGetLastError();
        grid = cus;
        if (grid > 1024) grid = 1024;
    }
    if (grid < 0) return;
    (void)hipMemsetAsync((char*)d_ws + WS_CTL, 0, CTL_ZERO_BYTES, stream);
    Args a{};
    for (int i = 0; i < 30; ++i) a.in[i] = (const float*)d_in[i];
    a.out = (float*)d_out; a.ws = (unsigned char*)d_ws;
#if MK_SPLIT
    for (int p = 0; p < N_PHASES; ++p) { a.ph_lo = p; a.ph_hi = p + 1; hipLaunchKernelGGL(mk_fwd, dim3(grid), dim3(512), LDS_BYTES, stream, a); }
#else
    a.ph_lo = 0; a.ph_hi = N_PHASES; hipLaunchKernelGGL(mk_fwd, dim3(grid), dim3(512), LDS_BYTES, stream, a);
#endif
}
```

```cpp
#include <hip/hip_runtime.h>
#include <cstdio>
#include <cstdint>

#ifndef MK_SPLIT
#define MK_SPLIT 0
#endif

#define LAS __attribute__((address_space(3)))
#define GAS __attribute__((address_space(1)))
typedef unsigned short bf16_t;
typedef short bf16x8 __attribute__((ext_vector_type(8)));
typedef float f32x4 __attribute__((ext_vector_type(4)));
typedef float f32x2 __attribute__((ext_vector_type(2)));
typedef unsigned u32x4 __attribute__((ext_vector_type(4)));
typedef unsigned u32x2 __attribute__((ext_vector_type(2)));

constexpr int T = 32768, D = 1024, SEQ = 8192, NH = 16, HD = 64;
constexpr int C_IN = 7456, NP = 7680;
constexpr int PC_R = 0, PC_K = 1024, PC_V = 2048, PC_L = 3072, PC_U = 3584, PC_GV = 4608, PC_GA = 5632, PC_GB = 6656;
constexpr int NE = 256, TOPK = 8;
constexpr int LK = 384;
constexpr int RMAX = 360448;
constexpr int HRK = 3072;
constexpr float LN_EPS = 1e-5f, GN_EPS = 64e-5f;
constexpr float ALPHA = 1.189207115002721f;
constexpr float ROUTED_SCALE = 2.5f;

constexpr size_t MiB = 1u << 20;
constexpr size_t WS_CTL = 0, CTL_ZERO_BYTES = 1 * MiB;
constexpr size_t WS_WT_IN = 2 * MiB;
constexpr size_t WS_WT_LORA = 17 * MiB;
constexpr size_t WS_WT_OA = 20 * MiB, WS_WT_OB = 22 * MiB, WS_WT_OUT = 24 * MiB;
constexpr size_t WS_WT_R = 26 * MiB;
constexpr size_t WS_WT_GU = 28 * MiB;
constexpr size_t WS_WT_DN = 285 * MiB;
constexpr size_t WS_H1 = 414 * MiB;
constexpr size_t WS_HR = 542 * MiB;
constexpr size_t WS_LOGITS = 734 * MiB;
constexpr size_t WS_TOPE = 766 * MiB;
constexpr size_t WS_TOPG = 767 * MiB;
constexpr size_t WS_SLOT = 768 * MiB;
constexpr size_t WS_CNT = 769 * MiB;
constexpr size_t WS_ROWTOK = 770 * MiB;
constexpr size_t WS_ROWGATE = 772 * MiB;
constexpr size_t WS_XB = 774 * MiB;
constexpr size_t WS_P = 838 * MiB;
constexpr size_t WS_LORAIN = 1318 * MiB;
constexpr size_t WS_LOGW = 1342 * MiB;
constexpr size_t WS_AA = 1470 * MiB;
constexpr size_t WS_GG = 1534 * MiB;
constexpr size_t WS_YA = 1598 * MiB;
constexpr size_t WS_YB = 1662 * MiB;
constexpr size_t WS_T1 = 1726 * MiB;
constexpr size_t WS_MIXIN = 1854 * MiB;
constexpr size_t WS_H1PRE = 1918 * MiB;
constexpr size_t WS_END = 2046 * MiB;
constexpr size_t WS_ACT = 774 * MiB;
constexpr size_t WS_YR = 950 * MiB;
constexpr size_t WS_PT = WS_XB;
constexpr size_t WS_QQ = WS_T1;
constexpr size_t WS_SC = WS_T1 + 64 * MiB;
constexpr size_t WS_RH = WS_MIXIN;
constexpr size_t WS_Y0 = WS_H1PRE;
constexpr size_t WS_BV = WS_H1PRE + 64 * MiB;
static_assert(WS_ACT + (size_t)RMAX * 256 * 2 <= WS_YR && WS_YR + (size_t)RMAX * 1024 * 2 <= WS_END, "moe overlay");
static_assert(WS_WT_GU + (size_t)257 * 512 * 1024 * 2 <= WS_WT_DN && WS_WT_DN + (size_t)257 * 1024 * 256 * 2 <= WS_H1, "weights");
static_assert(WS_ROWGATE + (size_t)RMAX * 4 <= WS_XB && WS_ROWTOK + (size_t)RMAX * 4 <= WS_ROWGATE, "routing");
constexpr int CW_NBLK = 16;
constexpr int CW_SHBASE = 17;
constexpr int CW_BLKE = 1024;
constexpr int CW_BAR = 8192;
static_assert((CW_BAR + 3456) * 4 <= (int)CTL_ZERO_BYTES, "ctl");

constexpr int RING_BYTES = 131072;
constexpr int LDS_BYTES = 147456;
constexpr int MISC_OFF = LDS_BYTES - 512;

__device__ __forceinline__ float bf2f(unsigned b) { return __uint_as_float(b << 16); }
typedef __bf16 bf16v2_t __attribute__((ext_vector_type(2)));
__device__ __forceinline__ unsigned cvt_pk_bf16(float lo, float hi) { const f32x2 v = {lo, hi}; const bf16v2_t b = __builtin_convertvector(v, bf16v2_t); return __builtin_bit_cast(unsigned, b); }
__device__ __forceinline__ unsigned f2bf(float f) { return cvt_pk_bf16(f, 0.f) & 0xffffu; }
__device__ __forceinline__ float wave_sum(float v) {
#pragma unroll
    for (int o = 1; o < 64; o <<= 1) v += __shfl_xor(v, o);
    return v;
}
__device__ __forceinline__ float sigmoidf_(float x) { return 1.0f / (1.0f + __expf(-x)); }
__device__ __forceinline__ void unpack8(const u32x4 w, float (&f)[8]) {
    f[0] = bf2f(w.x & 0xffffu); f[1] = bf2f(w.x >> 16); f[2] = bf2f(w.y & 0xffffu); f[3] = bf2f(w.y >> 16);
    f[4] = bf2f(w.z & 0xffffu); f[5] = bf2f(w.z >> 16); f[6] = bf2f(w.w & 0xffffu); f[7] = bf2f(w.w >> 16);
}
__device__ __forceinline__ unsigned ld_u32_sc1(const unsigned* p) { return __hip_atomic_load(p, __ATOMIC_RELAXED, __HIP_MEMORY_SCOPE_AGENT); }

#define XB_TMO      128
#define XB_XCNT(j)  (256  + 64 * (j))
#define XB_XSUB(j)  (1280 + 64 * (j))
#define XB_XGEN(j)  (2304 + 64 * (j))
#define XB_TOP      3328
#define XB_TOPGEN   3392
#define XCD_BAR_WORDS 3456
#define XB_SPIN_CAP (1u << 18)
__device__ __forceinline__ unsigned xb_ld(unsigned* p)              { return __hip_atomic_load(p, __ATOMIC_RELAXED, __HIP_MEMORY_SCOPE_AGENT); }
__device__ __forceinline__ unsigned xb_add(unsigned* p, unsigned v) { return __hip_atomic_fetch_add(p, v, __ATOMIC_RELAXED, __HIP_MEMORY_SCOPE_AGENT); }
__device__ __forceinline__ unsigned xb_xcc_id() { return (unsigned)__builtin_amdgcn_s_getreg((3 << 11) | 20) & 0xFu; }
#define XB_SPIN(cond, bar) do { unsigned _sp = 0; while (cond) { __builtin_amdgcn_s_sleep(1); \
    if ((++_sp & 255u) == 0u) { if (xb_ld(&(bar)[XB_TMO])) break; if (_sp > XB_SPIN_CAP) { atomicAdd(&(bar)[XB_TMO], 1u); break; } } } } while (0)
struct XcdBarrier { unsigned* bar; unsigned x; volatile LAS unsigned* st; };
__device__ __forceinline__ XcdBarrier xcd_barrier_post(unsigned* bar, volatile LAS unsigned* st) {
    XcdBarrier b; b.bar = bar; b.x = xb_xcc_id(); b.st = st;
    if (threadIdx.x == 0) (void)xb_add(&bar[XB_XCNT(b.x)], 1u);
    return b;
}
__device__ __forceinline__ void xcd_barrier_complete(unsigned* bar, unsigned x, unsigned& nloc, unsigned& nx) {
    const unsigned G = gridDim.x * gridDim.y * gridDim.z;
    unsigned sum, cnt, mine, sp = 0u;
    for (;;) {
        sum = 0u; cnt = 0u; mine = 0u;
#pragma unroll
        for (unsigned j = 0; j < 16; ++j) { const unsigned c = xb_ld(&bar[XB_XCNT(j)]); sum += c; cnt += (c > 0u) ? 1u : 0u; mine = (j == x) ? c : mine; }
        if (sum == G) break;
        __builtin_amdgcn_s_sleep(1);
        if ((++sp & 255u) == 0u) { if (xb_ld(&bar[XB_TMO])) break; if (sp > XB_SPIN_CAP) { atomicAdd(&bar[XB_TMO], 1u); break; } }
    }
    nloc = mine > 0u ? mine : 1u; nx = cnt > 0u ? cnt : 1u;
}
__device__ __forceinline__ void xcd_barrier(const XcdBarrier& b) {
    asm volatile("s_waitcnt vmcnt(0)" ::: "memory");
    __syncthreads();
    if (threadIdx.x == 0) {
        unsigned* bar = b.bar;
        __builtin_amdgcn_s_waitcnt(0);
        unsigned nloc = b.st[0], nx = b.st[1];
        if (nloc == 0u) { xcd_barrier_complete(bar, b.x, nloc, nx); b.st[0] = nloc; b.st[1] = nx; }
        const unsigned old = xb_add(&bar[XB_XSUB(b.x)], 1u);
        const unsigned gen = old / nloc;
        if (old + 1u == (gen + 1u) * nloc) {
            __builtin_amdgcn_fence(__ATOMIC_RELEASE, "agent");
            asm volatile("s_waitcnt vmcnt(0)" ::: "memory");
            const unsigned og = xb_add(&bar[XB_TOP], 1u);
            const unsigned tg = og / nx;
            if (og + 1u == (tg + 1u) * nx) xb_add(&bar[XB_TOPGEN], 1u);
            else XB_SPIN(xb_ld(&bar[XB_TOPGEN]) == tg, bar);
            __builtin_amdgcn_fence(__ATOMIC_ACQUIRE, "agent");
            xb_add(&bar[XB_XGEN(b.x)], 1u);
            asm volatile("s_waitcnt vmcnt(0)" ::: "memory");
        } else {
            XB_SPIN(xb_ld(&bar[XB_XGEN(b.x)]) == gen, bar);
            __builtin_amdgcn_fence(__ATOMIC_ACQUIRE, "agent");
            asm volatile("s_waitcnt vmcnt(0)" ::: "memory");
        }
    }
    __syncthreads();
}

namespace pg8 {
constexpr int BM = 256, BK = 64, HALF = 128, HTB = HALF * BK * 2, STAGE_BYTES = 8 * HTB, NXCD = 8, WGM = 8;
__host__ __device__ __forceinline__ int lds_byte(int r, int c) { const int st = (r >> 4) * 2 + (c >> 5), rr = r & 15, cc = c & 31, ob = rr * 64 + cc * 2; return st * 1024 + (ob ^ (((ob >> 9) & 1) << 5)); }
__host__ __device__ __forceinline__ void stage_rc(int b, int& R, int& C) { const int st = b / 1024, sb = b % 1024, swz = sb ^ (((sb >> 9) & 1) << 5); R = (st >> 1) * 16 + swz / 64; C = (st & 1) * 32 + (swz % 64) / 2; }
__host__ __device__ __forceinline__ int perm32(int rho) { const int n = rho >> 4, i = rho & 15; return 8 * (i >> 2) + 4 * n + (i & 3); }

struct Unit { int pm, pn, aux; };
struct Gemm { const bf16_t* A; const bf16_t* Bt; int K, lda, ldb; };

struct StaticOrder {
    static constexpr bool GATHER = false;
    int nM, nN, nwg, G, c;
    __device__ void init(int M, int N, int G_, int c_) { nM = M / BM; nN = N / BM; nwg = nM * nN; G = G_; c = c_; }
    __device__ bool next(int i, Unit& u) const {
        const long L = (long)i * G + c; if (L >= nwg) return false;
        int wgid = (int)L; { const int q = nwg / NXCD, r = nwg % NXCD, xcd = wgid % NXCD, off = wgid / NXCD; wgid = (xcd < r ? xcd * (q + 1) : r * (q + 1) + (xcd - r) * q) + off; }
        const int nig = WGM * nN, gid = wgid / nig, fm = gid * WGM, gsz = (nM - fm) < WGM ? (nM - fm) : WGM;
        u.pm = fm + ((wgid % nig) % gsz); u.pn = (wgid % nig) / gsz; u.aux = 0; return true;
    }
    __device__ __forceinline__ const char* a_base(const Gemm& g, const Unit& u) const { return (const char*)g.A + (size_t)u.pm * BM * g.lda * 2; }
    __device__ __forceinline__ const char* b_base(const Gemm& g, const Unit& u) const { return (const char*)g.Bt + (size_t)u.pn * BM * g.ldb * 2; }
    __device__ __forceinline__ unsigned a_rowoff(const Gemm&, const Unit&, int) const { return 0u; }
};
template <bool GATH> struct GroupedOrder {
    static constexpr bool GATHER = GATH;
    const unsigned* blk_e; const int* row_tok; int nblk, nN, G, c; size_t wstride;
    __device__ bool next(int i, Unit& u) const {
        const long L = (long)i * G + c; if (L >= (long)nblk * nN) return false;
        u.pm = (int)(L / nN); u.pn = (int)(L % nN);
        u.aux = (int)__builtin_amdgcn_readfirstlane(ld_u32_sc1(blk_e + u.pm)); return true;
    }
    __device__ __forceinline__ const char* a_base(const Gemm& g, const Unit& u) const { return (const char*)g.A + (size_t)u.pm * BM * g.lda * 2; }
    __device__ __forceinline__ const char* b_base(const Gemm& g, const Unit& u) const { return (const char*)g.Bt + (size_t)u.aux * wstride + (size_t)u.pn * BM * g.ldb * 2; }
    __device__ __forceinline__ unsigned a_rowoff(const Gemm& g, const Unit& u, int r) const { return (unsigned)row_tok[u.pm * BM + r] * (unsigned)(g.lda * 2); }
};

template <class Epi, class Sched>
__device__ __forceinline__ void gemm_phase(LAS unsigned char* lds, const Gemm g, const Sched& S, const Epi& E) {
    int tid_o = threadIdx.x; asm volatile("" : "+v"(tid_o));
    const int tid = tid_o, wid = __builtin_amdgcn_readfirstlane(tid >> 6), lane = tid & 63, wr = wid >> 2, wc = wid & 3, fr = lane & 15, fq = lane >> 4;
    const int K = g.K, nt = K / BK;
    unsigned voffA[2], voffB[2]; int RA[2]; unsigned CA2[2];
#pragma unroll
    for (int i = 0; i < 2; ++i) { int R, C; stage_rc(tid * 16 + i * 8192, R, C); const int Rb = (R & ~31) + perm32(R & 31);
        voffA[i] = (unsigned)(R * g.lda + C) * 2u; voffB[i] = (unsigned)(Rb * g.ldb + C) * 2u; RA[i] = R; CA2[i] = (unsigned)C * 2u; }
    const size_t kstep = (size_t)(BK * 2);
    const size_t hstepA = (size_t)HALF * g.lda * 2, hstepB = (size_t)HALF * g.ldb * 2;
    const unsigned ldsw = (unsigned)wid * 1024u;
    const int aoff = lds_byte(wr * 64 + fr, fq * 8), boff = lds_byte(wc * 32 + fr, fq * 8);
#define PG8_SA(b, h) (((b) * 2 + (h)) * HTB)
#define PG8_SB(b, h) ((4 + (b) * 2 + (h)) * HTB)
#define PG8_STAGE(bufoff, gbase, voff) do { _Pragma("unroll") for (int _i = 0; _i < 2; ++_i) \
        __builtin_amdgcn_global_load_lds((const unsigned*)((const char*)(gbase) + (voff)[_i]), (LAS unsigned*)(lds + (bufoff) + ldsw + _i * 8192), 16, 0, 0); } while (0)
#define PG8_LDA(dst, b, h) do { _Pragma("unroll") for (int m = 0; m < 4; ++m) _Pragma("unroll") for (int k = 0; k < 2; ++k) dst[m][k] = *(const LAS bf16x8*)(lds + PG8_SA(b, h) + aoff + m * 2048 + k * 1024); } while (0)
#define PG8_LDB(dst, b, h) do { _Pragma("unroll") for (int n = 0; n < 2; ++n) _Pragma("unroll") for (int k = 0; k < 2; ++k) dst[n][k] = *(const LAS bf16x8*)(lds + PG8_SB(b, h) + boff + n * 2048 + k * 1024); } while (0)
#define PG8_MMA(ai, bj, At, Bt) do { __builtin_amdgcn_s_setprio(1); _Pragma("unroll") for (int m = 0; m < 4; ++m) _Pragma("unroll") for (int n = 0; n < 2; ++n) _Pragma("unroll") for (int k = 0; k < 2; ++k) \
        acc[ai][bj][m][n] = __builtin_amdgcn_mfma_f32_16x16x32_bf16(Bt[n][k], At[m][k], acc[ai][bj][m][n], 0, 0, 0); __builtin_amdgcn_s_setprio(0); } while (0)
#define PG8_WAIT_V(n) asm volatile("s_waitcnt vmcnt(" #n ")" ::: "memory")
#define PG8_WAIT_L(n) asm volatile("s_waitcnt lgkmcnt(" #n ")" ::: "memory")
#define PG8_BAR __builtin_amdgcn_s_barrier()
#define PG8_SCHED __builtin_amdgcn_sched_barrier(0)
    Unit cur, nxt; int ui = 0;
    if (!S.next(0, cur)) return;
    f32x4 acc[2][2][4][2];
#pragma unroll
    for (int a = 0; a < 2; ++a)
#pragma unroll
        for (int b = 0; b < 2; ++b)
#pragma unroll
            for (int m = 0; m < 4; ++m)
#pragma unroll
                for (int n = 0; n < 2; ++n) acc[a][b][m][n] = (f32x4){0.f, 0.f, 0.f, 0.f};
    bf16x8 At[4][2], B0[2][2], B1[2][2];
    unsigned gcur[2][2], gnxt[2][2];
    const char* cA = Sched::GATHER ? (const char*)g.A : S.a_base(g, cur); const char* cB = S.b_base(g, cur);
    if constexpr (Sched::GATHER) {
#pragma unroll
        for (int h = 0; h < 2; ++h)
#pragma unroll
            for (int i = 0; i < 2; ++i) { gcur[h][i] = S.a_rowoff(g, cur, h * HALF + RA[i]) + CA2[i]; gnxt[h][i] = gcur[h][i]; }
    }
#define PG8_STAGE_A(bufoff, base, h, GO) do { if constexpr (Sched::GATHER) { PG8_STAGE(bufoff, base, GO[h]); } else { PG8_STAGE(bufoff, (base) + (h) * hstepA, voffA); } } while (0)
    PG8_STAGE(PG8_SB(0, 0), cB, voffB); PG8_STAGE_A(PG8_SA(0, 0), cA, 0, gcur); PG8_STAGE(PG8_SB(0, 1), cB + hstepB, voffB); PG8_STAGE_A(PG8_SA(0, 1), cA, 1, gcur);
    if (wr == 1) PG8_BAR;
    PG8_WAIT_V(4); PG8_BAR;
    PG8_STAGE(PG8_SB(1, 0), cB + kstep, voffB); PG8_STAGE_A(PG8_SA(1, 0), cA + kstep, 0, gcur); PG8_STAGE(PG8_SB(1, 1), cB + hstepB + kstep, voffB);
    PG8_WAIT_V(6); PG8_BAR;
    for (;;) {
        const bool has_next = S.next(ui + 1, nxt);
        const char* nA = has_next ? (Sched::GATHER ? (const char*)g.A : S.a_base(g, nxt)) : cA; const char* nB = has_next ? S.b_base(g, nxt) : cB;
        if constexpr (Sched::GATHER) {
            if (has_next) {
#pragma unroll
                for (int h = 0; h < 2; ++h)
#pragma unroll
                    for (int i = 0; i < 2; ++i) gnxt[h][i] = S.a_rowoff(g, nxt, h * HALF + RA[i]) + CA2[i];
            }
        }
#pragma unroll 1
        for (int t = 0; t < nt; t += 2) {
            const bool last = (t == nt - 2);
            const char* a1 = cA + (size_t)(t + 1) * kstep;
            const char* a2 = last ? nA : cA + (size_t)(t + 2) * kstep; const char* b2 = last ? nB : cB + (size_t)(t + 2) * kstep;
            const char* a3 = a2 + kstep; const char* b3 = b2 + kstep;
            unsigned g2[2][2];
            if constexpr (Sched::GATHER) {
#pragma unroll
                for (int h = 0; h < 2; ++h)
#pragma unroll
                    for (int i = 0; i < 2; ++i) g2[h][i] = last ? gnxt[h][i] : gcur[h][i];
            }
            PG8_LDB(B0, 0, 0); PG8_SCHED; PG8_LDA(At, 0, 0); PG8_STAGE_A(PG8_SA(1, 1), a1, 1, gcur);
            PG8_WAIT_L(8); PG8_BAR; PG8_WAIT_L(0); PG8_MMA(0, 0, At, B0); PG8_BAR; PG8_SCHED;
            PG8_LDB(B1, 0, 1); PG8_STAGE(PG8_SB(0, 0), b2, voffB);
            PG8_BAR; PG8_WAIT_L(0); PG8_MMA(0, 1, At, B1); PG8_BAR;
            PG8_LDA(At, 0, 1); PG8_STAGE_A(PG8_SA(0, 0), a2, 0, g2);
            PG8_BAR; PG8_WAIT_L(0); PG8_MMA(1, 0, At, B0); PG8_BAR; PG8_SCHED;
            PG8_STAGE(PG8_SB(0, 1), b2 + hstepB, voffB);
            PG8_WAIT_V(6); PG8_BAR; PG8_MMA(1, 1, At, B1); PG8_BAR;
            PG8_LDB(B0, 1, 0); PG8_SCHED; PG8_LDA(At, 1, 0); PG8_STAGE_A(PG8_SA(0, 1), a2, 1, g2);
            PG8_WAIT_L(8); PG8_BAR; PG8_WAIT_L(0); PG8_MMA(0, 0, At, B0); PG8_BAR; PG8_SCHED;
            PG8_LDB(B1, 1, 1); PG8_STAGE(PG8_SB(1, 0), b3, voffB);
            PG8_BAR; PG8_WAIT_L(0); PG8_MMA(0, 1, At, B1); PG8_BAR;
            PG8_LDA(At, 1, 1); PG8_STAGE_A(PG8_SA(1, 0), a3, 0, g2);
            PG8_BAR; PG8_WAIT_L(0); PG8_MMA(1, 0, At, B0); PG8_BAR; PG8_SCHED;
            PG8_STAGE(PG8_SB(1, 1), b3 + hstepB, voffB);
            PG8_WAIT_V(6); PG8_BAR; PG8_MMA(1, 1, At, B1); PG8_BAR;
        }
        E(acc, cur, wr, wc, fr, fq);
        if (!has_next) break;
#pragma unroll
        for (int a = 0; a < 2; ++a)
#pragma unroll
            for (int b = 0; b < 2; ++b)
#pragma unroll
                for (int m = 0; m < 4; ++m)
#pragma unroll
                    for (int n = 0; n < 2; ++n) acc[a][b][m][n] = (f32x4){0.f, 0.f, 0.f, 0.f};
        cur = nxt; cA = nA; cB = nB; ++ui;
        if constexpr (Sched::GATHER) {
#pragma unroll
            for (int h = 0; h < 2; ++h)
#pragma unroll
                for (int i = 0; i < 2; ++i) gcur[h][i] = gnxt[h][i];
        }
    }
    PG8_WAIT_V(0);
    if (wr == 0) PG8_BAR;
    PG8_BAR;
#undef PG8_SA
#undef PG8_SB
#undef PG8_STAGE
#undef PG8_STAGE_A
#undef PG8_LDA
#undef PG8_LDB
#undef PG8_MMA
#undef PG8_WAIT_V
#undef PG8_WAIT_L
#undef PG8_BAR
#undef PG8_SCHED
}

__device__ __forceinline__ f32x2 gelu_pk(f32x2 v) {
    const f32x2 av = __builtin_elementwise_abs(v), d = av * 0.2316418882f + 1.0f;
    f32x2 t; t.x = __builtin_amdgcn_rcpf(d.x); t.y = __builtin_amdgcn_rcpf(d.y);
    f32x2 q = t * 0.5307027145f + (-0.7265760135f); q = q * t + 0.7107068705f; q = q * t + (-0.142248368f); q = q * t + 0.127414796f; q = q * t;
    const f32x2 s = (v * v) * (-0.72134752044f);
    f32x2 e; e.x = __builtin_amdgcn_exp2f(s.x); e.y = __builtin_amdgcn_exp2f(s.y);
    const f32x2 m = v * (q * e), r = v - m;
    f32x2 o; o.x = v.x < 0.f ? m.x : r.x; o.y = v.y < 0.f ? m.y : r.y; return o;
}
}
using pg8::Unit;

__device__ __forceinline__ u32x4 pack8(const f32x4 v0, const f32x4 v1) { u32x4 w; w.x = cvt_pk_bf16(v0[0], v0[1]); w.y = cvt_pk_bf16(v0[2], v0[3]); w.z = cvt_pk_bf16(v1[0], v1[1]); w.w = cvt_pk_bf16(v1[2], v1[3]); return w; }

struct EpiP {
    bf16_t* P;
    __device__ __forceinline__ void operator()(const f32x4 (&acc)[2][2][4][2], const Unit& u, int wr, int wc, int fr, int fq) const {
        const int row0 = u.pm * 256 + wr * 64 + fr, col0 = u.pn * 256 + wc * 32 + 8 * fq;
        const int act = u.pn < 14 ? 0 : (u.pn < 22 ? 1 : 2);
#pragma unroll
        for (int ai = 0; ai < 2; ++ai)
#pragma unroll
            for (int m = 0; m < 4; ++m) { const int row = row0 + ai * 128 + m * 16;
#pragma unroll
                for (int bj = 0; bj < 2; ++bj) { f32x4 v0 = acc[ai][bj][m][0], v1 = acc[ai][bj][m][1];
                    if (act == 1) { f32x2 a = pg8::gelu_pk((f32x2){v0[0], v0[1]}), b = pg8::gelu_pk((f32x2){v0[2], v0[3]}), c = pg8::gelu_pk((f32x2){v1[0], v1[1]}), d = pg8::gelu_pk((f32x2){v1[2], v1[3]});
                        v0 = (f32x4){a.x, a.y, b.x, b.y}; v1 = (f32x4){c.x, c.y, d.x, d.y}; }
                    else if (act == 2) {
#pragma unroll
                        for (int j = 0; j < 4; ++j) { v0[j] = sigmoidf_(v0[j]); v1[j] = sigmoidf_(v1[j]); } }
                    *(u32x4*)(P + (size_t)row * NP + col0 + bj * 128) = pack8(v0, v1); } }
    }
};
struct EpiLora {
    float* LOGW; bf16_t* AA; bf16_t* GG; const float* w0; const float* a0;
    __device__ __forceinline__ void operator()(const f32x4 (&acc)[2][2][4][2], const Unit& u, int wr, int wc, int fr, int fq) const {
        const int row0 = u.pm * 256 + wr * 64 + fr, seg = u.pn >> 2, colt = (u.pn & 3) * 256 + wc * 32 + 8 * fq;
        const float* bsrc = seg == 0 ? w0 : a0;
        f32x4 bb[2][2];
#pragma unroll
        for (int bj = 0; bj < 2; ++bj) { bb[bj][0] = *(const f32x4*)(bsrc + colt + bj * 128); bb[bj][1] = *(const f32x4*)(bsrc + colt + bj * 128 + 4); }
#pragma unroll
        for (int ai = 0; ai < 2; ++ai)
#pragma unroll
            for (int m = 0; m < 4; ++m) { const int row = row0 + ai * 128 + m * 16;
#pragma unroll
                for (int bj = 0; bj < 2; ++bj) { f32x4 v0 = acc[ai][bj][m][0], v1 = acc[ai][bj][m][1];
                    const int col = colt + bj * 128;
                    if (seg == 0) {
#pragma unroll
                        for (int j = 0; j < 4; ++j) {
                            { const float z = bb[bj][0][j] + v0[j]; const float sp = fmaxf(-z, 0.f) + __logf(1.0f + __expf(-fabsf(z))); v0[j] = -__expf(-sp - 0.5f); }
                            { const float z = bb[bj][1][j] + v1[j]; const float sp = fmaxf(-z, 0.f) + __logf(1.0f + __expf(-fabsf(z))); v1[j] = -__expf(-sp - 0.5f); } }
                        float* o = LOGW + (size_t)row * D + col; *(f32x4*)o = v0; *(f32x4*)(o + 4) = v1;
                    } else if (seg == 1) {
#pragma unroll
                        for (int j = 0; j < 4; ++j) { v0[j] = sigmoidf_(bb[bj][0][j] + v0[j]); v1[j] = sigmoidf_(bb[bj][1][j] + v1[j]); }
                        *(u32x4*)(AA + (size_t)row * D + col) = pack8(v0, v1);
                    } else {
                        *(u32x4*)(GG + (size_t)row * D + col) = pack8(v0, v1);
                    }
                    __builtin_amdgcn_sched_barrier(0); } }
    }
};
template <int MODE> struct EpiMix {
    const bf16_t* P; float* F; bf16_t* Bo; const float* X; int ldc;
    __device__ __forceinline__ void operator()(const f32x4 (&acc)[2][2][4][2], const Unit& u, int wr, int wc, int fr, int fq) const {
        const int row0 = u.pm * 256 + wr * 64 + fr, col0 = u.pn * 256 + wc * 32 + 8 * fq;
#pragma unroll
        for (int ai = 0; ai < 2; ++ai)
#pragma unroll
            for (int m = 0; m < 4; ++m) { const int row = row0 + ai * 128 + m * 16;
#pragma unroll
                for (int bj = 0; bj < 2; ++bj) { f32x4 v0 = acc[ai][bj][m][0], v1 = acc[ai][bj][m][1];
                    const int col = col0 + bj * 128;
                    if (MODE == 0 || MODE == 1) {
                        const u32x4 gw = *(const u32x4*)(P + (size_t)row * NP + (MODE == 0 ? PC_GA : PC_GB) + col); float gf[8]; unpack8(gw, gf);
#pragma unroll
                        for (int j = 0; j < 4; ++j) { v0[j] *= gf[j]; v1[j] *= gf[4 + j]; }
                    }
                    if (MODE == 0) { float* o = F + (size_t)row * D + col; *(f32x4*)o = v0; *(f32x4*)(o + 4) = v1; }
                    if (MODE == 1) { const float* t1 = F + (size_t)row * D + col; v0 = v0 + *(const f32x4*)t1; v1 = v1 + *(const f32x4*)(t1 + 4); *(u32x4*)(Bo + (size_t)row * D + col) = pack8(v0, v1); }
                    if (MODE == 2) { const float* xr = X + (size_t)row * D + col; v0 = v0 + ALPHA * *(const f32x4*)xr; v1 = v1 + ALPHA * *(const f32x4*)(xr + 4);
                        float* o = F + (size_t)row * D + col; *(f32x4*)o = v0; *(f32x4*)(o + 4) = v1; }
                    if (MODE == 3) { float* o = F + (size_t)row * ldc + col; *(f32x4*)o = v0; *(f32x4*)(o + 4) = v1; } } }
    }
};
struct EpiAct {
    bf16_t* ACT;
    __device__ __forceinline__ void operator()(const f32x4 (&acc)[2][2][4][2], const Unit& u, int wr, int wc, int fr, int fq) const {
        const int row0 = u.pm * 256 + wr * 64 + fr, col = u.pn * 128 + wc * 32 + 8 * fq;
#pragma unroll
        for (int ai = 0; ai < 2; ++ai)
#pragma unroll
            for (int m = 0; m < 4; ++m) { const int row = row0 + ai * 128 + m * 16;
                f32x4 g0 = acc[ai][0][m][0], g1 = acc[ai][0][m][1]; const f32x4 u0 = acc[ai][1][m][0], u1 = acc[ai][1][m][1];
#pragma unroll
                for (int j = 0; j < 4; ++j) { g0[j] = g0[j] * sigmoidf_(g0[j]) * u0[j]; g1[j] = g1[j] * sigmoidf_(g1[j]) * u1[j]; }
                *(u32x4*)(ACT + (size_t)row * 256 + col) = pack8(g0, g1); }
    }
};
struct EpiDown {
    bf16_t* YR; const float* row_gate;
    __device__ __forceinline__ void operator()(const f32x4 (&acc)[2][2][4][2], const Unit& u, int wr, int wc, int fr, int fq) const {
        const int row0 = u.pm * 256 + wr * 64 + fr, col0 = u.pn * 256 + wc * 32 + 8 * fq;
#pragma unroll
        for (int ai = 0; ai < 2; ++ai)
#pragma unroll
            for (int m = 0; m < 4; ++m) { const int row = row0 + ai * 128 + m * 16; const float gt = row_gate[row];
#pragma unroll
                for (int bj = 0; bj < 2; ++bj) { const f32x4 v0 = acc[ai][bj][m][0] * gt, v1 = acc[ai][bj][m][1] * gt;
                    *(u32x4*)(YR + (size_t)row * D + col0 + bj * 128) = pack8(v0, v1); } }
    }
};

struct Args { const float* in[30]; float* out; unsigned char* ws; int ph_lo, ph_hi; };
struct Frame {
    LAS unsigned char* lds;
    int tid, lane, wave, G, gw, NGW;
    const struct Args& A; float* out; unsigned char* ws; unsigned* ctl;
};
#define WSP(T_, off) ((T_*)(F.ws + (off)))

__device__ __forceinline__ void tr_item(const float* W, int N, int k0, int n0, bf16_t* WT, int ldo, int drow0, LAS float* scr, int lane) {
#pragma unroll 8
    for (int i = 0; i < 32; ++i) { const int kk = 2 * i + (lane >> 5); scr[kk * 33 + (lane & 31)] = W[(size_t)(k0 + kk) * N + n0 + (lane & 31)]; }
    asm volatile("s_waitcnt lgkmcnt(0)" ::: "memory");
    const int c = lane & 7;
#pragma unroll
    for (int j = 0; j < 4; ++j) { const int n = (lane >> 3) + 8 * j; const LAS float* s = scr + (8 * c) * 33 + n;
        u32x4 o; o.x = cvt_pk_bf16(s[0 * 33], s[1 * 33]); o.y = cvt_pk_bf16(s[2 * 33], s[3 * 33]); o.z = cvt_pk_bf16(s[4 * 33], s[5 * 33]); o.w = cvt_pk_bf16(s[6 * 33], s[7 * 33]);
        *(u32x4*)(WT + (size_t)(drow0 + n) * ldo + k0 + 8 * c) = o; }
    asm volatile("s_waitcnt lgkmcnt(0)" ::: "memory");
}
__device__ __forceinline__ void p0_prologue(Frame& F) {
    LAS float* scr = (LAS float*)(F.lds + F.wave * 8448);
    constexpr int I_IN = 16 * 233, I_SQ = 16 * 32, I_GU = 16 * 16, I_DN = 4 * 32;
    constexpr int NITEMS = I_IN + 3 * I_SQ + 257 * I_GU + 257 * I_DN;
    for (int it = F.gw; it < NITEMS; it += F.NGW) {
        int r = it;
        if (r < I_IN) { const int kb = r / 233, nb = r % 233, n0 = nb * 32; tr_item(F.A.in[1], C_IN, kb * 64, n0, WSP(bf16_t, WS_WT_IN), D, n0 < 3360 ? n0 : n0 + 224, scr, F.lane); continue; } r -= I_IN;
        if (r < 3 * I_SQ) { const int w = r / I_SQ, q = r % I_SQ, kb = q / 32, nb = q % 32;
            tr_item(w == 0 ? F.A.in[17] : (w == 1 ? F.A.in[18] : F.A.in[19]), D, kb * 64, nb * 32, WSP(bf16_t, w == 0 ? WS_WT_OA : (w == 1 ? WS_WT_OB : WS_WT_OUT)), D, nb * 32, scr, F.lane); continue; } r -= 3 * I_SQ;
        if (r < 257 * I_GU) { const int e = r / I_GU, q = r % I_GU, kb = q / 16, nb = q % 16, n0 = nb * 32;
            const float* src = e < 256 ? F.A.in[24] + (size_t)e * 1024 * 512 : F.A.in[26];
            const int half = n0 >> 8, idx = n0 & 255, drow = (idx >> 7) * 256 + half * 128 + (idx & 127);
            tr_item(src, 512, kb * 64, n0, WSP(bf16_t, WS_WT_GU) + (size_t)e * 512 * 1024, 1024, drow, scr, F.lane); continue; } r -= 257 * I_GU;
        { const int e = r / I_DN, q = r % I_DN, kb = q / 32, nb = q % 32;
            const float* src = e < 256 ? F.A.in[25] + (size_t)e * 256 * 1024 : F.A.in[27];
            tr_item(src, 1024, kb * 64, nb * 32, WSP(bf16_t, WS_WT_DN) + (size_t)e * 1024 * 256, 256, nb * 32, scr, F.lane); }
    }
    const size_t gt = (size_t)blockIdx.x * 512 + F.tid, NT = (size_t)F.G * 512;
    { bf16_t* w = WSP(bf16_t, WS_WT_IN) + (size_t)3360 * D; for (size_t i = gt; i < (size_t)224 * D / 8; i += NT) ((u32x4*)w)[i] = (u32x4){0u, 0u, 0u, 0u}; }
    { bf16_t* w = WSP(bf16_t, WS_WT_LORA);
      for (size_t i = gt; i < (size_t)3072 * LK; i += NT) { const int n = (int)(i / LK), k = (int)(i % LK); float v = 0.f;
          if (n < 1024) { if (k < 64) v = F.A.in[4][(size_t)k * D + n]; }
          else if (n < 2048) { if (k >= 64 && k < 128) v = F.A.in[6][(size_t)(k - 64) * D + (n - 1024)]; }
          else { if (k >= 128 && k < 288) v = F.A.in[7][(size_t)(k - 128) * D + (n - 2048)]; }
          w[i] = (bf16_t)f2bf(v); } }
    { bf16_t* w = WSP(bf16_t, WS_WT_R);
      for (size_t i = gt; i < (size_t)256 * HRK; i += NT) { const int n = (int)(i / HRK), k = (int)(i % HRK), kk = k & 1023, seg = k >> 10;
          const float v = F.A.in[22][(size_t)kk * NE + n]; const unsigned hi = f2bf(v); const float lo = v - bf2f(hi);
          w[i] = (bf16_t)(seg == 2 ? f2bf(lo) : hi); } }
    { const f32x4* x = (const f32x4*)F.A.in[0]; u32x2* xb = WSP(u32x2, WS_XB);
      for (size_t i = gt; i < (size_t)T * D / 4; i += NT) { const f32x4 v = x[i]; u32x2 o; o.x = cvt_pk_bf16(v[0], v[1]); o.y = cvt_pk_bf16(v[2], v[3]); xb[i] = o; } }
}

__device__ __forceinline__ void p2_lora_in(Frame& F) {
    const bf16_t* P = WSP(bf16_t, WS_P); bf16_t* L = WSP(bf16_t, WS_LORAIN); const float* mu = F.A.in[2];
    for (int t = F.gw; t < T; t += F.NGW) {
        const bool first = (t % SEQ) == 0;
#pragma unroll
        for (int j = 0; j < 6; ++j) { const int c = F.lane + 64 * j; float v = 0.f;
            if (c < 288) { const float cur = bf2f(P[(size_t)t * NP + PC_L + c]); const float prev = first ? 0.f : bf2f(P[(size_t)(t - 1) * NP + PC_L + c]);
                const float m = cur + mu[3072 + c] * (prev - cur);
                v = c < 64 ? tanhf(m) : (c < 128 ? m : sigmoidf_(m)); }
            L[(size_t)t * LK + c] = (bf16_t)f2bf(v); }
    }
}

__device__ __forceinline__ void p2_gmlp(Frame& F) {
    const bf16_t* P = WSP(bf16_t, WS_P); bf16_t* YB = WSP(bf16_t, WS_YB);
    const float* lnw = F.A.in[13]; const float* lnb = F.A.in[14]; const float* sw = F.A.in[15]; const float* sb = F.A.in[16];
    LAS bf16_t* VT = (LAS bf16_t*)F.lds;
    LAS float* ST = (LAS float*)(F.lds + 36864);
    const int lane = F.lane, wave = F.wave, fr = lane & 15, fq = lane >> 4;
    for (int ch = blockIdx.x; ch < T / 128; ch += F.G) {
        const int t0 = ch * 128;
        for (int i = 0; i < 16; ++i) { const int tl = wave * 16 + i; const bf16_t* vr = P + (size_t)(t0 + tl) * NP + PC_GV;
            float f0[8], f1[8]; unpack8(*(const u32x4*)(vr + lane * 8), f0); unpack8(*(const u32x4*)(vr + 512 + lane * 8), f1);
            float s = 0.f;
#pragma unroll
            for (int j = 0; j < 8; ++j) s += f0[j] + f1[j];
            const float mean = wave_sum(s) * (1.f / 1024.f); float q = 0.f;
#pragma unroll
            for (int j = 0; j < 8; ++j) { const float a = f0[j] - mean, b = f1[j] - mean; q += a * a + b * b; }
            const float rstd = 1.0f / sqrtf(wave_sum(q) * (1.f / 1024.f) + LN_EPS);
            if (lane == 0) { ST[tl * 2] = mean; ST[tl * 2 + 1] = rstd; } }
        __syncthreads();
        for (int g = 0; g < 8; ++g) {
            { const int s = F.tid >> 2, d0 = (F.tid & 3) * 32; const float mean = ST[s * 2], rstd = ST[s * 2 + 1];
              const bf16_t* vr = P + (size_t)(t0 + s) * NP + PC_GV + g * 128 + d0;
#pragma unroll
              for (int q4 = 0; q4 < 4; ++q4) { float f[8]; unpack8(*(const u32x4*)(vr + q4 * 8), f);
#pragma unroll
                  for (int j = 0; j < 8; ++j) { const int d = d0 + q4 * 8 + j; const float v = (f[j] - mean) * rstd * lnw[g * 128 + d] + lnb[g * 128 + d];
                      VT[d * 136 + s] = (bf16_t)f2bf(v); } } }
            __syncthreads();
            f32x4 acc[8];
#pragma unroll
            for (int n = 0; n < 8; ++n) acc[n] = (f32x4){0.f, 0.f, 0.f, 0.f};
            const int tl = wave * 16 + fr;
            const float* wrow = sw + ((size_t)g * 128 + tl) * 128;
#pragma unroll
            for (int ks = 0; ks < 4; ++ks) {
                if (ks * 32 <= wave * 16 + 15) {
                    const int s0 = ks * 32 + fq * 8;
                    const f32x4 w0 = *(const f32x4*)(wrow + s0), w1 = *(const f32x4*)(wrow + s0 + 4);
                    float wf[8] = {w0[0], w0[1], w0[2], w0[3], w1[0], w1[1], w1[2], w1[3]};
#pragma unroll
                    for (int j = 0; j < 8; ++j) wf[j] = (s0 + j <= tl) ? wf[j] : 0.f;
                    u32x4 aw; aw.x = cvt_pk_bf16(wf[0], wf[1]); aw.y = cvt_pk_bf16(wf[2], wf[3]); aw.z = cvt_pk_bf16(wf[4], wf[5]); aw.w = cvt_pk_bf16(wf[6], wf[7]);
                    const bf16x8 af = __builtin_bit_cast(bf16x8, aw);
#pragma unroll
                    for (int n = 0; n < 8; ++n) { const bf16x8 bfrag = *(const LAS bf16x8*)(VT + (n * 16 + fr) * 136 + s0);
                        acc[n] = __builtin_amdgcn_mfma_f32_16x16x32_bf16(bfrag, af, acc[n], 0, 0, 0); }
                }
            }
            const float bias = sb[g * 128 + tl];
            const bf16_t* ur = P + (size_t)(t0 + tl) * NP + PC_U + g * 128; bf16_t* yr = YB + (size_t)(t0 + tl) * D + g * 128;
#pragma unroll
            for (int n = 0; n < 8; ++n) { const int d = n * 16 + 4 * fq; const u32x2 uw = *(const u32x2*)(ur + d);
                const float o0 = bf2f(uw.x & 0xffffu) * (acc[n][0] + bias), o1 = bf2f(uw.x >> 16) * (acc[n][1] + bias), o2 = bf2f(uw.y & 0xffffu) * (acc[n][2] + bias), o3 = bf2f(uw.y >> 16) * (acc[n][3] + bias);
                u32x2 o; o.x = cvt_pk_bf16(o0, o1); o.y = cvt_pk_bf16(o2, o3); *(u32x2*)(yr + d) = o; }
            __syncthreads();
        }
    }
}

__device__ __forceinline__ void p4_scan_seq(Frame& F) {
    if (F.wave != 0) return;
    const bf16_t* P = WSP(bf16_t, WS_P); const float* LOGW = WSP(float, WS_LOGW); const bf16_t* AA = WSP(bf16_t, WS_AA); const bf16_t* GG = WSP(bf16_t, WS_GG); bf16_t* YA = WSP(bf16_t, WS_YA);
    LAS float* V = (LAS float*)F.lds;
    const int lane = F.lane;
    for (int bh = blockIdx.x; bh < 4 * NH; bh += F.G) {
        const int b = bh / NH, h = bh % NH, c = h * HD + lane;
        const float mu_r = F.A.in[2][c], mu_k = F.A.in[2][1024 + c], mu_v = F.A.in[2][2048 + c];
        const float k_k = F.A.in[8][c], k_a = F.A.in[9][c], r_k = F.A.in[10][c], gn_w = F.A.in[11][c], gn_b = F.A.in[12][c];
        float S[64];
#pragma unroll
        for (int j = 0; j < 64; ++j) S[j] = 0.f;
        float pr = 0.f, pk = 0.f, pv = 0.f;
        const size_t row0 = (size_t)b * SEQ;
        float cr = bf2f(P[row0 * NP + PC_R + c]), ck = bf2f(P[row0 * NP + PC_K + c]), cv = bf2f(P[row0 * NP + PC_V + c]);
        float cw = LOGW[row0 * D + c], ca = bf2f(AA[row0 * D + c]), cg = bf2f(GG[row0 * D + c]);
#pragma unroll 1
        for (int t = 0; t < SEQ; ++t) {
            const size_t rown = row0 + (t + 1 < SEQ ? t + 1 : t);
            const float nr = bf2f(P[rown * NP + PC_R + c]), nk = bf2f(P[rown * NP + PC_K + c]), nv = bf2f(P[rown * NP + PC_V + c]);
            const float nw = LOGW[rown * D + c], na = bf2f(AA[rown * D + c]), ng = bf2f(GG[rown * D + c]);
            const float r = cr + mu_r * (pr - cr), k = ck + mu_k * (pk - ck), v = cv + mu_v * (pv - cv);
            pr = cr; pk = ck; pv = cv;
            const float a = ca;
            float kk = k * k_k; const float nrm = sqrtf(wave_sum(kk * kk)); kk = kk / fmaxf(nrm, 1e-12f);
            const float kp = k * (1.0f + (a - 1.0f) * k_a);
            const float w = __expf(cw);
            V[lane] = w; V[64 + lane] = -kk; V[128 + lane] = kk * a; V[192 + lane] = kp; V[256 + lane] = r;
            asm volatile("s_waitcnt lgkmcnt(0)" ::: "memory");
            float sa = 0.f;
#pragma unroll
            for (int j = 0; j < 64; j += 4) { const f32x4 av = *(const LAS f32x4*)(V + 64 + j); sa += S[j] * av[0] + S[j + 1] * av[1] + S[j + 2] * av[2] + S[j + 3] * av[3]; }
            float y = 0.f;
#pragma unroll
            for (int j = 0; j < 64; j += 4) { const f32x4 wv = *(const LAS f32x4*)(V + j), bv = *(const LAS f32x4*)(V + 128 + j), kv = *(const LAS f32x4*)(V + 192 + j), rv = *(const LAS f32x4*)(V + 256 + j);
#pragma unroll
                for (int q = 0; q < 4; ++q) { S[j + q] = S[j + q] * wv[q] + sa * bv[q] + v * kv[q]; y += S[j + q] * rv[q]; }
                if ((j & 12) == 12) asm volatile("" ::: "memory"); }
            const float mean = wave_sum(y) * (1.f / 64.f); const float dy = y - mean; const float var = wave_sum(dy * dy) * (1.f / 64.f);
            const float yn = dy * (1.0f / sqrtf(var + GN_EPS)) * gn_w + gn_b;
            const float bonus = wave_sum(r * kp * r_k) * v;
            YA[(row0 + t) * D + c] = (bf16_t)f2bf((yn + bonus) * cg);
            asm volatile("s_waitcnt lgkmcnt(0)" ::: "memory");
            cr = nr; ck = nk; cv = nv; cw = nw; ca = na; cg = ng;
        }
    }
}


constexpr int TS = 72;
constexpr int TILE_B = 64 * TS * 2;
constexpr int NCH = SEQ / 64;
typedef __attribute__((address_space(3))) bf16_t lbf16;
__device__ __forceinline__ f32x4 mfma16(const bf16x8 a, const bf16x8 b, const f32x4 c) { return __builtin_amdgcn_mfma_f32_16x16x32_bf16(a, b, c, 0, 0, 0); }
__device__ __forceinline__ void mm_nt(const lbf16* X, const lbf16* Y, f32x4 (&acc)[2], int mt, int nt0, int fr, int fq) {
#pragma unroll
    for (int ks = 0; ks < 2; ++ks) { const bf16x8 xb = *(const LAS bf16x8*)(X + (mt * 16 + fr) * TS + ks * 32 + fq * 8);
#pragma unroll
        for (int i = 0; i < 2; ++i) { const bf16x8 ya = *(const LAS bf16x8*)(Y + ((nt0 + i) * 16 + fr) * TS + ks * 32 + fq * 8); acc[i] = mfma16(ya, xb, acc[i]); } }
}
__device__ __forceinline__ void st_nat(lbf16* Dn, const f32x4 (&acc)[2], int mt, int nt0, int fr, int fq) {
#pragma unroll
    for (int i = 0; i < 2; ++i) { u32x2 o; o.x = cvt_pk_bf16(acc[i][0], acc[i][1]); o.y = cvt_pk_bf16(acc[i][2], acc[i][3]); *(LAS u32x2*)(Dn + (mt * 16 + fr) * TS + (nt0 + i) * 16 + 4 * fq) = o; }
}
__device__ __forceinline__ void st_tr(lbf16* Dt, const f32x4 (&acc)[2], int mt, int nt0, int fr, int fq) {
#pragma unroll
    for (int i = 0; i < 2; ++i)
#pragma unroll
        for (int r = 0; r < 4; ++r) Dt[((nt0 + i) * 16 + 4 * fq + r) * TS + mt * 16 + fr] = (bf16_t)f2bf(acc[i][r]);
}
#define ZACC(a) do { a[0] = (f32x4){0.f, 0.f, 0.f, 0.f}; a[1] = (f32x4){0.f, 0.f, 0.f, 0.f}; } while (0)

__device__ __forceinline__ void scan_pass1(Frame& F) {
    const bf16_t* P = WSP(bf16_t, WS_P); const float* LOGW = WSP(float, WS_LOGW); const bf16_t* AA = WSP(bf16_t, WS_AA);
    bf16_t* PT = WSP(bf16_t, WS_PT); bf16_t* QQ = WSP(bf16_t, WS_QQ); bf16_t* RH = WSP(bf16_t, WS_RH); bf16_t* Y0 = WSP(bf16_t, WS_Y0); bf16_t* BV = WSP(bf16_t, WS_BV);
    const int tid = F.tid, lane = F.lane, w = F.wave, fr = lane & 15, fq = lane >> 4, mt = w >> 1, nt0 = (w & 1) * 2;
#define TL(n) ((lbf16*)(F.lds + (n) * TILE_B))
    lbf16 *tA = TL(0), *tB = TL(1), *tK = TL(2), *tR = TL(3), *tAT = TL(4), *tBT = TL(5), *tKT = TL(6), *tVT = TL(7);
    lbf16 *tAak = TL(11), *tArb = TL(12), *tArk = TL(13), *tX1T = TL(14), *tU0T = TL(8), *tAhT = TL(9);
    LAS float* CW = (LAS float*)(F.lds + 8 * TILE_B);
    LAS float* WL = (LAS float*)(F.lds + 15 * TILE_B);
    LAS float* TOT = WL + 64;
    for (int item = blockIdx.x; item < 64 * NCH; item += F.G) {
        const int bh = item / NCH, c = item % NCH, b = bh >> 4, h = bh & 15;
        const size_t tok0 = (size_t)b * SEQ + (size_t)c * 64;
        {
            const int t = tid >> 3, c0 = (tid & 7) * 8, col = h * 64 + c0; const size_t row = tok0 + t;
            const bool first = (c == 0 && t == 0);
            float r[8], k[8], v[8], a[8], lw[8];
            { float cur[8], prv[8]; const float* mu = F.A.in[2];
              unpack8(*(const u32x4*)(P + row * NP + PC_R + col), cur); if (first) { for (int j = 0; j < 8; ++j) prv[j] = 0.f; } else unpack8(*(const u32x4*)(P + (row - 1) * NP + PC_R + col), prv);
#pragma unroll
              for (int j = 0; j < 8; ++j) r[j] = cur[j] + mu[PC_R + col + j] * (prv[j] - cur[j]);
              unpack8(*(const u32x4*)(P + row * NP + PC_K + col), cur); if (first) { for (int j = 0; j < 8; ++j) prv[j] = 0.f; } else unpack8(*(const u32x4*)(P + (row - 1) * NP + PC_K + col), prv);
#pragma unroll
              for (int j = 0; j < 8; ++j) k[j] = cur[j] + mu[PC_K + col + j] * (prv[j] - cur[j]);
              unpack8(*(const u32x4*)(P + row * NP + PC_V + col), cur); if (first) { for (int j = 0; j < 8; ++j) prv[j] = 0.f; } else unpack8(*(const u32x4*)(P + (row - 1) * NP + PC_V + col), prv);
#pragma unroll
              for (int j = 0; j < 8; ++j) v[j] = cur[j] + mu[PC_V + col + j] * (prv[j] - cur[j]); }
            unpack8(*(const u32x4*)(AA + row * D + col), a);
            { const f32x4 l0 = *(const f32x4*)(LOGW + row * D + col), l1 = *(const f32x4*)(LOGW + row * D + col + 4);
#pragma unroll
              for (int j = 0; j < 4; ++j) { lw[j] = l0[j]; lw[4 + j] = l1[j]; } }
            *(LAS f32x4*)(CW + t * 64 + c0) = (f32x4){lw[0], lw[1], lw[2], lw[3]}; *(LAS f32x4*)(CW + t * 64 + c0 + 4) = (f32x4){lw[4], lw[5], lw[6], lw[7]};
            __syncthreads();
            { const int cc = tid & 63, tq = tid >> 6; float p[8]; float s = 0.f;
#pragma unroll
              for (int i = 0; i < 8; ++i) { s += CW[(tq * 8 + i) * 64 + cc]; p[i] = s; }
              TOT[tq * 64 + cc] = s;
              __syncthreads();
              float off = 0.f;
#pragma unroll
              for (int q = 0; q < 7; ++q) off += (q < tq) ? TOT[q * 64 + cc] : 0.f;
#pragma unroll
              for (int i = 0; i < 8; ++i) CW[(tq * 8 + i) * 64 + cc] = p[i] + off; }
            __syncthreads();
            float cw[8];
            { const f32x4 c0v = *(const LAS f32x4*)(CW + t * 64 + c0), c1v = *(const LAS f32x4*)(CW + t * 64 + c0 + 4);
#pragma unroll
              for (int j = 0; j < 4; ++j) { cw[j] = c0v[j]; cw[4 + j] = c1v[j]; } }
            const float* kkp = F.A.in[8] + col; const float* kap = F.A.in[9] + col; const float* rkp = F.A.in[10] + col;
            float kk[8], n2 = 0.f, bon = 0.f;
#pragma unroll
            for (int j = 0; j < 8; ++j) { kk[j] = k[j] * kkp[j]; n2 += kk[j] * kk[j]; }
            n2 += __shfl_xor(n2, 1); n2 += __shfl_xor(n2, 2); n2 += __shfl_xor(n2, 4);
            const float inv = 1.0f / fmaxf(sqrtf(n2), 1e-12f);
#pragma unroll
            for (int j = 0; j < 8; ++j) { kk[j] *= inv; k[j] = k[j] * (1.0f + (a[j] - 1.0f) * kap[j]); bon += r[j] * k[j] * rkp[j]; }
            bon += __shfl_xor(bon, 1); bon += __shfl_xor(bon, 2); bon += __shfl_xor(bon, 4);
            { f32x4 b0, b1;
#pragma unroll
              for (int j = 0; j < 4; ++j) { b0[j] = bon * v[j]; b1[j] = bon * v[4 + j]; }
              *(u32x4*)(BV + row * D + col) = pack8(b0, b1); }
            float at[8], bt[8], kt[8], rt[8];
#pragma unroll
            for (int j = 0; j < 8; ++j) { const float e1 = __expf(cw[j]), e2 = __expf(-cw[j]), e3 = __expf(cw[j] - lw[j]);
                at[j] = -kk[j] * e3; bt[j] = kk[j] * a[j] * e2; kt[j] = k[j] * e2; rt[j] = r[j] * e1;
                if (t == 63) WL[c0 + j] = e1; }
            __syncthreads();
            *(LAS u32x4*)(tA + t * TS + c0) = pack8((f32x4){at[0], at[1], at[2], at[3]}, (f32x4){at[4], at[5], at[6], at[7]});
            *(LAS u32x4*)(tB + t * TS + c0) = pack8((f32x4){bt[0], bt[1], bt[2], bt[3]}, (f32x4){bt[4], bt[5], bt[6], bt[7]});
            *(LAS u32x4*)(tK + t * TS + c0) = pack8((f32x4){kt[0], kt[1], kt[2], kt[3]}, (f32x4){kt[4], kt[5], kt[6], kt[7]});
            *(LAS u32x4*)(tR + t * TS + c0) = pack8((f32x4){rt[0], rt[1], rt[2], rt[3]}, (f32x4){rt[4], rt[5], rt[6], rt[7]});
#pragma unroll
            for (int j = 0; j < 8; ++j) { tAT[(c0 + j) * TS + t] = (bf16_t)f2bf(at[j]); tBT[(c0 + j) * TS + t] = (bf16_t)f2bf(bt[j]); tKT[(c0 + j) * TS + t] = (bf16_t)f2bf(kt[j]); tVT[(c0 + j) * TS + t] = (bf16_t)f2bf(v[j]); }
        }
        __syncthreads();
        const int mrow = mt * 16 + fr;
        {
            f32x4 acc[2];
            ZACC(acc); mm_nt(tA, tB, acc, mt, nt0, fr, fq);
#pragma unroll
            for (int i = 0; i < 2; ++i)
#pragma unroll
                for (int r = 0; r < 4; ++r) { const int n = (nt0 + i) * 16 + 4 * fq + r; acc[i][r] = (n < mrow) ? acc[i][r] : 0.f; }
            st_nat(TL(8), acc, mt, nt0, fr, fq); st_tr(TL(9), acc, mt, nt0, fr, fq);
#pragma unroll
            for (int i = 0; i < 2; ++i)
#pragma unroll
                for (int r = 0; r < 4; ++r) { const int n = (nt0 + i) * 16 + 4 * fq + r; acc[i][r] += (n == mrow) ? 1.f : 0.f; }
            st_nat(TL(10), acc, mt, nt0, fr, fq);
            ZACC(acc); mm_nt(tA, tK, acc, mt, nt0, fr, fq);
#pragma unroll
            for (int i = 0; i < 2; ++i)
#pragma unroll
                for (int r = 0; r < 4; ++r) { const int n = (nt0 + i) * 16 + 4 * fq + r; acc[i][r] = (n < mrow) ? acc[i][r] : 0.f; }
            st_nat(tAak, acc, mt, nt0, fr, fq);
            ZACC(acc); mm_nt(tR, tB, acc, mt, nt0, fr, fq);
#pragma unroll
            for (int i = 0; i < 2; ++i)
#pragma unroll
                for (int r = 0; r < 4; ++r) { const int n = (nt0 + i) * 16 + 4 * fq + r; acc[i][r] = (n <= mrow) ? acc[i][r] : 0.f; }
            st_nat(tArb, acc, mt, nt0, fr, fq);
            ZACC(acc); mm_nt(tR, tK, acc, mt, nt0, fr, fq);
#pragma unroll
            for (int i = 0; i < 2; ++i)
#pragma unroll
                for (int r = 0; r < 4; ++r) { const int n = (nt0 + i) * 16 + 4 * fq + r; acc[i][r] = (n <= mrow) ? acc[i][r] : 0.f; }
            st_nat(tArk, acc, mt, nt0, fr, fq);
        }
        __syncthreads();
        {
            f32x4 acc[2];
            ZACC(acc); mm_nt(TL(8), TL(9), acc, mt, nt0, fr, fq); st_nat(TL(0), acc, mt, nt0, fr, fq); st_tr(TL(1), acc, mt, nt0, fr, fq);
            ZACC(acc); mm_nt(tVT, tAak, acc, mt, nt0, fr, fq); st_nat(tX1T, acc, mt, nt0, fr, fq);
        }
        __syncthreads();
#pragma unroll
        for (int lvl = 0; lvl < 4; ++lvl) {
            lbf16* Nn = (lvl & 1) ? TL(8) : TL(0); lbf16* Nt = (lvl & 1) ? TL(9) : TL(1); lbf16* Tk = (lvl & 1) ? TL(2) : TL(10);
            lbf16* N2n = (lvl & 1) ? TL(0) : TL(8); lbf16* N2t = (lvl & 1) ? TL(1) : TL(9); lbf16* T2 = (lvl & 1) ? TL(10) : TL(2);
            f32x4 acc[2];
#pragma unroll
            for (int i = 0; i < 2; ++i) { const u32x2 tw = *(const LAS u32x2*)(Tk + mrow * TS + (nt0 + i) * 16 + 4 * fq);
                acc[i] = (f32x4){bf2f(tw.x & 0xffffu), bf2f(tw.x >> 16), bf2f(tw.y & 0xffffu), bf2f(tw.y >> 16)}; }
            mm_nt(Tk, Nt, acc, mt, nt0, fr, fq); st_nat(T2, acc, mt, nt0, fr, fq);
            ZACC(acc); mm_nt(Nn, Nt, acc, mt, nt0, fr, fq); st_nat(N2n, acc, mt, nt0, fr, fq); st_tr(N2t, acc, mt, nt0, fr, fq);
            __syncthreads();
        }
        {
            f32x4 acc[2];
#pragma unroll
            for (int i = 0; i < 2; ++i) { const u32x2 tw = *(const LAS u32x2*)(TL(10) + mrow * TS + (nt0 + i) * 16 + 4 * fq);
                acc[i] = (f32x4){bf2f(tw.x & 0xffffu), bf2f(tw.x >> 16), bf2f(tw.y & 0xffffu), bf2f(tw.y >> 16)}; }
            mm_nt(TL(10), TL(1), acc, mt, nt0, fr, fq); st_nat(TL(2), acc, mt, nt0, fr, fq);
        }
        __syncthreads();
        {
            f32x4 acc[2];
            ZACC(acc); mm_nt(tX1T, TL(2), acc, mt, nt0, fr, fq); st_nat(tU0T, acc, mt, nt0, fr, fq);
            ZACC(acc); mm_nt(tAT, TL(2), acc, mt, nt0, fr, fq); st_nat(tAhT, acc, mt, nt0, fr, fq);
        }
        __syncthreads();
        {
            f32x4 acc[2];
            const size_t tile = (size_t)item * 4096;
            ZACC(acc); mm_nt(tBT, tAhT, acc, mt, nt0, fr, fq);
            { const float wl = WL[mrow];
#pragma unroll
              for (int i = 0; i < 2; ++i) { const int n0 = (nt0 + i) * 16 + 4 * fq; f32x4 o;
#pragma unroll
                  for (int r = 0; r < 4; ++r) o[r] = (acc[i][r] + ((n0 + r == mrow) ? 1.f : 0.f)) * wl;
                  u32x2 ow; ow.x = cvt_pk_bf16(o[0], o[1]); ow.y = cvt_pk_bf16(o[2], o[3]); *(u32x2*)(PT + tile + mrow * 64 + n0) = ow; } }
            ZACC(acc); mm_nt(tU0T, tBT, acc, mt, nt0, fr, fq); mm_nt(tVT, tKT, acc, mt, nt0, fr, fq);
#pragma unroll
            for (int i = 0; i < 2; ++i) { const int n0 = (nt0 + i) * 16 + 4 * fq; const f32x4 wl = *(const LAS f32x4*)(WL + n0); const f32x4 o = acc[i] * wl;
                u32x2 ow; ow.x = cvt_pk_bf16(o[0], o[1]); ow.y = cvt_pk_bf16(o[2], o[3]); *(u32x2*)(QQ + tile + mrow * 64 + n0) = ow; }
#pragma unroll
            for (int i = 0; i < 2; ++i) { const u32x2 tw = *(const LAS u32x2*)(tR + mrow * TS + (nt0 + i) * 16 + 4 * fq);
                acc[i] = (f32x4){bf2f(tw.x & 0xffffu), bf2f(tw.x >> 16), bf2f(tw.y & 0xffffu), bf2f(tw.y >> 16)}; }
            mm_nt(tArb, tAhT, acc, mt, nt0, fr, fq);
#pragma unroll
            for (int i = 0; i < 2; ++i) { const int n0 = (nt0 + i) * 16 + 4 * fq; u32x2 ow; ow.x = cvt_pk_bf16(acc[i][0], acc[i][1]); ow.y = cvt_pk_bf16(acc[i][2], acc[i][3]);
                *(u32x2*)(RH + (tok0 + mrow) * D + h * 64 + n0) = ow; }
            ZACC(acc); mm_nt(tArb, tU0T, acc, mt, nt0, fr, fq); mm_nt(tArk, tVT, acc, mt, nt0, fr, fq);
#pragma unroll
            for (int i = 0; i < 2; ++i) { const int n0 = (nt0 + i) * 16 + 4 * fq; u32x2 ow; ow.x = cvt_pk_bf16(acc[i][0], acc[i][1]); ow.y = cvt_pk_bf16(acc[i][2], acc[i][3]);
                *(u32x2*)(Y0 + (tok0 + mrow) * D + h * 64 + n0) = ow; }
        }
        __syncthreads();
    }
#undef TL
}

__device__ __forceinline__ void scan_pass2(Frame& F) {
    const bf16_t* PT = WSP(bf16_t, WS_PT); const bf16_t* QQ = WSP(bf16_t, WS_QQ); bf16_t* SC = WSP(bf16_t, WS_SC);
    const int lane = F.lane, w = F.wave, fr = lane & 15, fq = lane >> 4;
    if (w >= 4) return;
    for (int bh = blockIdx.x; bh < 64; bh += F.G) {
        f32x4 acc[4];
#pragma unroll
        for (int m = 0; m < 4; ++m) acc[m] = (f32x4){0.f, 0.f, 0.f, 0.f};
        const int irow = 16 * w + fr;
        u32x2 pa[4][2][2], pn[4][2][2]; u32x2 qa[4], qn[4];
        { const bf16_t* pt = PT + (size_t)(bh * NCH) * 4096; const bf16_t* qq = QQ + (size_t)(bh * NCH) * 4096;
#pragma unroll
          for (int m = 0; m < 4; ++m) { qa[m] = *(const u32x2*)(qq + irow * 64 + 16 * m + 4 * fq);
#pragma unroll
              for (int ks = 0; ks < 2; ++ks) { pa[m][ks][0] = *(const u32x2*)(pt + (16 * m + fr) * 64 + 32 * ks + 4 * fq); pa[m][ks][1] = *(const u32x2*)(pt + (16 * m + fr) * 64 + 32 * ks + 16 + 4 * fq); } } }
#pragma unroll 1
        for (int c = 0; c < NCH; ++c) {
            const int cn = (c + 1 < NCH) ? c + 1 : c;
            { const bf16_t* pt = PT + (size_t)(bh * NCH + cn) * 4096; const bf16_t* qq = QQ + (size_t)(bh * NCH + cn) * 4096;
#pragma unroll
              for (int m = 0; m < 4; ++m) { qn[m] = *(const u32x2*)(qq + irow * 64 + 16 * m + 4 * fq);
#pragma unroll
                  for (int ks = 0; ks < 2; ++ks) { pn[m][ks][0] = *(const u32x2*)(pt + (16 * m + fr) * 64 + 32 * ks + 4 * fq); pn[m][ks][1] = *(const u32x2*)(pt + (16 * m + fr) * 64 + 32 * ks + 16 + 4 * fq); } } }
            u32x2 sp[4];
#pragma unroll
            for (int m = 0; m < 4; ++m) { sp[m].x = cvt_pk_bf16(acc[m][0], acc[m][1]); sp[m].y = cvt_pk_bf16(acc[m][2], acc[m][3]); }
            bf16_t* sc = SC + (size_t)(bh * NCH + c) * 4096 + irow * 64;
#pragma unroll
            for (int m = 0; m < 4; ++m) *(u32x2*)(sc + 16 * m + 4 * fq) = sp[m];
            bf16x8 bop[2];
#pragma unroll
            for (int ks = 0; ks < 2; ++ks) { u32x4 t4; t4.x = sp[2 * ks].x; t4.y = sp[2 * ks].y; t4.z = sp[2 * ks + 1].x; t4.w = sp[2 * ks + 1].y; bop[ks] = __builtin_bit_cast(bf16x8, t4); }
#pragma unroll
            for (int m = 0; m < 4; ++m) {
                f32x4 a0 = (f32x4){bf2f(qa[m].x & 0xffffu), bf2f(qa[m].x >> 16), bf2f(qa[m].y & 0xffffu), bf2f(qa[m].y >> 16)};
#pragma unroll
                for (int ks = 0; ks < 2; ++ks) { u32x4 t4; t4.x = pa[m][ks][0].x; t4.y = pa[m][ks][0].y; t4.z = pa[m][ks][1].x; t4.w = pa[m][ks][1].y; a0 = mfma16(__builtin_bit_cast(bf16x8, t4), bop[ks], a0); }
                acc[m] = a0; }
#pragma unroll
            for (int m = 0; m < 4; ++m) { qa[m] = qn[m];
#pragma unroll
                for (int ks = 0; ks < 2; ++ks) { pa[m][ks][0] = pn[m][ks][0]; pa[m][ks][1] = pn[m][ks][1]; } }
        }
    }
}

__device__ __forceinline__ void scan_pass3(Frame& F) {
    const bf16_t* SC = WSP(bf16_t, WS_SC); const bf16_t* RH = WSP(bf16_t, WS_RH); const bf16_t* Y0 = WSP(bf16_t, WS_Y0); const bf16_t* BV = WSP(bf16_t, WS_BV);
    const bf16_t* GG = WSP(bf16_t, WS_GG); bf16_t* YA = WSP(bf16_t, WS_YA);
    const float* gnw = F.A.in[11]; const float* gnb = F.A.in[12];
    const int lane = F.lane, fr = lane & 15, fq = lane >> 4;
    for (int item = F.gw; item < 64 * NCH; item += F.NGW) {
        const int bh = item / NCH, c = item % NCH, b = bh >> 4, h = bh & 15;
        const size_t tok0 = (size_t)b * SEQ + (size_t)c * 64;
        const bf16_t* sc = SC + (size_t)item * 4096;
        bf16x8 sa[4][2];
#pragma unroll
        for (int nt = 0; nt < 4; ++nt)
#pragma unroll
            for (int ks = 0; ks < 2; ++ks) sa[nt][ks] = *(const bf16x8*)(sc + (16 * nt + fr) * 64 + 32 * ks + 8 * fq);
        f32x4 gw4[4], gb4[4];
#pragma unroll
        for (int nt = 0; nt < 4; ++nt) { gw4[nt] = *(const f32x4*)(gnw + h * 64 + 16 * nt + 4 * fq); gb4[nt] = *(const f32x4*)(gnb + h * 64 + 16 * nt + 4 * fq); }
#pragma unroll 1
        for (int mt = 0; mt < 4; ++mt) {
            const size_t row = tok0 + 16 * mt + fr; const size_t base = row * D + h * 64;
            bf16x8 rb[2];
#pragma unroll
            for (int ks = 0; ks < 2; ++ks) rb[ks] = *(const bf16x8*)(RH + base + 32 * ks + 8 * fq);
            f32x4 y[4];
#pragma unroll
            for (int nt = 0; nt < 4; ++nt) { const u32x2 yw = *(const u32x2*)(Y0 + base + 16 * nt + 4 * fq);
                y[nt] = (f32x4){bf2f(yw.x & 0xffffu), bf2f(yw.x >> 16), bf2f(yw.y & 0xffffu), bf2f(yw.y >> 16)};
#pragma unroll
                for (int ks = 0; ks < 2; ++ks) y[nt] = mfma16(sa[nt][ks], rb[ks], y[nt]); }
            float s = 0.f;
#pragma unroll
            for (int nt = 0; nt < 4; ++nt) s += (y[nt][0] + y[nt][1]) + (y[nt][2] + y[nt][3]);
            s += __shfl_xor(s, 16); s += __shfl_xor(s, 32);
            const float mean = s * (1.f / 64.f); float q = 0.f;
#pragma unroll
            for (int nt = 0; nt < 4; ++nt) { y[nt] = y[nt] - mean; q += (y[nt][0] * y[nt][0] + y[nt][1] * y[nt][1]) + (y[nt][2] * y[nt][2] + y[nt][3] * y[nt][3]); }
            q += __shfl_xor(q, 16); q += __shfl_xor(q, 32);
            const float rstd = 1.0f / sqrtf(q * (1.f / 64.f) + GN_EPS);
#pragma unroll
            for (int nt = 0; nt < 4; ++nt) { const u32x2 bw = *(const u32x2*)(BV + base + 16 * nt + 4 * fq), gw = *(const u32x2*)(GG + base + 16 * nt + 4 * fq);
                const f32x4 bv = (f32x4){bf2f(bw.x & 0xffffu), bf2f(bw.x >> 16), bf2f(bw.y & 0xffffu), bf2f(bw.y >> 16)}, gv = (f32x4){bf2f(gw.x & 0xffffu), bf2f(gw.x >> 16), bf2f(gw.y & 0xffffu), bf2f(gw.y >> 16)};
                const f32x4 o = (y[nt] * rstd * gw4[nt] + gb4[nt] + bv) * gv;
                u32x2 ow; ow.x = cvt_pk_bf16(o[0], o[1]); ow.y = cvt_pk_bf16(o[2], o[3]); *(u32x2*)(YA + base + 16 * nt + 4 * fq) = ow; }
        }
    }
}

__device__ __forceinline__ void p8_ln1(Frame& F) {
    const float* HP = WSP(float, WS_H1PRE); float* H1 = WSP(float, WS_H1); bf16_t* HR = WSP(bf16_t, WS_HR);
    const float* lw = F.A.in[20]; const float* lb = F.A.in[21];
    for (int t = F.gw; t < T; t += F.NGW) {
        const f32x4* xr = (const f32x4*)(HP + (size_t)t * D) + F.lane; f32x4 v[4]; float s = 0.f;
#pragma unroll
        for (int j = 0; j < 4; ++j) { v[j] = xr[64 * j]; s += (v[j][0] + v[j][1]) + (v[j][2] + v[j][3]); }
        const float mean = wave_sum(s) * (1.f / D); float q = 0.f;
#pragma unroll
        for (int j = 0; j < 4; ++j) { v[j] = v[j] - mean; q += (v[j][0] * v[j][0] + v[j][1] * v[j][1]) + (v[j][2] * v[j][2] + v[j][3] * v[j][3]); }
        const float rstd = 1.0f / sqrtf(wave_sum(q) * (1.f / D) + LN_EPS);
#pragma unroll
        for (int j = 0; j < 4; ++j) { const int col = 4 * F.lane + 256 * j; const f32x4 w = *(const f32x4*)(lw + col), bb = *(const f32x4*)(lb + col);
            const f32x4 o = v[j] * rstd * w + bb; *(f32x4*)(H1 + (size_t)t * D + col) = o;
            const unsigned h01 = cvt_pk_bf16(o[0], o[1]), h23 = cvt_pk_bf16(o[2], o[3]);
            const float l0 = o[0] - bf2f(h01 & 0xffffu), l1 = o[1] - bf2f(h01 >> 16), l2 = o[2] - bf2f(h23 & 0xffffu), l3 = o[3] - bf2f(h23 >> 16);
            u32x2 hi; hi.x = h01; hi.y = h23; u32x2 lo; lo.x = cvt_pk_bf16(l0, l1); lo.y = cvt_pk_bf16(l2, l3);
            bf16_t* hr = HR + (size_t)t * HRK + col; *(u32x2*)hr = hi; *(u32x2*)(hr + 1024) = lo; *(u32x2*)(hr + 2048) = hi; }
    }
}

__device__ __forceinline__ void p10_route(Frame& F) {
    const float* LG = WSP(float, WS_LOGITS); const float* rb = F.A.in[23];
    int* TE = WSP(int, WS_TOPE); float* TG = WSP(float, WS_TOPG); int* CNT = WSP(int, WS_CNT);
    LAS int* hist = (LAS int*)F.lds;
    if (F.tid < 256) hist[F.tid] = 0;
    __syncthreads();
    const int TPB = (T + F.G - 1) / F.G, tb = blockIdx.x * TPB, te = (tb + TPB < T) ? tb + TPB : T;
    const int lane = F.lane; const float NINF = -__builtin_inff();
    const f32x4 bias = *(const f32x4*)(rb + 4 * lane);
    for (int t = tb + F.wave; t < te; t += 8) {
        const f32x4 lg = *(const f32x4*)(LG + (size_t)t * NE + 4 * lane);
        float sc[4], chv[4];
#pragma unroll
        for (int j = 0; j < 4; ++j) { sc[j] = 1.0f / (1.0f + expf(-lg[j])); chv[j] = sc[j] + bias[j]; }
        float m1 = NINF, m2 = NINF;
#pragma unroll
        for (int j = 0; j < 4; ++j) { if (chv[j] > m1) { m2 = m1; m1 = chv[j]; } else if (chv[j] > m2) m2 = chv[j]; }
#pragma unroll
        for (int o = 1; o < 8; o <<= 1) { const float b1 = __shfl_xor(m1, o), b2 = __shfl_xor(m2, o); const float n1 = fmaxf(m1, b1), n2 = fmaxf(fminf(m1, b1), fmaxf(m2, b2)); m1 = n1; m2 = n2; }
        const float gs = m1 + m2; const int g = lane >> 3; int rank = 0;
#pragma unroll
        for (int gg = 0; gg < 8; ++gg) { const float o = __shfl(gs, gg * 8); rank += (o > gs || (o == gs && gg < g)) ? 1 : 0; }
        const bool sel = rank < 4;
#pragma unroll
        for (int j = 0; j < 4; ++j) chv[j] = sel ? chv[j] : NINF;
        int my_e = 0; float my_s = 0.f, ssum = 0.f;
#pragma unroll
        for (int k = 0; k < TOPK; ++k) {
            float bv = chv[0]; int bi = 4 * lane;
#pragma unroll
            for (int j = 1; j < 4; ++j) if (chv[j] > bv) { bv = chv[j]; bi = 4 * lane + j; }
#pragma unroll
            for (int o = 1; o < 64; o <<= 1) { const float ov = __shfl_xor(bv, o); const int oi = __shfl_xor(bi, o); if (ov > bv || (ov == bv && oi < bi)) { bv = ov; bi = oi; } }
            const int j = bi & 3; const float scs = j == 0 ? sc[0] : (j == 1 ? sc[1] : (j == 2 ? sc[2] : sc[3]));
            const float sk = __shfl(scs, bi >> 2);
            if (lane == (bi >> 2)) { if (j == 0) chv[0] = NINF; else if (j == 1) chv[1] = NINF; else if (j == 2) chv[2] = NINF; else chv[3] = NINF; }
            ssum += sk; if (lane == k) { my_e = bi; my_s = sk; }
        }
        if (lane < TOPK) { TE[(size_t)t * TOPK + lane] = my_e; TG[(size_t)t * TOPK + lane] = my_s / ssum * ROUTED_SCALE; __hip_atomic_fetch_add(&hist[my_e], 1, __ATOMIC_RELAXED, __HIP_MEMORY_SCOPE_WORKGROUP); }
    }
    __syncthreads();
    if (F.tid < 256) CNT[(size_t)blockIdx.x * NE + F.tid] = hist[F.tid];
}

__device__ __forceinline__ void p11_place(Frame& F) {
    const int* TE = WSP(int, WS_TOPE); const float* TG = WSP(float, WS_TOPG); const int* CNT = WSP(int, WS_CNT);
    int* SLOT = WSP(int, WS_SLOT); int* RT = WSP(int, WS_ROWTOK); float* RG = WSP(float, WS_ROWGATE);
    LAS int* tot = (LAS int*)F.lds; LAS int* mine = tot + 256; LAS int* start = tot + 512; LAS int* cursor = tot + 1024;
    const int b = blockIdx.x;
    if (F.tid < 256) { int s = 0, m = 0; for (int bb = 0; bb < F.G; ++bb) { const int c = CNT[(size_t)bb * NE + F.tid]; s += c; if (bb < b) m += c; } tot[F.tid] = s; mine[F.tid] = m; cursor[F.tid] = 0; }
    __syncthreads();
    if (F.tid == 0) { int s = 0; for (int e = 0; e < NE; ++e) { start[e] = s; s += (tot[e] + 255) & ~255; } start[NE] = s; start[NE + 1] = s + T; }
    __syncthreads();
    const int TPB = (T + F.G - 1) / F.G, tb = b * TPB, te = (tb + TPB < T) ? tb + TPB : T;
    for (int i = tb * TOPK + F.tid; i < te * TOPK; i += 512) { const int e = TE[i]; const int pos = __hip_atomic_fetch_add(&cursor[e], 1, __ATOMIC_RELAXED, __HIP_MEMORY_SCOPE_WORKGROUP); const int row = start[e] + mine[e] + pos;
        RT[row] = i / TOPK; RG[row] = TG[i]; SLOT[i] = row; }
    const int shb = start[NE];
    for (int t = tb + F.tid; t < te; t += 512) { RT[shb + t] = t; RG[shb + t] = 1.0f; }
    for (int e = b; e < NE; e += F.G) { for (int r = start[e] + tot[e] + F.tid; r < start[e + 1]; r += 512) { RT[r] = 0; RG[r] = 0.f; } }
    if (b == 0) {
        if (F.tid < 257) { for (int pm = start[F.tid] >> 8; pm < (start[F.tid + 1] >> 8); ++pm) F.ctl[CW_BLKE + pm] = (unsigned)F.tid; }
        if (F.tid == 0) { F.ctl[CW_NBLK] = (unsigned)(start[NE + 1] >> 8); F.ctl[CW_SHBASE] = (unsigned)shb; }
    }
}

__device__ __forceinline__ void p14_combine(Frame& F) {
    const float* H1 = WSP(float, WS_H1); const bf16_t* YR = WSP(bf16_t, WS_YR); const int* SLOT = WSP(int, WS_SLOT);
    const float* lw = F.A.in[28]; const float* lb = F.A.in[29];
    const int shb = (int)__builtin_amdgcn_readfirstlane(ld_u32_sc1(F.ctl + CW_SHBASE));
    for (int t = F.gw; t < T; t += F.NGW) {
        f32x4 v[4];
#pragma unroll
        for (int j = 0; j < 4; ++j) v[j] = ALPHA * *(const f32x4*)(H1 + (size_t)t * D + 4 * F.lane + 256 * j);
#pragma unroll
        for (int k = 0; k <= TOPK; ++k) { const int row = k < TOPK ? SLOT[(size_t)t * TOPK + k] : shb + t; const bf16_t* yr = YR + (size_t)row * D + 4 * F.lane;
#pragma unroll
            for (int j = 0; j < 4; ++j) { const u32x2 w = *(const u32x2*)(yr + 256 * j); v[j][0] += bf2f(w.x & 0xffffu); v[j][1] += bf2f(w.x >> 16); v[j][2] += bf2f(w.y & 0xffffu); v[j][3] += bf2f(w.y >> 16); } }
        float s = 0.f;
#pragma unroll
        for (int j = 0; j < 4; ++j) s += (v[j][0] + v[j][1]) + (v[j][2] + v[j][3]);
        const float mean = wave_sum(s) * (1.f / D); float q = 0.f;
#pragma unroll
        for (int j = 0; j < 4; ++j) { v[j] = v[j] - mean; q += (v[j][0] * v[j][0] + v[j][1] * v[j][1]) + (v[j][2] * v[j][2] + v[j][3] * v[j][3]); }
        const float rstd = 1.0f / sqrtf(wave_sum(q) * (1.f / D) + LN_EPS);
#pragma unroll
        for (int j = 0; j < 4; ++j) { const int col = 4 * F.lane + 256 * j; const f32x4 w = *(const f32x4*)(lw + col), bb = *(const f32x4*)(lb + col);
            *(f32x4*)(F.out + (size_t)t * D + col) = v[j] * rstd * w + bb; }
    }
}

constexpr int N_PHASES = 17;
#ifndef SCAN_SEQ
#define SCAN_SEQ 0
#endif
__global__ void __launch_bounds__(512, 2) mk_fwd(Args args) {
    extern __shared__ __attribute__((aligned(16))) unsigned char lds_raw[];
    const int tid_ = threadIdx.x, wave_ = __builtin_amdgcn_readfirstlane(tid_ >> 6);
    Frame F{(LAS unsigned char*)lds_raw, tid_, tid_ & 63, wave_, (int)gridDim.x, (int)blockIdx.x * 8 + wave_, (int)gridDim.x * 8, args, args.out, args.ws, (unsigned*)(args.ws + WS_CTL)};
    volatile LAS unsigned* MISC = (volatile LAS unsigned*)(F.lds + MISC_OFF);
    for (int u = F.tid; u < (LDS_BYTES - RING_BYTES) / 4; u += 512) ((LAS unsigned*)(F.lds + RING_BYTES))[u] = 0u;
    __syncthreads();
    XcdBarrier bar; bar.bar = F.ctl + CW_BAR; bar.x = 0; bar.st = nullptr;
    if (!MK_SPLIT) bar = xcd_barrier_post(F.ctl + CW_BAR, MISC + 8);
    const int lo = args.ph_lo, hi = args.ph_hi;
#ifndef PH_MASK
#define PH_MASK 0x1ffff
#endif
#define IN(k) (((PH_MASK >> (k)) & 1) && lo <= (k) && (k) < hi)
#define SEAM(k) do { if (IN(k) && IN((k) + 1)) xcd_barrier(bar); } while (0)

    if (IN(0)) { p0_prologue(F); } SEAM(0);
    if (IN(1)) { pg8::Gemm g{WSP(bf16_t, WS_XB), WSP(bf16_t, WS_WT_IN), D, D, D}; pg8::StaticOrder S; S.init(T, NP, F.G, (int)blockIdx.x);
        EpiP E{WSP(bf16_t, WS_P)}; pg8::gemm_phase(F.lds, g, S, E); } SEAM(1);
    if (IN(2)) { p2_lora_in(F); p2_gmlp(F); } SEAM(2);
    if (IN(3)) { pg8::Gemm g{WSP(bf16_t, WS_LORAIN), WSP(bf16_t, WS_WT_LORA), LK, LK, LK}; pg8::StaticOrder S; S.init(T, 3072, F.G, (int)blockIdx.x);
        EpiLora E{WSP(float, WS_LOGW), WSP(bf16_t, WS_AA), WSP(bf16_t, WS_GG), F.A.in[3], F.A.in[5]}; pg8::gemm_phase(F.lds, g, S, E); } SEAM(3);
#if SCAN_SEQ
    if (IN(4)) { p4_scan_seq(F); } SEAM(4); SEAM(5); SEAM(6);
#else
    if (IN(4)) { scan_pass1(F); } SEAM(4);
    if (IN(5)) { scan_pass2(F); } SEAM(5);
    if (IN(6)) { scan_pass3(F); } SEAM(6);
#endif
    if (IN(7)) { pg8::Gemm g{WSP(bf16_t, WS_YA), WSP(bf16_t, WS_WT_OA), D, D, D}; pg8::StaticOrder S; S.init(T, D, F.G, (int)blockIdx.x);
        EpiMix<0> E{WSP(bf16_t, WS_P), WSP(float, WS_T1), nullptr, nullptr, D}; pg8::gemm_phase(F.lds, g, S, E); } SEAM(7);
    if (IN(8)) { pg8::Gemm g{WSP(bf16_t, WS_YB), WSP(bf16_t, WS_WT_OB), D, D, D}; pg8::StaticOrder S; S.init(T, D, F.G, (int)blockIdx.x);
        EpiMix<1> E{WSP(bf16_t, WS_P), WSP(float, WS_T1), WSP(bf16_t, WS_MIXIN), nullptr, D}; pg8::gemm_phase(F.lds, g, S, E); } SEAM(8);
    if (IN(9)) { pg8::Gemm g{WSP(bf16_t, WS_MIXIN), WSP(bf16_t, WS_WT_OUT), D, D, D}; pg8::StaticOrder S; S.init(T, D, F.G, (int)blockIdx.x);
        EpiMix<2> E{nullptr, WSP(float, WS_H1PRE), nullptr, F.A.in[0], D}; pg8::gemm_phase(F.lds, g, S, E); } SEAM(9);
    if (IN(10)) { p8_ln1(F); } SEAM(10);
    if (IN(11)) { pg8::Gemm g{WSP(bf16_t, WS_HR), WSP(bf16_t, WS_WT_R), HRK, HRK, HRK}; pg8::StaticOrder S; S.init(T, NE, F.G, (int)blockIdx.x);
        EpiMix<3> E{nullptr, WSP(float, WS_LOGITS), nullptr, nullptr, NE}; pg8::gemm_phase(F.lds, g, S, E); } SEAM(11);
    if (IN(12)) { p10_route(F); } SEAM(12);
    if (IN(13)) { p11_place(F); } SEAM(13);
    if (IN(14)) { pg8::Gemm g{WSP(bf16_t, WS_HR), WSP(bf16_t, WS_WT_GU), D, HRK, D};
        pg8::GroupedOrder<true> S{F.ctl + CW_BLKE, WSP(int, WS_ROWTOK), (int)__builtin_amdgcn_readfirstlane(ld_u32_sc1(F.ctl + CW_NBLK)), 2, F.G, (int)blockIdx.x, (size_t)512 * 1024 * 2};
        EpiAct E{WSP(bf16_t, WS_ACT)}; pg8::gemm_phase(F.lds, g, S, E); } SEAM(14);
    if (IN(15)) { pg8::Gemm g{WSP(bf16_t, WS_ACT), WSP(bf16_t, WS_WT_DN), 256, 256, 256};
        pg8::GroupedOrder<false> S{F.ctl + CW_BLKE, WSP(int, WS_ROWTOK), (int)__builtin_amdgcn_readfirstlane(ld_u32_sc1(F.ctl + CW_NBLK)), 4, F.G, (int)blockIdx.x, (size_t)1024 * 256 * 2};
        EpiDown E{WSP(bf16_t, WS_YR), WSP(float, WS_ROWGATE)}; pg8::gemm_phase(F.lds, g, S, E); } SEAM(15);
    if (IN(16)) { p14_combine(F); }
#undef IN
#undef SEAM
}

extern "C" void kernel_launch(void* const* d_in, const int* in_sizes, int n_in, void* d_out, int out_size, void* d_ws, size_t ws_size, hipStream_t stream) {
    static int grid = 0;
    if (grid == 0) {
        if (n_in != 30 || out_size != T * D || ws_size < WS_END) { fprintf(stderr, "kernel_launch: unexpected shapes: n_in %d out %d ws %zu (need %zu)\n", n_in, out_size, ws_size, (size_t)WS_END); grid = -1; return; }
        int dev = 0, cus = 0, per_cu = 0;
        if (hipGetDevice(&dev) != hipSuccess || hipDeviceGetAttribute(&cus, hipDeviceAttributeMultiprocessorCount, dev) != hipSuccess) { grid = -1; return; }
        if (hipFuncSetAttribute((const void*)mk_fwd, hipFuncAttributeMaxDynamicSharedMemorySize, LDS_BYTES) != hipSuccess) { fprintf(stderr, "kernel_launch: hipFuncSetAttribute failed\n"); grid = -1; return; }
        if (hipOccupancyMaxActiveBlocksPerMultiprocessor(&per_cu, (const void*)mk_fwd, 512, LDS_BYTES) != hipSuccess || per_cu < 1) { fprintf(stderr, "kernel_launch: occupancy query says %d\n", per_cu); }
        (void)hipGetLastError();
        grid = cus;
        if (grid > 1024) grid = 1024;
    }
    if (grid < 0) return;
    (void)hipMemsetAsync((char*)d_ws + WS_CTL, 0, CTL_ZERO_BYTES, stream);
    Args a{};
    for (int i = 0; i < 30; ++i) a.in[i] = (const float*)d_in[i];
    a.out = (float*)d_out; a.ws = (unsigned char*)d_ws;
#if MK_SPLIT
    for (int p = 0; p < N_PHASES; ++p) { a.ph_lo = p; a.ph_hi = p + 1; hipLaunchKernelGGL(mk_fwd, dim3(grid), dim3(512), LDS_BYTES, stream, a); }
#else
    a.ph_lo = 0; a.ph_hi = N_PHASES; hipLaunchKernelGGL(mk_fwd, dim3(grid), dim3(512), LDS_BYTES, stream, a);
#endif
}
```

```cpp
#include <hip/hip_runtime.h>
#include <cstdio>
#include <cstdint>

#ifndef MK_SPLIT
#define MK_SPLIT 0
#endif

#define LAS __attribute__((address_space(3)))
#define GAS __attribute__((address_space(1)))
typedef unsigned short bf16_t;
typedef short bf16x8 __attribute__((ext_vector_type(8)));
typedef float f32x4 __attribute__((ext_vector_type(4)));
typedef float f32x2 __attribute__((ext_vector_type(2)));
typedef unsigned u32x4 __attribute__((ext_vector_type(4)));
typedef unsigned u32x2 __attribute__((ext_vector_type(2)));

constexpr int T = 32768, D = 1024, SEQ = 8192, NH = 16, HD = 64;
constexpr int C_IN = 7456, NP = 7680;
constexpr int PC_R = 0, PC_K = 1024, PC_V = 2048, PC_L = 3072, PC_U = 3584, PC_GV = 4608, PC_GA = 5632, PC_GB = 6656;
constexpr int NE = 256, TOPK = 8;
constexpr int LK = 384;
constexpr int RMAX = 360448;
constexpr int HRK = 3072;
constexpr float LN_EPS = 1e-5f, GN_EPS = 64e-5f;
constexpr float ALPHA = 1.189207115002721f;
constexpr float ROUTED_SCALE = 2.5f;

constexpr size_t MiB = 1u << 20;
constexpr size_t WS_CTL = 0, CTL_ZERO_BYTES = 1 * MiB;
constexpr size_t WS_WT_IN = 2 * MiB;
constexpr size_t WS_WT_LORA = 17 * MiB;
constexpr size_t WS_WT_OA = 20 * MiB, WS_WT_OB = 22 * MiB, WS_WT_OUT = 24 * MiB;
constexpr size_t WS_WT_R = 26 * MiB;
constexpr size_t WS_WT_GU = 28 * MiB;
constexpr size_t WS_WT_DN = 285 * MiB;
constexpr size_t WS_H1 = 414 * MiB;
constexpr size_t WS_HR = 542 * MiB;
constexpr size_t WS_LOGITS = 734 * MiB;
constexpr size_t WS_TOPE = 766 * MiB;
constexpr size_t WS_TOPG = 767 * MiB;
constexpr size_t WS_SLOT = 768 * MiB;
constexpr size_t WS_CNT = 769 * MiB;
constexpr size_t WS_ROWTOK = 770 * MiB;
constexpr size_t WS_ROWGATE = 772 * MiB;
constexpr size_t WS_XB = 774 * MiB;
constexpr size_t WS_P = 838 * MiB;
constexpr size_t WS_LORAIN = 1318 * MiB;
constexpr size_t WS_LOGW = 1342 * MiB;
constexpr size_t WS_AA = 1470 * MiB;
constexpr size_t WS_GG = 1534 * MiB;
constexpr size_t WS_YA = 1598 * MiB;
constexpr size_t WS_YB = 1662 * MiB;
constexpr size_t WS_T1 = 1726 * MiB;
constexpr size_t WS_MIXIN = 1854 * MiB;
constexpr size_t WS_H1PRE = 1918 * MiB;
constexpr size_t WS_END = 2046 * MiB;
constexpr size_t WS_ACT = 774 * MiB;
constexpr size_t WS_YR = 950 * MiB;
constexpr size_t WS_PT = WS_H1;
constexpr size_t WS_QQ = WS_HR;
constexpr size_t WS_SC = WS_T1;
constexpr size_t WS_RH = WS_MIXIN;
constexpr size_t WS_Y0 = WS_H1PRE;
constexpr size_t WS_BV = WS_H1PRE + 64 * MiB;
static_assert(WS_ACT + (size_t)RMAX * 256 * 2 <= WS_YR && WS_YR + (size_t)RMAX * 1024 * 2 <= WS_END, "moe overlay");
static_assert(WS_WT_GU + (size_t)257 * 512 * 1024 * 2 <= WS_WT_DN && WS_WT_DN + (size_t)257 * 1024 * 256 * 2 <= WS_H1, "weights");
static_assert(WS_ROWGATE + (size_t)RMAX * 4 <= WS_XB && WS_ROWTOK + (size_t)RMAX * 4 <= WS_ROWGATE, "routing");
constexpr int CW_NBLK = 16;
constexpr int CW_SHBASE = 17;
constexpr int CW_CONVQ = 64;
constexpr int CW_GTOT = 512;
constexpr int CW_BLKE = 1024;
constexpr int CW_BAR = 8192;
static_assert((CW_BAR + 3456) * 4 <= (int)CTL_ZERO_BYTES, "ctl");

constexpr int RING_BYTES = 131072;
constexpr int LDS_BYTES = 163840;
constexpr int MISC_OFF = LDS_BYTES - 512;

__device__ __forceinline__ float bf2f(unsigned b) { return __uint_as_float(b << 16); }
typedef __bf16 bf16v2_t __attribute__((ext_vector_type(2)));
__device__ __forceinline__ unsigned cvt_pk_bf16(float lo, float hi) { const f32x2 v = {lo, hi}; const bf16v2_t b = __builtin_convertvector(v, bf16v2_t); return __builtin_bit_cast(unsigned, b); }
__device__ __forceinline__ unsigned f2bf(float f) { return cvt_pk_bf16(f, 0.f) & 0xffffu; }
__device__ __forceinline__ float wave_sum(float v) {
#pragma unroll
    for (int o = 1; o < 64; o <<= 1) v += __shfl_xor(v, o);
    return v;
}
__device__ __forceinline__ float sigmoidf_(float x) { return __builtin_amdgcn_rcpf(1.0f + __expf(-x)); }
__device__ __forceinline__ void unpack8(const u32x4 w, float (&f)[8]) {
    f[0] = bf2f(w.x & 0xffffu); f[1] = bf2f(w.x >> 16); f[2] = bf2f(w.y & 0xffffu); f[3] = bf2f(w.y >> 16);
    f[4] = bf2f(w.z & 0xffffu); f[5] = bf2f(w.z >> 16); f[6] = bf2f(w.w & 0xffffu); f[7] = bf2f(w.w >> 16);
}
__device__ __forceinline__ unsigned ld_u32_sc1(const unsigned* p) { return __hip_atomic_load(p, __ATOMIC_RELAXED, __HIP_MEMORY_SCOPE_AGENT); }

#define XB_TMO      128
#define XB_XCNT(j)  (256  + 64 * (j))
#define XB_XSUB(j)  (1280 + 64 * (j))
#define XB_XGEN(j)  (2304 + 64 * (j))
#define XB_TOP      3328
#define XB_TOPGEN   3392
#define XCD_BAR_WORDS 3456
#define XB_SPIN_CAP (1u << 18)
__device__ __forceinline__ unsigned xb_ld(unsigned* p)              { return __hip_atomic_load(p, __ATOMIC_RELAXED, __HIP_MEMORY_SCOPE_AGENT); }
__device__ __forceinline__ unsigned xb_add(unsigned* p, unsigned v) { return __hip_atomic_fetch_add(p, v, __ATOMIC_RELAXED, __HIP_MEMORY_SCOPE_AGENT); }
__device__ __forceinline__ unsigned xb_xcc_id() { return (unsigned)__builtin_amdgcn_s_getreg((3 << 11) | 20) & 0xFu; }
#define XB_SPIN(cond, bar) do { unsigned _sp = 0; while (cond) { __builtin_amdgcn_s_sleep(1); \
    if ((++_sp & 255u) == 0u) { if (xb_ld(&(bar)[XB_TMO])) break; if (_sp > XB_SPIN_CAP) { atomicAdd(&(bar)[XB_TMO], 1u); break; } } } } while (0)
struct XcdBarrier { unsigned* bar; unsigned x; volatile LAS unsigned* st; };
__device__ __forceinline__ XcdBarrier xcd_barrier_post(unsigned* bar, volatile LAS unsigned* st) {
    XcdBarrier b; b.bar = bar; b.x = xb_xcc_id(); b.st = st;
    if (threadIdx.x == 0) (void)xb_add(&bar[XB_XCNT(b.x)], 1u);
    return b;
}
__device__ __forceinline__ void xcd_barrier_complete(unsigned* bar, unsigned x, unsigned& nloc, unsigned& nx) {
    const unsigned G = gridDim.x * gridDim.y * gridDim.z;
    unsigned sum, cnt, mine, sp = 0u;
    for (;;) {
        sum = 0u; cnt = 0u; mine = 0u;
#pragma unroll
        for (unsigned j = 0; j < 16; ++j) { const unsigned c = xb_ld(&bar[XB_XCNT(j)]); sum += c; cnt += (c > 0u) ? 1u : 0u; mine = (j == x) ? c : mine; }
        if (sum == G) break;
        __builtin_amdgcn_s_sleep(1);
        if ((++sp & 255u) == 0u) { if (xb_ld(&bar[XB_TMO])) break; if (sp > XB_SPIN_CAP) { atomicAdd(&bar[XB_TMO], 1u); break; } }
    }
    nloc = mine > 0u ? mine : 1u; nx = cnt > 0u ? cnt : 1u;
}
__device__ __forceinline__ void xcd_barrier(const XcdBarrier& b) {
    asm volatile("s_waitcnt vmcnt(0)" ::: "memory");
    __syncthreads();
    if (threadIdx.x == 0) {
        unsigned* bar = b.bar;
        __builtin_amdgcn_s_waitcnt(0);
        unsigned nloc = b.st[0], nx = b.st[1];
        if (nloc == 0u) { xcd_barrier_complete(bar, b.x, nloc, nx); b.st[0] = nloc; b.st[1] = nx; }
        const unsigned old = xb_add(&bar[XB_XSUB(b.x)], 1u);
        const unsigned gen = old / nloc;
        if (old + 1u == (gen + 1u) * nloc) {
            __builtin_amdgcn_fence(__ATOMIC_RELEASE, "agent");
            asm volatile("s_waitcnt vmcnt(0)" ::: "memory");
            const unsigned og = xb_add(&bar[XB_TOP], 1u);
            const unsigned tg = og / nx;
            if (og + 1u == (tg + 1u) * nx) xb_add(&bar[XB_TOPGEN], 1u);
            else XB_SPIN(xb_ld(&bar[XB_TOPGEN]) == tg, bar);
            __builtin_amdgcn_fence(__ATOMIC_ACQUIRE, "agent");
            xb_add(&bar[XB_XGEN(b.x)], 1u);
            asm volatile("s_waitcnt vmcnt(0)" ::: "memory");
        } else {
            XB_SPIN(xb_ld(&bar[XB_XGEN(b.x)]) == gen, bar);
            __builtin_amdgcn_fence(__ATOMIC_ACQUIRE, "agent");
            asm volatile("s_waitcnt vmcnt(0)" ::: "memory");
        }
    }
    __syncthreads();
}

namespace pg8 {
constexpr int BM = 256, BK = 64, HALF = 128, HTB = HALF * BK * 2, STAGE_BYTES = 8 * HTB, NXCD = 8, WGM = 8;
__host__ __device__ __forceinline__ int lds_byte(int r, int c) { const int st = (r >> 4) * 2 + (c >> 5), rr = r & 15, cc = c & 31, ob = rr * 64 + cc * 2; return st * 1024 + (ob ^ (((ob >> 9) & 1) << 5)); }
__host__ __device__ __forceinline__ void stage_rc(int b, int& R, int& C) { const int st = b / 1024, sb = b % 1024, swz = sb ^ (((sb >> 9) & 1) << 5); R = (st >> 1) * 16 + swz / 64; C = (st & 1) * 32 + (swz % 64) / 2; }
__host__ __device__ __forceinline__ int perm32(int rho) { const int n = rho >> 4, i = rho & 15; return 8 * (i >> 2) + 4 * n + (i & 3); }

struct Unit { int pm, pn, aux; };
struct Gemm { const bf16_t* A; const bf16_t* Bt; int K, lda, ldb; };

struct StaticOrder {
    static constexpr bool GATHER = false;
    int nM, nN, nwg, G, c;
    __device__ void init(int M, int N, int G_, int c_) { nM = M / BM; nN = N / BM; nwg = nM * nN; G = G_; c = c_; }
    __device__ bool next(int i, Unit& u) const {
        const long L = (long)i * G + c; if (L >= nwg) return false;
        int wgid = (int)L; { const int q = nwg / NXCD, r = nwg % NXCD, xcd = wgid % NXCD, off = wgid / NXCD; wgid = (xcd < r ? xcd * (q + 1) : r * (q + 1) + (xcd - r) * q) + off; }
        const int nig = WGM * nN, gid = wgid / nig, fm = gid * WGM, gsz = (nM - fm) < WGM ? (nM - fm) : WGM;
        u.pm = fm + ((wgid % nig) % gsz); u.pn = (wgid % nig) / gsz; u.aux = 0; return true;
    }
    __device__ __forceinline__ const char* a_base(const Gemm& g, const Unit& u) const { return (const char*)g.A + (size_t)u.pm * BM * g.lda * 2; }
    __device__ __forceinline__ const char* b_base(const Gemm& g, const Unit& u) const { return (const char*)g.Bt + (size_t)u.pn * BM * g.ldb * 2; }
    __device__ __forceinline__ unsigned a_rowoff(const Gemm&, const Unit&, int) const { return 0u; }
};
template <bool GATH> struct GroupedOrder {
    static constexpr bool GATHER = GATH;
    const unsigned* blk_e; const int* row_tok; int nblk, nN, G, c; size_t wstride;
    __device__ bool next(int i, Unit& u) const {
        const int vc = (G % 8 == 0) ? (c % 8) * (G / 8) + c / 8 : c;
        const long L = (long)i * G + vc; if (L >= (long)nblk * nN) return false;
        u.pm = (int)(L / nN); u.pn = (int)(L % nN);
        u.aux = (int)__builtin_amdgcn_readfirstlane(ld_u32_sc1(blk_e + u.pm)); return true;
    }
    __device__ __forceinline__ const char* a_base(const Gemm& g, const Unit& u) const { return (const char*)g.A + (size_t)u.pm * BM * g.lda * 2; }
    __device__ __forceinline__ const char* b_base(const Gemm& g, const Unit& u) const { return (const char*)g.Bt + (size_t)u.aux * wstride + (size_t)u.pn * BM * g.ldb * 2; }
    __device__ __forceinline__ unsigned a_rowoff(const Gemm& g, const Unit& u, int r) const { return (unsigned)row_tok[u.pm * BM + r] * (unsigned)(g.lda * 2); }
};

template <class Epi, class Sched>
__device__ __forceinline__ void gemm_phase(LAS unsigned char* lds, const Gemm g, const Sched& S, const Epi& E) {
    int tid_o = threadIdx.x; asm volatile("" : "+v"(tid_o));
    const int tid = tid_o, wid = __builtin_amdgcn_readfirstlane(tid >> 6), lane = tid & 63, wr = wid >> 2, wc = wid & 3, fr = lane & 15, fq = lane >> 4;
    const int K = g.K, nt = K / BK;
    unsigned voffA[2], voffB[2]; int RA[2]; unsigned CA2[2];
#pragma unroll
    for (int i = 0; i < 2; ++i) { int R, C; stage_rc(tid * 16 + i * 8192, R, C); const int Rb = (R & ~31) + perm32(R & 31);
        voffA[i] = (unsigned)(R * g.lda + C) * 2u; voffB[i] = (unsigned)(Rb * g.ldb + C) * 2u; RA[i] = R; CA2[i] = (unsigned)C * 2u; }
    const size_t kstep = (size_t)(BK * 2);
    const size_t hstepA = (size_t)HALF * g.lda * 2, hstepB = (size_t)HALF * g.ldb * 2;
    const unsigned ldsw = (unsigned)wid * 1024u;
    const int aoff = lds_byte(wr * 64 + fr, fq * 8), boff = lds_byte(wc * 32 + fr, fq * 8);
#define PG8_SA(b, h) (((b) * 2 + (h)) * HTB)
#define PG8_SB(b, h) ((4 + (b) * 2 + (h)) * HTB)
#define PG8_STAGE(bufoff, gbase, voff) do { _Pragma("unroll") for (int _i = 0; _i < 2; ++_i) \
        __builtin_amdgcn_global_load_lds((const unsigned*)((const char*)(gbase) + (voff)[_i]), (LAS unsigned*)(lds + (bufoff) + ldsw + _i * 8192), 16, 0, 0); } while (0)
#define PG8_LDA(dst, b, h) do { _Pragma("unroll") for (int m = 0; m < 4; ++m) _Pragma("unroll") for (int k = 0; k < 2; ++k) dst[m][k] = *(const LAS bf16x8*)(lds + PG8_SA(b, h) + aoff + m * 2048 + k * 1024); } while (0)
#define PG8_LDB(dst, b, h) do { _Pragma("unroll") for (int n = 0; n < 2; ++n) _Pragma("unroll") for (int k = 0; k < 2; ++k) dst[n][k] = *(const LAS bf16x8*)(lds + PG8_SB(b, h) + boff + n * 2048 + k * 1024); } while (0)
#define PG8_MMA(ai, bj, At, Bt) do { __builtin_amdgcn_s_setprio(1); _Pragma("unroll") for (int m = 0; m < 4; ++m) _Pragma("unroll") for (int n = 0; n < 2; ++n) _Pragma("unroll") for (int k = 0; k < 2; ++k) \
        acc[ai][bj][m][n] = __builtin_amdgcn_mfma_f32_16x16x32_bf16(Bt[n][k], At[m][k], acc[ai][bj][m][n], 0, 0, 0); __builtin_amdgcn_s_setprio(0); } while (0)
#define PG8_WAIT_V(n) asm volatile("s_waitcnt vmcnt(" #n ")" ::: "memory")
#define PG8_WAIT_L(n) asm volatile("s_waitcnt lgkmcnt(" #n ")" ::: "memory")
#define PG8_BAR __builtin_amdgcn_s_barrier()
#define PG8_SCHED __builtin_amdgcn_sched_barrier(0)
    Unit cur, nxt; int ui = 0;
    if (!S.next(0, cur)) return;
    f32x4 acc[2][2][4][2];
#pragma unroll
    for (int a = 0; a < 2; ++a)
#pragma unroll
        for (int b = 0; b < 2; ++b)
#pragma unroll
            for (int m = 0; m < 4; ++m)
#pragma unroll
                for (int n = 0; n < 2; ++n) acc[a][b][m][n] = (f32x4){0.f, 0.f, 0.f, 0.f};
    bf16x8 At[4][2], B0[2][2], B1[2][2];
    unsigned gcur[2][2], gnxt[2][2];
    const char* cA = Sched::GATHER ? (const char*)g.A : S.a_base(g, cur); const char* cB = S.b_base(g, cur);
    if constexpr (Sched::GATHER) {
#pragma unroll
        for (int h = 0; h < 2; ++h)
#pragma unroll
            for (int i = 0; i < 2; ++i) { gcur[h][i] = S.a_rowoff(g, cur, h * HALF + RA[i]) + CA2[i]; gnxt[h][i] = gcur[h][i]; }
    }
#define PG8_STAGE_A(bufoff, base, h, GO) do { if constexpr (Sched::GATHER) { PG8_STAGE(bufoff, base, GO[h]); } else { PG8_STAGE(bufoff, (base) + (h) * hstepA, voffA); } } while (0)
    PG8_STAGE(PG8_SB(0, 0), cB, voffB); PG8_STAGE_A(PG8_SA(0, 0), cA, 0, gcur); PG8_STAGE(PG8_SB(0, 1), cB + hstepB, voffB); PG8_STAGE_A(PG8_SA(0, 1), cA, 1, gcur);
    if (wr == 1) PG8_BAR;
    PG8_WAIT_V(4); PG8_BAR;
    PG8_STAGE(PG8_SB(1, 0), cB + kstep, voffB); PG8_STAGE_A(PG8_SA(1, 0), cA + kstep, 0, gcur); PG8_STAGE(PG8_SB(1, 1), cB + hstepB + kstep, voffB);
    PG8_WAIT_V(6); PG8_BAR;
    for (;;) {
        const bool has_next = S.next(ui + 1, nxt);
        const char* nA = has_next ? (Sched::GATHER ? (const char*)g.A : S.a_base(g, nxt)) : cA; const char* nB = has_next ? S.b_base(g, nxt) : cB;
        if constexpr (Sched::GATHER) {
            if (has_next) {
#pragma unroll
                for (int h = 0; h < 2; ++h)
#pragma unroll
                    for (int i = 0; i < 2; ++i) gnxt[h][i] = S.a_rowoff(g, nxt, h * HALF + RA[i]) + CA2[i];
            }
        }
#pragma unroll 1
        for (int t = 0; t < nt; t += 2) {
            const bool last = (t == nt - 2);
            const char* a1 = cA + (size_t)(t + 1) * kstep;
            const char* a2 = last ? nA : cA + (size_t)(t + 2) * kstep; const char* b2 = last ? nB : cB + (size_t)(t + 2) * kstep;
            const char* a3 = a2 + kstep; const char* b3 = b2 + kstep;
            unsigned g2[2][2];
            if constexpr (Sched::GATHER) {
#pragma unroll
                for (int h = 0; h < 2; ++h)
#pragma unroll
                    for (int i = 0; i < 2; ++i) g2[h][i] = last ? gnxt[h][i] : gcur[h][i];
            }
            PG8_LDB(B0, 0, 0); PG8_SCHED; PG8_LDA(At, 0, 0); PG8_STAGE_A(PG8_SA(1, 1), a1, 1, gcur);
            PG8_WAIT_L(8); PG8_BAR; PG8_WAIT_L(0); PG8_MMA(0, 0, At, B0); PG8_BAR; PG8_SCHED;
            PG8_LDB(B1, 0, 1); PG8_STAGE(PG8_SB(0, 0), b2, voffB);
            PG8_BAR; PG8_WAIT_L(0); PG8_MMA(0, 1, At, B1); PG8_BAR;
            PG8_LDA(At, 0, 1); PG8_STAGE_A(PG8_SA(0, 0), a2, 0, g2);
            PG8_BAR; PG8_WAIT_L(0); PG8_MMA(1, 0, At, B0); PG8_BAR; PG8_SCHED;
            PG8_STAGE(PG8_SB(0, 1), b2 + hstepB, voffB);
            PG8_WAIT_V(6); PG8_BAR; PG8_MMA(1, 1, At, B1); PG8_BAR;
            PG8_LDB(B0, 1, 0); PG8_SCHED; PG8_LDA(At, 1, 0); PG8_STAGE_A(PG8_SA(0, 1), a2, 1, g2);
            PG8_WAIT_L(8); PG8_BAR; PG8_WAIT_L(0); PG8_MMA(0, 0, At, B0); PG8_BAR; PG8_SCHED;
            PG8_LDB(B1, 1, 1); PG8_STAGE(PG8_SB(1, 0), b3, voffB);
            PG8_BAR; PG8_WAIT_L(0); PG8_MMA(0, 1, At, B1); PG8_BAR;
            PG8_LDA(At, 1, 1); PG8_STAGE_A(PG8_SA(1, 0), a3, 0, g2);
            PG8_BAR; PG8_WAIT_L(0); PG8_MMA(1, 0, At, B0); PG8_BAR; PG8_SCHED;
            PG8_STAGE(PG8_SB(1, 1), b3 + hstepB, voffB);
            PG8_WAIT_V(6); PG8_BAR; PG8_MMA(1, 1, At, B1); PG8_BAR;
        }
        E(acc, cur, wr, wc, fr, fq);
        if (!has_next) break;
#pragma unroll
        for (int a = 0; a < 2; ++a)
#pragma unroll
            for (int b = 0; b < 2; ++b)
#pragma unroll
                for (int m = 0; m < 4; ++m)
#pragma unroll
                    for (int n = 0; n < 2; ++n) acc[a][b][m][n] = (f32x4){0.f, 0.f, 0.f, 0.f};
        cur = nxt; cA = nA; cB = nB; ++ui;
        if constexpr (Sched::GATHER) {
#pragma unroll
            for (int h = 0; h < 2; ++h)
#pragma unroll
                for (int i = 0; i < 2; ++i) gcur[h][i] = gnxt[h][i];
        }
    }
    PG8_WAIT_V(0);
    if (wr == 0) PG8_BAR;
    PG8_BAR;
#undef PG8_SA
#undef PG8_SB
#undef PG8_STAGE
#undef PG8_STAGE_A
#undef PG8_LDA
#undef PG8_LDB
#undef PG8_MMA
#undef PG8_WAIT_V
#undef PG8_WAIT_L
#undef PG8_BAR
#undef PG8_SCHED
}

__device__ __forceinline__ f32x2 gelu_pk(f32x2 v) {
    const f32x2 av = __builtin_elementwise_abs(v), d = av * 0.2316418882f + 1.0f;
    f32x2 t; t.x = __builtin_amdgcn_rcpf(d.x); t.y = __builtin_amdgcn_rcpf(d.y);
    f32x2 q = t * 0.5307027145f + (-0.7265760135f); q = q * t + 0.7107068705f; q = q * t + (-0.142248368f); q = q * t + 0.127414796f; q = q * t;
    const f32x2 s = (v * v) * (-0.72134752044f);
    f32x2 e; e.x = __builtin_amdgcn_exp2f(s.x); e.y = __builtin_amdgcn_exp2f(s.y);
    const f32x2 m = v * (q * e), r = v - m;
    f32x2 o; o.x = v.x < 0.f ? m.x : r.x; o.y = v.y < 0.f ? m.y : r.y; return o;
}
}
using pg8::Unit;

__device__ __forceinline__ u32x4 pack8(const f32x4 v0, const f32x4 v1) { u32x4 w; w.x = cvt_pk_bf16(v0[0], v0[1]); w.y = cvt_pk_bf16(v0[2], v0[3]); w.z = cvt_pk_bf16(v1[0], v1[1]); w.w = cvt_pk_bf16(v1[2], v1[3]); return w; }

struct EpiP {
    bf16_t* P;
    __device__ __forceinline__ void operator()(const f32x4 (&acc)[2][2][4][2], const Unit& u, int wr, int wc, int fr, int fq) const {
        const int row0 = u.pm * 256 + wr * 64 + fr, col0 = u.pn * 256 + wc * 32 + 8 * fq;
        const int act = u.pn < 14 ? 0 : (u.pn < 22 ? 1 : 2);
#pragma unroll
        for (int ai = 0; ai < 2; ++ai)
#pragma unroll
            for (int m = 0; m < 4; ++m) { const int row = row0 + ai * 128 + m * 16;
#pragma unroll
                for (int bj = 0; bj < 2; ++bj) { f32x4 v0 = acc[ai][bj][m][0], v1 = acc[ai][bj][m][1];
                    if (act == 2) {
#pragma unroll
                        for (int j = 0; j < 4; ++j) { v0[j] = sigmoidf_(v0[j]); v1[j] = sigmoidf_(v1[j]); } }
                    *(u32x4*)(P + (size_t)row * NP + col0 + bj * 128) = pack8(v0, v1); } }
    }
};
struct EpiLora {
    float* LOGW; bf16_t* AA; bf16_t* GG; const float* w0; const float* a0;
    __device__ __forceinline__ void operator()(const f32x4 (&acc)[2][2][4][2], const Unit& u, int wr, int wc, int fr, int fq) const {
        const int row0 = u.pm * 256 + wr * 64 + fr, seg = u.pn >> 2, colt = (u.pn & 3) * 256 + wc * 32 + 8 * fq;
        const float* bsrc = seg == 0 ? w0 : a0;
        f32x4 bb[2][2];
#pragma unroll
        for (int bj = 0; bj < 2; ++bj) { bb[bj][0] = *(const f32x4*)(bsrc + colt + bj * 128); bb[bj][1] = *(const f32x4*)(bsrc + colt + bj * 128 + 4); }
#pragma unroll
        for (int ai = 0; ai < 2; ++ai)
#pragma unroll
            for (int m = 0; m < 4; ++m) { const int row = row0 + ai * 128 + m * 16;
#pragma unroll
                for (int bj = 0; bj < 2; ++bj) { f32x4 v0 = acc[ai][bj][m][0], v1 = acc[ai][bj][m][1];
                    const int col = colt + bj * 128;
                    if (seg == 0) {
#pragma unroll
                        for (int j = 0; j < 4; ++j) {
                            { const float z = bb[bj][0][j] + v0[j]; const float sp = fmaxf(-z, 0.f) + __logf(1.0f + __expf(-fabsf(z))); v0[j] = -__expf(-sp - 0.5f); }
                            { const float z = bb[bj][1][j] + v1[j]; const float sp = fmaxf(-z, 0.f) + __logf(1.0f + __expf(-fabsf(z))); v1[j] = -__expf(-sp - 0.5f); } }
                        float* o = LOGW + (size_t)row * D + col; *(f32x4*)o = v0; *(f32x4*)(o + 4) = v1;
                    } else if (seg == 1) {
#pragma unroll
                        for (int j = 0; j < 4; ++j) { v0[j] = sigmoidf_(bb[bj][0][j] + v0[j]); v1[j] = sigmoidf_(bb[bj][1][j] + v1[j]); }
                        *(u32x4*)(AA + (size_t)row * D + col) = pack8(v0, v1);
                    } else {
                        *(u32x4*)(GG + (size_t)row * D + col) = pack8(v0, v1);
                    }
                    __builtin_amdgcn_sched_barrier(0); } }
    }
};
template <int MODE> struct EpiMix {
    const bf16_t* P; float* F; bf16_t* Bo; const float* X; int ldc;
    __device__ __forceinline__ void operator()(const f32x4 (&acc)[2][2][4][2], const Unit& u, int wr, int wc, int fr, int fq) const {
        const int row0 = u.pm * 256 + wr * 64 + fr, col0 = u.pn * 256 + wc * 32 + 8 * fq;
#pragma unroll
        for (int ai = 0; ai < 2; ++ai)
#pragma unroll
            for (int m = 0; m < 4; ++m) { const int row = row0 + ai * 128 + m * 16;
#pragma unroll
                for (int bj = 0; bj < 2; ++bj) { f32x4 v0 = acc[ai][bj][m][0], v1 = acc[ai][bj][m][1];
                    const int col = col0 + bj * 128;
                    if (MODE == 0 || MODE == 1) {
                        const u32x4 gw = *(const u32x4*)(P + (size_t)row * NP + (MODE == 0 ? PC_GA : PC_GB) + col); float gf[8]; unpack8(gw, gf);
#pragma unroll
                        for (int j = 0; j < 4; ++j) { v0[j] *= gf[j]; v1[j] *= gf[4 + j]; }
                    }
                    if (MODE == 0) { float* o = F + (size_t)row * D + col; *(f32x4*)o = v0; *(f32x4*)(o + 4) = v1; }
                    if (MODE == 1) { const float* t1 = F + (size_t)row * D + col; v0 = v0 + *(const f32x4*)t1; v1 = v1 + *(const f32x4*)(t1 + 4); *(u32x4*)(Bo + (size_t)row * D + col) = pack8(v0, v1); }
                    if (MODE == 2) { const float* xr = X + (size_t)row * D + col; v0 = v0 + ALPHA * *(const f32x4*)xr; v1 = v1 + ALPHA * *(const f32x4*)(xr + 4);
                        float* o = F + (size_t)row * D + col; *(f32x4*)o = v0; *(f32x4*)(o + 4) = v1; }
                    if (MODE == 3) { float* o = F + (size_t)row * ldc + col; *(f32x4*)o = v0; *(f32x4*)(o + 4) = v1; } } }
    }
};
struct EpiAct {
    bf16_t* ACT;
    __device__ __forceinline__ void operator()(const f32x4 (&acc)[2][2][4][2], const Unit& u, int wr, int wc, int fr, int fq) const {
        const int row0 = u.pm * 256 + wr * 64 + fr, col = u.pn * 128 + wc * 32 + 8 * fq;
#pragma unroll
        for (int ai = 0; ai < 2; ++ai)
#pragma unroll
            for (int m = 0; m < 4; ++m) { const int row = row0 + ai * 128 + m * 16;
                f32x4 g0 = acc[ai][0][m][0], g1 = acc[ai][0][m][1]; const f32x4 u0 = acc[ai][1][m][0], u1 = acc[ai][1][m][1];
#pragma unroll
                for (int j = 0; j < 4; ++j) { g0[j] = g0[j] * sigmoidf_(g0[j]) * u0[j]; g1[j] = g1[j] * sigmoidf_(g1[j]) * u1[j]; }
                *(u32x4*)(ACT + (size_t)row * 256 + col) = pack8(g0, g1); }
    }
};
struct EpiDown {
    bf16_t* YR; const float* row_gate;
    __device__ __forceinline__ void operator()(const f32x4 (&acc)[2][2][4][2], const Unit& u, int wr, int wc, int fr, int fq) const {
        const int row0 = u.pm * 256 + wr * 64 + fr, col0 = u.pn * 256 + wc * 32 + 8 * fq;
#pragma unroll
        for (int ai = 0; ai < 2; ++ai)
#pragma unroll
            for (int m = 0; m < 4; ++m) { const int row = row0 + ai * 128 + m * 16; const float gt = row_gate[row];
#pragma unroll
                for (int bj = 0; bj < 2; ++bj) { const f32x4 v0 = acc[ai][bj][m][0] * gt, v1 = acc[ai][bj][m][1] * gt;
                    *(u32x4*)(YR + (size_t)row * D + col0 + bj * 128) = pack8(v0, v1); } }
    }
};

struct Args { const float* in[30]; float* out; unsigned char* ws; int ph_lo, ph_hi; };
struct Frame {
    LAS unsigned char* lds;
    int tid, lane, wave, G, gw, NGW;
    const struct Args& A; float* out; unsigned char* ws; unsigned* ctl;
};
#define WSP(T_, off) ((T_*)(F.ws + (off)))

struct TrItem { const float* W; int N, k0, n0; bf16_t* WT; int ldo, drow0; };
__device__ __forceinline__ void tr_load(f32x4 (&v)[8], const TrItem& t, int lane) {
#pragma unroll
    for (int i = 0; i < 8; ++i) v[i] = *(const f32x4*)(t.W + (size_t)(t.k0 + (lane >> 3) + 8 * i) * t.N + t.n0 + 4 * (lane & 7));
}
__device__ __forceinline__ void tr_store(const f32x4 (&v)[8], const TrItem& t, LAS float* scr, int lane) {
#pragma unroll
    for (int i = 0; i < 8; ++i) { LAS float* d = scr + ((lane >> 3) + 8 * i) * 33 + 4 * (lane & 7); d[0] = v[i][0]; d[1] = v[i][1]; d[2] = v[i][2]; d[3] = v[i][3]; }
    asm volatile("s_waitcnt lgkmcnt(0)" ::: "memory");
    const int c = lane & 7;
#pragma unroll
    for (int j = 0; j < 4; ++j) { const int n = (lane >> 3) + 8 * j; const LAS float* s = scr + (8 * c) * 33 + n;
        u32x4 o; o.x = cvt_pk_bf16(s[0 * 33], s[1 * 33]); o.y = cvt_pk_bf16(s[2 * 33], s[3 * 33]); o.z = cvt_pk_bf16(s[4 * 33], s[5 * 33]); o.w = cvt_pk_bf16(s[6 * 33], s[7 * 33]);
        *(u32x4*)(t.WT + (size_t)(t.drow0 + n) * t.ldo + t.k0 + 8 * c) = o; }
    asm volatile("s_waitcnt lgkmcnt(0)" ::: "memory");
}
constexpr int I_GU = 16 * 16, I_DN = 4 * 32, N_EXPERT_ITEMS = 257 * I_GU + 257 * I_DN;
__device__ __forceinline__ TrItem expert_item(Frame& F, int it) {
    TrItem t; int r = it;
    if (r < 257 * I_GU) { const int e = r / I_GU, q = r % I_GU, kb = q / 16, nb = q % 16, n0 = nb * 32;
        t.W = e < 256 ? F.A.in[24] + (size_t)e * 1024 * 512 : F.A.in[26]; t.N = 512; t.k0 = kb * 64; t.n0 = n0;
        const int half = n0 >> 8, idx = n0 & 255; t.drow0 = (idx >> 7) * 256 + half * 128 + (idx & 127);
        t.WT = WSP(bf16_t, WS_WT_GU) + (size_t)e * 512 * 1024; t.ldo = 1024; return t; }
    r -= 257 * I_GU;
    { const int e = r / I_DN, q = r % I_DN, kb = q / 32, nb = q % 32;
        t.W = e < 256 ? F.A.in[25] + (size_t)e * 256 * 1024 : F.A.in[27]; t.N = 1024; t.k0 = kb * 64; t.n0 = nb * 32; t.drow0 = nb * 32;
        t.WT = WSP(bf16_t, WS_WT_DN) + (size_t)e * 1024 * 256; t.ldo = 256; return t; }
}
__device__ __forceinline__ void p0b_expert_weights(Frame& F) {
    LAS float* scr = (LAS float*)(F.lds + F.wave * 8448);
    for (;;) {
        int base = 0; if (F.lane == 0) base = (int)__hip_atomic_fetch_add(F.ctl + CW_CONVQ, 16u, __ATOMIC_RELAXED, __HIP_MEMORY_SCOPE_AGENT);
        base = __builtin_amdgcn_readfirstlane(base);
        if (base >= N_EXPERT_ITEMS) break;
        const int lim = base + 16 < N_EXPERT_ITEMS ? base + 16 : N_EXPERT_ITEMS;
        f32x4 va[8], vb[8];
        TrItem ta = expert_item(F, base), tb = ta; tr_load(va, ta, F.lane);
#pragma unroll 1
        for (int it = base; it < lim; it += 2) {
            const bool hb = it + 1 < lim; tb = expert_item(F, hb ? it + 1 : it); tr_load(vb, tb, F.lane);
            tr_store(va, ta, scr, F.lane);
            const bool ha = it + 2 < lim; ta = expert_item(F, ha ? it + 2 : it); tr_load(va, ta, F.lane);
            if (hb) tr_store(vb, tb, scr, F.lane);
        }
    }
}
__device__ __forceinline__ void p0_prologue(Frame& F) {
    LAS float* scr = (LAS float*)(F.lds + F.wave * 8448);
    constexpr int I_IN = 16 * 233, I_SQ = 16 * 32;
    constexpr int NITEMS = I_IN + 3 * I_SQ;
    for (int it = F.gw; it < NITEMS; it += F.NGW) {
        int r = it; TrItem t; f32x4 v[8];
        if (r < I_IN) { const int kb = r / 233, nb = r % 233, n0 = nb * 32; t = TrItem{F.A.in[1], C_IN, kb * 64, n0, WSP(bf16_t, WS_WT_IN), D, n0 < 3360 ? n0 : n0 + 224}; }
        else { r -= I_IN; const int w = r / I_SQ, q = r % I_SQ, kb = q / 32, nb = q % 32;
            t = TrItem{w == 0 ? F.A.in[17] : (w == 1 ? F.A.in[18] : F.A.in[19]), D, kb * 64, nb * 32, WSP(bf16_t, w == 0 ? WS_WT_OA : (w == 1 ? WS_WT_OB : WS_WT_OUT)), D, nb * 32}; }
        tr_load(v, t, F.lane); tr_store(v, t, scr, F.lane);
    }
    const size_t gt = (size_t)blockIdx.x * 512 + F.tid, NT = (size_t)F.G * 512;
    { bf16_t* w = WSP(bf16_t, WS_WT_IN) + (size_t)3360 * D; for (size_t i = gt; i < (size_t)224 * D / 8; i += NT) ((u32x4*)w)[i] = (u32x4){0u, 0u, 0u, 0u}; }
    { bf16_t* w = WSP(bf16_t, WS_WT_LORA);
      for (size_t i = gt; i < (size_t)3072 * LK; i += NT) { const int n = (int)(i / LK), k = (int)(i % LK); float v = 0.f;
          if (n < 1024) { if (k < 64) v = F.A.in[4][(size_t)k * D + n]; }
          else if (n < 2048) { if (k >= 64 && k < 128) v = F.A.in[6][(size_t)(k - 64) * D + (n - 1024)]; }
          else { if (k >= 128 && k < 288) v = F.A.in[7][(size_t)(k - 128) * D + (n - 2048)]; }
          w[i] = (bf16_t)f2bf(v); } }
    { bf16_t* w = WSP(bf16_t, WS_WT_R);
      for (size_t i = gt; i < (size_t)256 * HRK; i += NT) { const int n = (int)(i / HRK), k = (int)(i % HRK), kk = k & 1023, seg = k >> 10;
          const float v = F.A.in[22][(size_t)kk * NE + n]; const unsigned hi = f2bf(v); const float lo = v - bf2f(hi);
          w[i] = (bf16_t)(seg == 2 ? f2bf(lo) : hi); } }
    { const f32x4* x = (const f32x4*)F.A.in[0]; u32x2* xb = WSP(u32x2, WS_XB);
      for (size_t i = gt; i < (size_t)T * D / 4; i += NT) { const f32x4 v = x[i]; u32x2 o; o.x = cvt_pk_bf16(v[0], v[1]); o.y = cvt_pk_bf16(v[2], v[3]); xb[i] = o; } }
}

__device__ __forceinline__ void p2_lora_in(Frame& F) {
    const bf16_t* P = WSP(bf16_t, WS_P); bf16_t* L = WSP(bf16_t, WS_LORAIN); const float* mu = F.A.in[2];
    for (int t = F.gw; t < T; t += F.NGW) {
        const bool first = (t % SEQ) == 0;
#pragma unroll
        for (int j = 0; j < 6; ++j) { const int c = F.lane + 64 * j; float v = 0.f;
            if (c < 288) { const float cur = bf2f(P[(size_t)t * NP + PC_L + c]); const float prev = first ? 0.f : bf2f(P[(size_t)(t - 1) * NP + PC_L + c]);
                const float m = cur + mu[3072 + c] * (prev - cur);
                v = c < 64 ? tanhf(m) : (c < 128 ? m : sigmoidf_(m)); }
            L[(size_t)t * LK + c] = (bf16_t)f2bf(v); }
    }
}

__device__ __forceinline__ void p2_gmlp(Frame& F) {
    const bf16_t* P = WSP(bf16_t, WS_P); bf16_t* YB = WSP(bf16_t, WS_YB);
    const float* lnw = F.A.in[13]; const float* lnb = F.A.in[14]; const float* sw = F.A.in[15]; const float* sb = F.A.in[16];
    LAS bf16_t* VT = (LAS bf16_t*)F.lds;
    LAS float* ST = (LAS float*)(F.lds + 36864);
    const int lane = F.lane, wave = F.wave, fr = lane & 15, fq = lane >> 4;
    for (int ch = blockIdx.x; ch < T / 128; ch += F.G) {
        const int t0 = ch * 128;
        for (int i = 0; i < 16; ++i) { const int tl = wave * 16 + i; const bf16_t* vr = P + (size_t)(t0 + tl) * NP + PC_GV;
            float f0[8], f1[8]; unpack8(*(const u32x4*)(vr + lane * 8), f0); unpack8(*(const u32x4*)(vr + 512 + lane * 8), f1);
#pragma unroll
            for (int j = 0; j < 8; j += 2) { const f32x2 a = pg8::gelu_pk((f32x2){f0[j], f0[j + 1]}), b = pg8::gelu_pk((f32x2){f1[j], f1[j + 1]}); f0[j] = a.x; f0[j + 1] = a.y; f1[j] = b.x; f1[j + 1] = b.y; }
            float s = 0.f;
#pragma unroll
            for (int j = 0; j < 8; ++j) s += f0[j] + f1[j];
            const float mean = wave_sum(s) * (1.f / 1024.f); float q = 0.f;
#pragma unroll
            for (int j = 0; j < 8; ++j) { const float a = f0[j] - mean, b = f1[j] - mean; q += a * a + b * b; }
            const float rstd = 1.0f / sqrtf(wave_sum(q) * (1.f / 1024.f) + LN_EPS);
            if (lane == 0) { ST[tl * 2] = mean; ST[tl * 2 + 1] = rstd; } }
        __syncthreads();
        for (int g = 0; g < 8; ++g) {
            { const int s = F.tid >> 2, d0 = (F.tid & 3) * 32; const float mean = ST[s * 2], rstd = ST[s * 2 + 1];
              const bf16_t* vr = P + (size_t)(t0 + s) * NP + PC_GV + g * 128 + d0;
#pragma unroll
              for (int q4 = 0; q4 < 4; ++q4) { float f[8]; unpack8(*(const u32x4*)(vr + q4 * 8), f);
#pragma unroll
                  for (int j = 0; j < 8; j += 2) { const f32x2 a = pg8::gelu_pk((f32x2){f[j], f[j + 1]}); f[j] = a.x; f[j + 1] = a.y; }
#pragma unroll
                  for (int j = 0; j < 8; ++j) { const int d = d0 + q4 * 8 + j; const float v = (f[j] - mean) * rstd * lnw[g * 128 + d] + lnb[g * 128 + d];
                      VT[d * 136 + s] = (bf16_t)f2bf(v); } } }
            __syncthreads();
            f32x4 acc[8];
#pragma unroll
            for (int n = 0; n < 8; ++n) acc[n] = (f32x4){0.f, 0.f, 0.f, 0.f};
            const int tl = wave * 16 + fr;
            const float* wrow = sw + ((size_t)g * 128 + tl) * 128;
#pragma unroll
            for (int ks = 0; ks < 4; ++ks) {
                if (ks * 32 <= wave * 16 + 15) {
                    const int s0 = ks * 32 + fq * 8;
                    const f32x4 w0 = *(const f32x4*)(wrow + s0), w1 = *(const f32x4*)(wrow + s0 + 4);
                    float wf[8] = {w0[0], w0[1], w0[2], w0[3], w1[0], w1[1], w1[2], w1[3]};
#pragma unroll
                    for (int j = 0; j < 8; ++j) wf[j] = (s0 + j <= tl) ? wf[j] : 0.f;
                    u32x4 aw; aw.x = cvt_pk_bf16(wf[0], wf[1]); aw.y = cvt_pk_bf16(wf[2], wf[3]); aw.z = cvt_pk_bf16(wf[4], wf[5]); aw.w = cvt_pk_bf16(wf[6], wf[7]);
                    const bf16x8 af = __builtin_bit_cast(bf16x8, aw);
#pragma unroll
                    for (int n = 0; n < 8; ++n) { const bf16x8 bfrag = *(const LAS bf16x8*)(VT + (n * 16 + fr) * 136 + s0);
                        acc[n] = __builtin_amdgcn_mfma_f32_16x16x32_bf16(bfrag, af, acc[n], 0, 0, 0); }
                }
            }
            const float bias = sb[g * 128 + tl];
            const bf16_t* ur = P + (size_t)(t0 + tl) * NP + PC_U + g * 128; bf16_t* yr = YB + (size_t)(t0 + tl) * D + g * 128;
#pragma unroll
            for (int n = 0; n < 8; ++n) { const int d = n * 16 + 4 * fq; const u32x2 uw = *(const u32x2*)(ur + d);
                const f32x2 u01 = pg8::gelu_pk((f32x2){bf2f(uw.x & 0xffffu), bf2f(uw.x >> 16)}), u23 = pg8::gelu_pk((f32x2){bf2f(uw.y & 0xffffu), bf2f(uw.y >> 16)});
                const float o0 = u01.x * (acc[n][0] + bias), o1 = u01.y * (acc[n][1] + bias), o2 = u23.x * (acc[n][2] + bias), o3 = u23.y * (acc[n][3] + bias);
                u32x2 o; o.x = cvt_pk_bf16(o0, o1); o.y = cvt_pk_bf16(o2, o3); *(u32x2*)(yr + d) = o; }
            __syncthreads();
        }
    }
}

__device__ __forceinline__ void p4_scan_seq(Frame& F) {
    if (F.wave != 0) return;
    const bf16_t* P = WSP(bf16_t, WS_P); const float* LOGW = WSP(float, WS_LOGW); const bf16_t* AA = WSP(bf16_t, WS_AA); const bf16_t* GG = WSP(bf16_t, WS_GG); bf16_t* YA = WSP(bf16_t, WS_YA);
    LAS float* V = (LAS float*)F.lds;
    const int lane = F.lane;
    for (int bh = blockIdx.x; bh < 4 * NH; bh += F.G) {
        const int b = bh / NH, h = bh % NH, c = h * HD + lane;
        const float mu_r = F.A.in[2][c], mu_k = F.A.in[2][1024 + c], mu_v = F.A.in[2][2048 + c];
        const float k_k = F.A.in[8][c], k_a = F.A.in[9][c], r_k = F.A.in[10][c], gn_w = F.A.in[11][c], gn_b = F.A.in[12][c];
        float S[64];
#pragma unroll
        for (int j = 0; j < 64; ++j) S[j] = 0.f;
        float pr = 0.f, pk = 0.f, pv = 0.f;
        const size_t row0 = (size_t)b * SEQ;
        float cr = bf2f(P[row0 * NP + PC_R + c]), ck = bf2f(P[row0 * NP + PC_K + c]), cv = bf2f(P[row0 * NP + PC_V + c]);
        float cw = LOGW[row0 * D + c], ca = bf2f(AA[row0 * D + c]), cg = bf2f(GG[row0 * D + c]);
#pragma unroll 1
        for (int t = 0; t < SEQ; ++t) {
            const size_t rown = row0 + (t + 1 < SEQ ? t + 1 : t);
            const float nr = bf2f(P[rown * NP + PC_R + c]), nk = bf2f(P[rown * NP + PC_K + c]), nv = bf2f(P[rown * NP + PC_V + c]);
            const float nw = LOGW[rown * D + c], na = bf2f(AA[rown * D + c]), ng = bf2f(GG[rown * D + c]);
            const float r = cr + mu_r * (pr - cr), k = ck + mu_k * (pk - ck), v = cv + mu_v * (pv - cv);
            pr = cr; pk = ck; pv = cv;
            const float a = ca;
            float kk = k * k_k; const float nrm = sqrtf(wave_sum(kk * kk)); kk = kk / fmaxf(nrm, 1e-12f);
            const float kp = k * (1.0f + (a - 1.0f) * k_a);
            const float w = __expf(cw);
            V[lane] = w; V[64 + lane] = -kk; V[128 + lane] = kk * a; V[192 + lane] = kp; V[256 + lane] = r;
            asm volatile("s_waitcnt lgkmcnt(0)" ::: "memory");
            float sa = 0.f;
#pragma unroll
            for (int j = 0; j < 64; j += 4) { const f32x4 av = *(const LAS f32x4*)(V + 64 + j); sa += S[j] * av[0] + S[j + 1] * av[1] + S[j + 2] * av[2] + S[j + 3] * av[3]; }
            float y = 0.f;
#pragma unroll
            for (int j = 0; j < 64; j += 4) { const f32x4 wv = *(const LAS f32x4*)(V + j), bv = *(const LAS f32x4*)(V + 128 + j), kv = *(const LAS f32x4*)(V + 192 + j), rv = *(const LAS f32x4*)(V + 256 + j);
#pragma unroll
                for (int q = 0; q < 4; ++q) { S[j + q] = S[j + q] * wv[q] + sa * bv[q] + v * kv[q]; y += S[j + q] * rv[q]; }
                if ((j & 12) == 12) asm volatile("" ::: "memory"); }
            const float mean = wave_sum(y) * (1.f / 64.f); const float dy = y - mean; const float var = wave_sum(dy * dy) * (1.f / 64.f);
            const float yn = dy * (1.0f / sqrtf(var + GN_EPS)) * gn_w + gn_b;
            const float bonus = wave_sum(r * kp * r_k) * v;
            YA[(row0 + t) * D + c] = (bf16_t)f2bf((yn + bonus) * cg);
            asm volatile("s_waitcnt lgkmcnt(0)" ::: "memory");
            cr = nr; ck = nk; cv = nv; cw = nw; ca = na; cg = ng;
        }
    }
}


constexpr int NCH2 = SEQ / 32;
constexpr int TS2 = 72;
constexpr int WTILE = 32 * TS2 * 2;
constexpr int WLDS = 4 * WTILE + 256;
static_assert(8 * WLDS <= MISC_OFF, "scan LDS");
typedef __attribute__((address_space(3))) bf16_t lbf16;
typedef short s16x4 __attribute__((ext_vector_type(4)));
__device__ __forceinline__ f32x4 mfma16(const bf16x8 a, const bf16x8 b, const f32x4 c) { return __builtin_amdgcn_mfma_f32_16x16x32_bf16(a, b, c, 0, 0, 0); }
__device__ __forceinline__ u32x2 pk4(const f32x4 v) { u32x2 o; o.x = cvt_pk_bf16(v[0], v[1]); o.y = cvt_pk_bf16(v[2], v[3]); return o; }
__device__ __forceinline__ bf16x8 mkfrag(const u32x2 lo, const u32x2 hi) { u32x4 t; t.x = lo.x; t.y = lo.y; t.z = hi.x; t.w = hi.y; return __builtin_bit_cast(bf16x8, t); }
__device__ __forceinline__ f32x4 up4(const u32x2 w) { return (f32x4){bf2f(w.x & 0xffffu), bf2f(w.x >> 16), bf2f(w.y & 0xffffu), bf2f(w.y >> 16)}; }
__device__ __forceinline__ void unfrag(const bf16x8 f, f32x4& lo, f32x4& hi) { const u32x4 t = __builtin_bit_cast(u32x4, f); u32x2 a; a.x = t.x; a.y = t.y; u32x2 b; b.x = t.z; b.y = t.w; lo = up4(a); hi = up4(b); }
__device__ __forceinline__ bf16x8 tr_frag(const lbf16* tile, int ct, int fr, int fq) {
    const lbf16* p = tile + (4 * fq + (fr >> 2)) * TS2 + 16 * ct + 4 * (fr & 3);
    const s16x4 lo = __builtin_amdgcn_ds_read_tr16_b64_v4i16((LAS s16x4*)p), hi = __builtin_amdgcn_ds_read_tr16_b64_v4i16((LAS s16x4*)(p + 16 * TS2));
    return __builtin_shufflevector(lo, hi, 0, 1, 2, 3, 4, 5, 6, 7);
}
__device__ __forceinline__ void prod32(const bf16x8 (&X)[2], const bf16x8 (&Y)[2], const bf16x8* init, bf16x8 (&R)[2]) {
#pragma unroll
    for (int mt = 0; mt < 2; ++mt) { f32x4 d0 = (f32x4){0.f, 0.f, 0.f, 0.f}, d1 = d0; if (init) unfrag(init[mt], d0, d1);
        d0 = mfma16(Y[0], X[mt], d0); d1 = mfma16(Y[1], X[mt], d1); R[mt] = mkfrag(pk4(d0), pk4(d1)); }
}
#define WAVE_LDS_SYNC() do { asm volatile("s_waitcnt lgkmcnt(0)" ::: "memory"); __builtin_amdgcn_wave_barrier(); } while (0)

__device__ __forceinline__ void scan_pass1(Frame& F) {
    const bf16_t* P = WSP(bf16_t, WS_P); const float* LOGW = WSP(float, WS_LOGW); const bf16_t* AA = WSP(bf16_t, WS_AA);
    bf16_t* PT = WSP(bf16_t, WS_PT); bf16_t* QQ = WSP(bf16_t, WS_QQ); bf16_t* RH = WSP(bf16_t, WS_RH); bf16_t* Y0 = WSP(bf16_t, WS_Y0); bf16_t* BV = WSP(bf16_t, WS_BV);
    const float* mu = F.A.in[2];
    const int lane = F.lane, fr = lane & 15, fq = lane >> 4;
    lbf16* tA = (lbf16*)(F.lds + F.wave * WLDS); lbf16* tB = tA + 32 * TS2; lbf16* tK = tB + 32 * TS2; lbf16* tV = tK + 32 * TS2;
    LAS float* WLs = (LAS float*)(F.lds + F.wave * WLDS + 4 * WTILE);
#pragma unroll 1
    for (int item = F.gw; item < 64 * NCH2; item += F.NGW) {
        const int c = item >> 6, bh = item & 63, b = bh >> 4, h = bh & 15;
        const size_t tok0 = (size_t)b * SEQ + (size_t)c * 32;
        bf16x8 fR[2][2];
        {
            float carry[2][8];
#pragma unroll
            for (int ks = 0; ks < 2; ++ks)
#pragma unroll
                for (int j = 0; j < 8; ++j) carry[ks][j] = 0.f;
#pragma unroll
            for (int rt = 0; rt < 2; ++rt) {
                const size_t row = tok0 + 16 * rt + fr; const bool first = (c == 0 && rt == 0 && fr == 0); const size_t prow = first ? row : row - 1;
                float r[2][8], k[2][8], v[2][8], a[2][8], lw[2][8];
#pragma unroll
                for (int ks = 0; ks < 2; ++ks) { const int col = h * 64 + 32 * ks + 8 * fq; float cur[8], prv[8];
                    unpack8(*(const u32x4*)(P + row * NP + PC_R + col), cur); unpack8(*(const u32x4*)(P + prow * NP + PC_R + col), prv); if (first) { for (int j = 0; j < 8; ++j) prv[j] = 0.f; }
#pragma unroll
                    for (int j = 0; j < 8; ++j) r[ks][j] = cur[j] + mu[PC_R + col + j] * (prv[j] - cur[j]);
                    unpack8(*(const u32x4*)(P + row * NP + PC_K + col), cur); unpack8(*(const u32x4*)(P + prow * NP + PC_K + col), prv); if (first) { for (int j = 0; j < 8; ++j) prv[j] = 0.f; }
#pragma unroll
                    for (int j = 0; j < 8; ++j) k[ks][j] = cur[j] + mu[PC_K + col + j] * (prv[j] - cur[j]);
                    unpack8(*(const u32x4*)(P + row * NP + PC_V + col), cur); unpack8(*(const u32x4*)(P + prow * NP + PC_V + col), prv); if (first) { for (int j = 0; j < 8; ++j) prv[j] = 0.f; }
#pragma unroll
                    for (int j = 0; j < 8; ++j) v[ks][j] = cur[j] + mu[PC_V + col + j] * (prv[j] - cur[j]);
                    unpack8(*(const u32x4*)(AA + row * D + col), a[ks]);
                    const f32x4 l0 = *(const f32x4*)(LOGW + row * D + col), l1 = *(const f32x4*)(LOGW + row * D + col + 4);
#pragma unroll
                    for (int j = 0; j < 4; ++j) { lw[ks][j] = l0[j]; lw[ks][4 + j] = l1[j]; }
                    asm volatile("" ::: "memory"); }
                float kk[2][8], n2 = 0.f, bon = 0.f;
#pragma unroll
                for (int ks = 0; ks < 2; ++ks) { const int col = h * 64 + 32 * ks + 8 * fq;
#pragma unroll
                    for (int j = 0; j < 8; ++j) { kk[ks][j] = k[ks][j] * F.A.in[8][col + j]; n2 += kk[ks][j] * kk[ks][j]; } }
                n2 += __shfl_xor(n2, 16); n2 += __shfl_xor(n2, 32);
                const float inv = 1.0f / fmaxf(sqrtf(n2), 1e-12f);
#pragma unroll
                for (int ks = 0; ks < 2; ++ks) { const int col = h * 64 + 32 * ks + 8 * fq;
#pragma unroll
                    for (int j = 0; j < 8; ++j) { kk[ks][j] *= inv; k[ks][j] = k[ks][j] * (1.0f + (a[ks][j] - 1.0f) * F.A.in[9][col + j]); bon += r[ks][j] * k[ks][j] * F.A.in[10][col + j]; } }
                bon += __shfl_xor(bon, 16); bon += __shfl_xor(bon, 32);
#pragma unroll
                for (int ks = 0; ks < 2; ++ks) { const int col = h * 64 + 32 * ks + 8 * fq; f32x4 b0, b1;
#pragma unroll
                    for (int j = 0; j < 4; ++j) { b0[j] = bon * v[ks][j]; b1[j] = bon * v[ks][4 + j]; }
                    *(u32x4*)(BV + row * D + col) = pack8(b0, b1);
                    *(LAS u32x4*)(tV + (16 * rt + fr) * TS2 + 32 * ks + 8 * fq) = pack8((f32x4){v[ks][0], v[ks][1], v[ks][2], v[ks][3]}, (f32x4){v[ks][4], v[ks][5], v[ks][6], v[ks][7]}); }
#pragma unroll
                for (int ks = 0; ks < 2; ++ks)
#pragma unroll
                    for (int j = 0; j < 8; ++j) { float x = lw[ks][j];
#pragma unroll
                        for (int d = 1; d < 16; d <<= 1) { const float y = __shfl_up(x, d, 16); x += (fr >= d) ? y : 0.f; }
                        const float tot = __shfl(x, (lane & 48) | 15); const float cw = x + carry[ks][j]; carry[ks][j] += tot;
                        const float e1 = __expf(cw), e2 = __expf(-cw), e3 = __expf(cw - lw[ks][j]);
                        const float at = -kk[ks][j] * e3, bt = kk[ks][j] * a[ks][j] * e2, kt = k[ks][j] * e2, rr = r[ks][j] * e1;
                        r[ks][j] = rr; a[ks][j] = at; lw[ks][j] = bt; k[ks][j] = kt;
                        if (rt == 1) { const float wl = __shfl(e1, (lane & 48) | 15); if (fr == 0) WLs[32 * ks + 8 * fq + j] = wl; } }
#pragma unroll
                for (int ks = 0; ks < 2; ++ks) {
                    const u32x4 wa = pack8((f32x4){a[ks][0], a[ks][1], a[ks][2], a[ks][3]}, (f32x4){a[ks][4], a[ks][5], a[ks][6], a[ks][7]});
                    const u32x4 wb = pack8((f32x4){lw[ks][0], lw[ks][1], lw[ks][2], lw[ks][3]}, (f32x4){lw[ks][4], lw[ks][5], lw[ks][6], lw[ks][7]});
                    const u32x4 wk = pack8((f32x4){k[ks][0], k[ks][1], k[ks][2], k[ks][3]}, (f32x4){k[ks][4], k[ks][5], k[ks][6], k[ks][7]});
                    const u32x4 wr = pack8((f32x4){r[ks][0], r[ks][1], r[ks][2], r[ks][3]}, (f32x4){r[ks][4], r[ks][5], r[ks][6], r[ks][7]});
                    fR[rt][ks] = __builtin_bit_cast(bf16x8, wr);
                    const int o = (16 * rt + fr) * TS2 + 32 * ks + 8 * fq;
                    *(LAS u32x4*)(tA + o) = wa; *(LAS u32x4*)(tB + o) = wb; *(LAS u32x4*)(tK + o) = wk; }
            }
        }
        WAVE_LDS_SYNC();
        bf16x8 Nn[2], Nt[2], Tm[2], Aak[2], Arb[2], Ark[2];
        {
            bf16x8 fA[2][2], fB[2][2], fK[2][2];
#pragma unroll
            for (int rt = 0; rt < 2; ++rt)
#pragma unroll
                for (int ks = 0; ks < 2; ++ks) { const int o = (16 * rt + fr) * TS2 + 32 * ks + 8 * fq;
                    fA[rt][ks] = *(const LAS bf16x8*)(tA + o); fB[rt][ks] = *(const LAS bf16x8*)(tB + o); fK[rt][ks] = *(const LAS bf16x8*)(tK + o); }
#pragma unroll
            for (int tt = 0; tt < 2; ++tt) {
                f32x4 dab[2], dak[2], drb[2], drk[2];
#pragma unroll
                for (int st = 0; st < 2; ++st) { dab[st] = (f32x4){0.f, 0.f, 0.f, 0.f}; dak[st] = dab[st]; drb[st] = dab[st]; drk[st] = dab[st];
#pragma unroll
                    for (int ks = 0; ks < 2; ++ks) { dab[st] = mfma16(fB[st][ks], fA[tt][ks], dab[st]); dak[st] = mfma16(fK[st][ks], fA[tt][ks], dak[st]);
                        drb[st] = mfma16(fB[st][ks], fR[tt][ks], drb[st]); drk[st] = mfma16(fK[st][ks], fR[tt][ks], drk[st]); }
                    const int t = 16 * tt + fr;
#pragma unroll
                    for (int rg = 0; rg < 4; ++rg) { const int s = 16 * st + 4 * fq + rg;
                        dab[st][rg] = (s < t) ? dab[st][rg] : 0.f; dak[st][rg] = (s < t) ? dak[st][rg] : 0.f; drb[st][rg] = (s <= t) ? drb[st][rg] : 0.f; drk[st][rg] = (s <= t) ? drk[st][rg] : 0.f; } }
                Nn[tt] = mkfrag(pk4(dab[0]), pk4(dab[1])); Aak[tt] = mkfrag(pk4(dak[0]), pk4(dak[1])); Arb[tt] = mkfrag(pk4(drb[0]), pk4(drb[1])); Ark[tt] = mkfrag(pk4(drk[0]), pk4(drk[1]));
                const int t = 16 * tt + fr;
#pragma unroll
                for (int st = 0; st < 2; ++st)
#pragma unroll
                    for (int rg = 0; rg < 4; ++rg) dab[st][rg] += (16 * st + 4 * fq + rg == t) ? 1.f : 0.f;
                Tm[tt] = mkfrag(pk4(dab[0]), pk4(dab[1]));
            }
#pragma unroll
            for (int st = 0; st < 2; ++st) {
                f32x4 dt[2];
#pragma unroll
                for (int tt = 0; tt < 2; ++tt) { dt[tt] = (f32x4){0.f, 0.f, 0.f, 0.f};
#pragma unroll
                    for (int ks = 0; ks < 2; ++ks) dt[tt] = mfma16(fA[tt][ks], fB[st][ks], dt[tt]);
                    const int s = 16 * st + fr;
#pragma unroll
                    for (int rg = 0; rg < 4; ++rg) { const int t = 16 * tt + 4 * fq + rg; dt[tt][rg] = (s < t) ? dt[tt][rg] : 0.f; } }
                Nt[st] = mkfrag(pk4(dt[0]), pk4(dt[1]));
            }
        }
        bf16x8 VT[4];
#pragma unroll
        for (int it = 0; it < 4; ++it) VT[it] = tr_frag(tV, it, fr, fq);
        WAVE_LDS_SYNC();
#pragma unroll
        for (int rt = 0; rt < 2; ++rt)
#pragma unroll
            for (int ks = 0; ks < 2; ++ks) *(LAS bf16x8*)(tV + (16 * rt + fr) * TS2 + 32 * ks + 8 * fq) = fR[rt][ks];
        {
            bf16x8 N2[2], N2t[2], T2[2];
            prod32(Nn, Nt, nullptr, N2); prod32(Nt, Nn, nullptr, N2t);
            prod32(Tm, N2t, Tm, T2); prod32(N2, N2t, nullptr, Nn); prod32(N2t, N2, nullptr, Nt);
            prod32(T2, Nt, T2, Tm); prod32(Nn, Nt, nullptr, N2); prod32(Nt, Nn, nullptr, N2t);
            prod32(Tm, N2t, Tm, T2); prod32(N2, N2t, nullptr, Nn); prod32(N2t, N2, nullptr, Nt);
            prod32(T2, Nt, T2, Tm);
        }
        bf16x8 U0T[4], AhT[4];
#pragma unroll
        for (int it = 0; it < 4; ++it) {
            f32x4 d0 = (f32x4){0.f, 0.f, 0.f, 0.f}, d1 = d0; d0 = mfma16(Aak[0], VT[it], d0); d1 = mfma16(Aak[1], VT[it], d1);
            const bf16x8 x1 = mkfrag(pk4(d0), pk4(d1));
            d0 = (f32x4){0.f, 0.f, 0.f, 0.f}; d1 = d0; d0 = mfma16(Tm[0], x1, d0); d1 = mfma16(Tm[1], x1, d1);
            U0T[it] = mkfrag(pk4(d0), pk4(d1)); }
#pragma unroll
        for (int jt = 0; jt < 4; ++jt) { const bf16x8 at = tr_frag(tA, jt, fr, fq);
            f32x4 d0 = (f32x4){0.f, 0.f, 0.f, 0.f}, d1 = d0; d0 = mfma16(Tm[0], at, d0); d1 = mfma16(Tm[1], at, d1);
            AhT[jt] = mkfrag(pk4(d0), pk4(d1)); }
        WAVE_LDS_SYNC();
        bf16x8 BT[4], KT[4];
#pragma unroll
        for (int jt = 0; jt < 4; ++jt) { BT[jt] = tr_frag(tB, jt, fr, fq); KT[jt] = tr_frag(tK, jt, fr, fq); }
        const size_t tile = (size_t)item * 4096;
#pragma unroll
        for (int mt = 0; mt < 4; ++mt) {
            const float wl = WLs[16 * mt + fr];
#pragma unroll
            for (int nt = 0; nt < 4; ++nt) { f32x4 d = (f32x4){0.f, 0.f, 0.f, 0.f}; d = mfma16(AhT[nt], BT[mt], d);
#pragma unroll
                for (int rg = 0; rg < 4; ++rg) d[rg] = (d[rg] + ((16 * nt + 4 * fq + rg == 16 * mt + fr) ? 1.f : 0.f)) * wl;
                *(u32x2*)(PT + tile + (16 * mt + fr) * 64 + 16 * nt + 4 * fq) = pk4(d); } }
#pragma unroll
        for (int mt = 0; mt < 4; ++mt) {
#pragma unroll
            for (int nt = 0; nt < 4; ++nt) { f32x4 d = (f32x4){0.f, 0.f, 0.f, 0.f}; d = mfma16(BT[nt], U0T[mt], d); d = mfma16(KT[nt], VT[mt], d);
                d = d * *(const LAS f32x4*)(WLs + 16 * nt + 4 * fq);
                *(u32x2*)(QQ + tile + (16 * mt + fr) * 64 + 16 * nt + 4 * fq) = pk4(d); } }
#pragma unroll
        for (int tt = 0; tt < 2; ++tt) {
            const size_t base = (tok0 + 16 * tt + fr) * D + h * 64;
#pragma unroll
            for (int nt = 0; nt < 4; ++nt) {
                f32x4 d = up4(*(const LAS u32x2*)(tV + (16 * tt + fr) * TS2 + 16 * nt + 4 * fq)); d = mfma16(AhT[nt], Arb[tt], d);
                *(u32x2*)(RH + base + 16 * nt + 4 * fq) = pk4(d); }
#pragma unroll
            for (int nt = 0; nt < 4; ++nt) {
                f32x4 d = (f32x4){0.f, 0.f, 0.f, 0.f}; d = mfma16(U0T[nt], Arb[tt], d); d = mfma16(VT[nt], Ark[tt], d);
                *(u32x2*)(Y0 + base + 16 * nt + 4 * fq) = pk4(d); }
        }
        WAVE_LDS_SYNC();
    }
}

constexpr int RING_NS = 8, RING_D = 6, SLOT_B = 16384;
__device__ __forceinline__ void scan_pass2(Frame& F) {
    const bf16_t* PT = WSP(bf16_t, WS_PT); const bf16_t* QQ = WSP(bf16_t, WS_QQ); bf16_t* SC = WSP(bf16_t, WS_SC);
    const int lane = F.lane, w = F.wave, fr = lane & 15, fq = lane >> 4;
#pragma unroll 1
    for (int bh = blockIdx.x; bh < 64; bh += F.G) {
        const char* ptg = (const char*)(PT + (size_t)bh * 4096); const char* qqg = (const char*)(QQ + (size_t)bh * 4096);
        const int lw4 = (w - 4) * 4;
        auto issue = [&](int step) {
            const int cs = step < NCH2 ? step : NCH2 - 1; LAS unsigned char* slot = F.lds + (step % RING_NS) * SLOT_B;
#pragma unroll
            for (int i = 0; i < 4; ++i) { const int G = (lw4 + i) * 64 + lane, g = G & 511, row = g >> 3, ch = (g & 7) ^ (row & 7);
                const char* srcp = (G < 512 ? ptg : qqg) + (size_t)cs * (64 * 8192) + row * 128 + ch * 16;
                __builtin_amdgcn_global_load_lds((const unsigned*)srcp, (LAS unsigned*)(slot + (lw4 + i) * 1024), 16, 0, 0); }
        };
        if (w >= 4) {
#pragma unroll
            for (int s = 0; s < RING_D; ++s) issue(s);
        }
        f32x4 acc[4];
#pragma unroll
        for (int m = 0; m < 4; ++m) acc[m] = (f32x4){0.f, 0.f, 0.f, 0.f};
        const int irow = 16 * w + fr;
#pragma unroll 1
        for (int c = 0; c < NCH2; ++c) {
            if (w >= 4) asm volatile("s_waitcnt vmcnt(20)" ::: "memory");
            __builtin_amdgcn_s_barrier();
            asm volatile("" ::: "memory");
            if (w < 4) {
                const LAS unsigned char* slot = F.lds + (c % RING_NS) * SLOT_B;
                u32x2 pa[4][2][2], qa[4];
#pragma unroll
                for (int m = 0; m < 4; ++m) { const int row = 16 * m + fr;
                    qa[m] = *(const LAS u32x2*)(slot + 8192 + irow * 128 + (((2 * m + (fq >> 1)) ^ (irow & 7)) * 16) + (fq & 1) * 8);
#pragma unroll
                    for (int ks = 0; ks < 2; ++ks)
#pragma unroll
                        for (int hf = 0; hf < 2; ++hf) pa[m][ks][hf] = *(const LAS u32x2*)(slot + row * 128 + (((4 * ks + 2 * hf + (fq >> 1)) ^ (row & 7)) * 16) + (fq & 1) * 8); }
                u32x2 sp[4];
#pragma unroll
                for (int m = 0; m < 4; ++m) sp[m] = pk4(acc[m]);
                bf16_t* sc = SC + (size_t)(c * 64 + bh) * 4096 + irow * 64;
#pragma unroll
                for (int m = 0; m < 4; ++m) *(u32x2*)(sc + 16 * m + 4 * fq) = sp[m];
                const bf16x8 bop0 = mkfrag(sp[0], sp[1]), bop1 = mkfrag(sp[2], sp[3]);
                asm volatile("s_waitcnt lgkmcnt(0)" ::: "memory");
#pragma unroll
                for (int m = 0; m < 4; ++m) { f32x4 a0 = up4(qa[m]);
                    a0 = mfma16(mkfrag(pa[m][0][0], pa[m][0][1]), bop0, a0); a0 = mfma16(mkfrag(pa[m][1][0], pa[m][1][1]), bop1, a0); acc[m] = a0; }
            } else {
                issue(c + RING_D);
            }
        }
        if (w >= 4) asm volatile("s_waitcnt vmcnt(0)" ::: "memory");
        __builtin_amdgcn_s_barrier();
    }
}

struct P3In { bf16x8 sa[4][2]; bf16x8 rb[2][2]; u32x2 y0[2][4]; };
__device__ __forceinline__ void p3_load(P3In& I, const bf16_t* SC, const bf16_t* RH, const bf16_t* Y0, int item, int fr, int fq) {
    const int c = item >> 6, bh = item & 63, b = bh >> 4, h = bh & 15; const size_t tok0 = (size_t)b * SEQ + (size_t)c * 32; const bf16_t* sc = SC + (size_t)item * 4096;
#pragma unroll
    for (int nt = 0; nt < 4; ++nt)
#pragma unroll
        for (int ks = 0; ks < 2; ++ks) I.sa[nt][ks] = *(const bf16x8*)(sc + (16 * nt + fr) * 64 + 32 * ks + 8 * fq);
#pragma unroll
    for (int mt = 0; mt < 2; ++mt) { const size_t base = (tok0 + 16 * mt + fr) * D + h * 64;
#pragma unroll
        for (int ks = 0; ks < 2; ++ks) I.rb[mt][ks] = *(const bf16x8*)(RH + base + 32 * ks + 8 * fq);
#pragma unroll
        for (int nt = 0; nt < 4; ++nt) I.y0[mt][nt] = *(const u32x2*)(Y0 + base + 16 * nt + 4 * fq); }
}
__device__ __forceinline__ void scan_pass3(Frame& F) {
    const bf16_t* SC = WSP(bf16_t, WS_SC); const bf16_t* RH = WSP(bf16_t, WS_RH); const bf16_t* Y0 = WSP(bf16_t, WS_Y0); const bf16_t* BV = WSP(bf16_t, WS_BV);
    const bf16_t* GG = WSP(bf16_t, WS_GG); bf16_t* YA = WSP(bf16_t, WS_YA);
    const float* gnw = F.A.in[11]; const float* gnb = F.A.in[12];
    const int lane = F.lane, fr = lane & 15, fq = lane >> 4;
    constexpr int NIT = 64 * NCH2;
    P3In cur, nxt;
    if (F.gw < NIT) p3_load(cur, SC, RH, Y0, F.gw, fr, fq);
#pragma unroll 1
    for (int item = F.gw; item < NIT; item += F.NGW) {
        const int inext = (item + F.NGW < NIT) ? item + F.NGW : item;
        p3_load(nxt, SC, RH, Y0, inext, fr, fq);
        const int c = item >> 6, bh = item & 63, b = bh >> 4, h = bh & 15;
        const size_t tok0 = (size_t)b * SEQ + (size_t)c * 32;
        f32x4 gw4[4], gb4[4]; u32x2 bvw[2][4], ggw[2][4];
#pragma unroll
        for (int nt = 0; nt < 4; ++nt) { gw4[nt] = *(const f32x4*)(gnw + h * 64 + 16 * nt + 4 * fq); gb4[nt] = *(const f32x4*)(gnb + h * 64 + 16 * nt + 4 * fq); }
#pragma unroll
        for (int mt = 0; mt < 2; ++mt) { const size_t base = (tok0 + 16 * mt + fr) * D + h * 64;
#pragma unroll
            for (int nt = 0; nt < 4; ++nt) { bvw[mt][nt] = *(const u32x2*)(BV + base + 16 * nt + 4 * fq); ggw[mt][nt] = *(const u32x2*)(GG + base + 16 * nt + 4 * fq); } }
#pragma unroll
        for (int mt = 0; mt < 2; ++mt) {
            const size_t base = (tok0 + 16 * mt + fr) * D + h * 64;
            f32x4 y[4];
#pragma unroll
            for (int nt = 0; nt < 4; ++nt) { y[nt] = up4(cur.y0[mt][nt]);
#pragma unroll
                for (int ks = 0; ks < 2; ++ks) y[nt] = mfma16(cur.sa[nt][ks], cur.rb[mt][ks], y[nt]); }
            float s = 0.f;
#pragma unroll
            for (int nt = 0; nt < 4; ++nt) s += (y[nt][0] + y[nt][1]) + (y[nt][2] + y[nt][3]);
            s += __shfl_xor(s, 16); s += __shfl_xor(s, 32);
            const float mean = s * (1.f / 64.f); float q = 0.f;
#pragma unroll
            for (int nt = 0; nt < 4; ++nt) { y[nt] = y[nt] - mean; q += (y[nt][0] * y[nt][0] + y[nt][1] * y[nt][1]) + (y[nt][2] * y[nt][2] + y[nt][3] * y[nt][3]); }
            q += __shfl_xor(q, 16); q += __shfl_xor(q, 32);
            const float rstd = 1.0f / sqrtf(q * (1.f / 64.f) + GN_EPS);
#pragma unroll
            for (int nt = 0; nt < 4; ++nt) { const f32x4 bv = up4(bvw[mt][nt]), gv = up4(ggw[mt][nt]);
                const f32x4 o = (y[nt] * rstd * gw4[nt] + gb4[nt] + bv) * gv;
                *(u32x2*)(YA + base + 16 * nt + 4 * fq) = pk4(o); }
        }
        cur = nxt;
    }
}

__device__ __forceinline__ void p8_ln1(Frame& F) {
    const float* HP = WSP(float, WS_H1PRE); float* H1 = WSP(float, WS_H1); bf16_t* HR = WSP(bf16_t, WS_HR);
    const float* lw = F.A.in[20]; const float* lb = F.A.in[21];
    for (int t = F.gw; t < T; t += F.NGW) {
        const f32x4* xr = (const f32x4*)(HP + (size_t)t * D) + F.lane; f32x4 v[4]; float s = 0.f;
#pragma unroll
        for (int j = 0; j < 4; ++j) { v[j] = xr[64 * j]; s += (v[j][0] + v[j][1]) + (v[j][2] + v[j][3]); }
        const float mean = wave_sum(s) * (1.f / D); float q = 0.f;
#pragma unroll
        for (int j = 0; j < 4; ++j) { v[j] = v[j] - mean; q += (v[j][0] * v[j][0] + v[j][1] * v[j][1]) + (v[j][2] * v[j][2] + v[j][3] * v[j][3]); }
        const float rstd = 1.0f / sqrtf(wave_sum(q) * (1.f / D) + LN_EPS);
#pragma unroll
        for (int j = 0; j < 4; ++j) { const int col = 4 * F.lane + 256 * j; const f32x4 w = *(const f32x4*)(lw + col), bb = *(const f32x4*)(lb + col);
            const f32x4 o = v[j] * rstd * w + bb; *(f32x4*)(H1 + (size_t)t * D + col) = o;
            const unsigned h01 = cvt_pk_bf16(o[0], o[1]), h23 = cvt_pk_bf16(o[2], o[3]);
            const float l0 = o[0] - bf2f(h01 & 0xffffu), l1 = o[1] - bf2f(h01 >> 16), l2 = o[2] - bf2f(h23 & 0xffffu), l3 = o[3] - bf2f(h23 >> 16);
            u32x2 hi; hi.x = h01; hi.y = h23; u32x2 lo; lo.x = cvt_pk_bf16(l0, l1); lo.y = cvt_pk_bf16(l2, l3);
            bf16_t* hr = HR + (size_t)t * HRK + col; *(u32x2*)hr = hi; *(u32x2*)(hr + 1024) = lo; *(u32x2*)(hr + 2048) = hi; }
    }
}

__device__ __forceinline__ void p10_route(Frame& F) {
    const float* LG = WSP(float, WS_LOGITS); const float* rb = F.A.in[23];
    int* TE = WSP(int, WS_TOPE); float* TG = WSP(float, WS_TOPG); int* CNT = WSP(int, WS_CNT);
    LAS int* hist = (LAS int*)F.lds;
    if (F.tid < 256) hist[F.tid] = 0;
    __syncthreads();
    const int TPB = (T + F.G - 1) / F.G, tb = blockIdx.x * TPB, te = (tb + TPB < T) ? tb + TPB : T;
    const int lane = F.lane; const float NINF = -__builtin_inff();
    const f32x4 bias = *(const f32x4*)(rb + 4 * lane);
    for (int t = tb + F.wave; t < te; t += 8) {
        const f32x4 lg = *(const f32x4*)(LG + (size_t)t * NE + 4 * lane);
        float sc[4], chv[4];
#pragma unroll
        for (int j = 0; j < 4; ++j) { sc[j] = 1.0f / (1.0f + expf(-lg[j])); chv[j] = sc[j] + bias[j]; }
        float m1 = NINF, m2 = NINF;
#pragma unroll
        for (int j = 0; j < 4; ++j) { if (chv[j] > m1) { m2 = m1; m1 = chv[j]; } else if (chv[j] > m2) m2 = chv[j]; }
#pragma unroll
        for (int o = 1; o < 8; o <<= 1) { const float b1 = __shfl_xor(m1, o), b2 = __shfl_xor(m2, o); const float n1 = fmaxf(m1, b1), n2 = fmaxf(fminf(m1, b1), fmaxf(m2, b2)); m1 = n1; m2 = n2; }
        const float gs = m1 + m2; const int g = lane >> 3; int rank = 0;
#pragma unroll
        for (int gg = 0; gg < 8; ++gg) { const float o = __shfl(gs, gg * 8); rank += (o > gs || (o == gs && gg < g)) ? 1 : 0; }
        const bool sel = rank < 4;
#pragma unroll
        for (int j = 0; j < 4; ++j) chv[j] = sel ? chv[j] : NINF;
        int my_e = 0; float my_s = 0.f, ssum = 0.f;
#pragma unroll
        for (int k = 0; k < TOPK; ++k) {
            float bv = chv[0]; int bi = 4 * lane;
#pragma unroll
            for (int j = 1; j < 4; ++j) if (chv[j] > bv) { bv = chv[j]; bi = 4 * lane + j; }
#pragma unroll
            for (int o = 1; o < 64; o <<= 1) { const float ov = __shfl_xor(bv, o); const int oi = __shfl_xor(bi, o); if (ov > bv || (ov == bv && oi < bi)) { bv = ov; bi = oi; } }
            const int j = bi & 3; const float scs = j == 0 ? sc[0] : (j == 1 ? sc[1] : (j == 2 ? sc[2] : sc[3]));
            const float sk = __shfl(scs, bi >> 2);
            if (lane == (bi >> 2)) { if (j == 0) chv[0] = NINF; else if (j == 1) chv[1] = NINF; else if (j == 2) chv[2] = NINF; else chv[3] = NINF; }
            ssum += sk; if (lane == k) { my_e = bi; my_s = sk; }
        }
        if (lane < TOPK) { TE[(size_t)t * TOPK + lane] = my_e; TG[(size_t)t * TOPK + lane] = my_s / ssum * ROUTED_SCALE; __hip_atomic_fetch_add(&hist[my_e], 1, __ATOMIC_RELAXED, __HIP_MEMORY_SCOPE_WORKGROUP); }
    }
    __syncthreads();
    if (F.tid < 256) CNT[(size_t)blockIdx.x * NE + F.tid] = (int)__hip_atomic_fetch_add(F.ctl + CW_GTOT + F.tid, (unsigned)hist[F.tid], __ATOMIC_RELAXED, __HIP_MEMORY_SCOPE_AGENT);
}

__device__ __forceinline__ void p11_place(Frame& F) {
    const int* TE = WSP(int, WS_TOPE); const float* TG = WSP(float, WS_TOPG); const int* CNT = WSP(int, WS_CNT);
    int* SLOT = WSP(int, WS_SLOT); int* RT = WSP(int, WS_ROWTOK); float* RG = WSP(float, WS_ROWGATE);
    LAS int* tot = (LAS int*)F.lds; LAS int* mine = tot + 256; LAS int* start = tot + 512; LAS int* cursor = tot + 1024;
    const int b = blockIdx.x;
    if (F.tid < 256) { tot[F.tid] = (int)ld_u32_sc1(F.ctl + CW_GTOT + F.tid); mine[F.tid] = CNT[(size_t)b * NE + F.tid]; cursor[F.tid] = 0; }
    __syncthreads();
    if (F.tid == 0) { int s = 0; for (int e = 0; e < NE; ++e) { start[e] = s; s += (tot[e] + 255) & ~255; } start[NE] = s; start[NE + 1] = s + T; }
    __syncthreads();
    const int TPB = (T + F.G - 1) / F.G, tb = b * TPB, te = (tb + TPB < T) ? tb + TPB : T;
    for (int i = tb * TOPK + F.tid; i < te * TOPK; i += 512) { const int e = TE[i]; const int pos = __hip_atomic_fetch_add(&cursor[e], 1, __ATOMIC_RELAXED, __HIP_MEMORY_SCOPE_WORKGROUP); const int row = start[e] + mine[e] + pos;
        RT[row] = i / TOPK; RG[row] = TG[i]; SLOT[i] = row; }
    const int shb = start[NE];
    for (int t = tb + F.tid; t < te; t += 512) { RT[shb + t] = t; RG[shb + t] = 1.0f; }
    for (int e = b; e < NE; e += F.G) { for (int r = start[e] + tot[e] + F.tid; r < start[e + 1]; r += 512) { RT[r] = 0; RG[r] = 0.f; } }
    if (b == 0) {
        if (F.tid < 257) { for (int pm = start[F.tid] >> 8; pm < (start[F.tid + 1] >> 8); ++pm) F.ctl[CW_BLKE + pm] = (unsigned)F.tid; }
        if (F.tid == 0) { F.ctl[CW_NBLK] = (unsigned)(start[NE + 1] >> 8); F.ctl[CW_SHBASE] = (unsigned)shb; }
    }
}

__device__ __forceinline__ void p14_combine(Frame& F) {
    const float* H1 = WSP(float, WS_H1); const bf16_t* YR = WSP(bf16_t, WS_YR); const int* SLOT = WSP(int, WS_SLOT);
    const float* lw = F.A.in[28]; const float* lb = F.A.in[29];
    const int shb = (int)__builtin_amdgcn_readfirstlane(ld_u32_sc1(F.ctl + CW_SHBASE));
    for (int t = F.gw; t < T; t += F.NGW) {
        f32x4 v[4];
#pragma unroll
        for (int j = 0; j < 4; ++j) v[j] = ALPHA * *(const f32x4*)(H1 + (size_t)t * D + 4 * F.lane + 256 * j);
#pragma unroll
        for (int k = 0; k <= TOPK; ++k) { const int row = k < TOPK ? SLOT[(size_t)t * TOPK + k] : shb + t; const bf16_t* yr = YR + (size_t)row * D + 4 * F.lane;
#pragma unroll
            for (int j = 0; j < 4; ++j) { const u32x2 w = *(const u32x2*)(yr + 256 * j); v[j][0] += bf2f(w.x & 0xffffu); v[j][1] += bf2f(w.x >> 16); v[j][2] += bf2f(w.y & 0xffffu); v[j][3] += bf2f(w.y >> 16); } }
        float s = 0.f;
#pragma unroll
        for (int j = 0; j < 4; ++j) s += (v[j][0] + v[j][1]) + (v[j][2] + v[j][3]);
        const float mean = wave_sum(s) * (1.f / D); float q = 0.f;
#pragma unroll
        for (int j = 0; j < 4; ++j) { v[j] = v[j] - mean; q += (v[j][0] * v[j][0] + v[j][1] * v[j][1]) + (v[j][2] * v[j][2] + v[j][3] * v[j][3]); }
        const float rstd = 1.0f / sqrtf(wave_sum(q) * (1.f / D) + LN_EPS);
#pragma unroll
        for (int j = 0; j < 4; ++j) { const int col = 4 * F.lane + 256 * j; const f32x4 w = *(const f32x4*)(lw + col), bb = *(const f32x4*)(lb + col);
            *(f32x4*)(F.out + (size_t)t * D + col) = v[j] * rstd * w + bb; }
    }
}

constexpr int N_PHASES = 17;
#ifndef SCAN_SEQ
#define SCAN_SEQ 0
#endif
__global__ void __launch_bounds__(512, 2) mk_fwd(Args args) {
    extern __shared__ __attribute__((aligned(16))) unsigned char lds_raw[];
    const int tid_ = threadIdx.x, wave_ = __builtin_amdgcn_readfirstlane(tid_ >> 6);
    Frame F{(LAS unsigned char*)lds_raw, tid_, tid_ & 63, wave_, (int)gridDim.x, (int)blockIdx.x * 8 + wave_, (int)gridDim.x * 8, args, args.out, args.ws, (unsigned*)(args.ws + WS_CTL)};
    volatile LAS unsigned* MISC = (volatile LAS unsigned*)(F.lds + MISC_OFF);
    for (int u = F.tid; u < (LDS_BYTES - RING_BYTES) / 4; u += 512) ((LAS unsigned*)(F.lds + RING_BYTES))[u] = 0u;
    __syncthreads();
    XcdBarrier bar; bar.bar = F.ctl + CW_BAR; bar.x = 0; bar.st = nullptr;
    if (!MK_SPLIT) bar = xcd_barrier_post(F.ctl + CW_BAR, MISC + 8);
    const int lo = args.ph_lo, hi = args.ph_hi;
#ifndef PH_MASK
#define PH_MASK 0x1ffff
#endif
#define IN(k) (((PH_MASK >> (k)) & 1) && lo <= (k) && (k) < hi)
#define SEAM(k) do { if (IN(k) && IN((k) + 1)) xcd_barrier(bar); } while (0)

#ifndef REP_MASK
#define REP_MASK 0
#endif
#define PH(k, ...) do { if (IN(k)) { __VA_ARGS__ if ((REP_MASK >> (k)) & 1) { xcd_barrier(bar); __VA_ARGS__ } } SEAM(k); } while (0)
    PH(0, { p0_prologue(F); });
    PH(1, { pg8::Gemm g{WSP(bf16_t, WS_XB), WSP(bf16_t, WS_WT_IN), D, D, D}; pg8::StaticOrder S; S.init(T, NP, F.G, (int)blockIdx.x);
        EpiP E{WSP(bf16_t, WS_P)}; pg8::gemm_phase(F.lds, g, S, E); });
    PH(2, { p2_lora_in(F); p2_gmlp(F); });
    PH(3, { pg8::Gemm g{WSP(bf16_t, WS_LORAIN), WSP(bf16_t, WS_WT_LORA), LK, LK, LK}; pg8::StaticOrder S; S.init(T, 3072, F.G, (int)blockIdx.x);
        EpiLora E{WSP(float, WS_LOGW), WSP(bf16_t, WS_AA), WSP(bf16_t, WS_GG), F.A.in[3], F.A.in[5]}; pg8::gemm_phase(F.lds, g, S, E); });
#if SCAN_SEQ
    PH(4, { p4_scan_seq(F); }); SEAM(5); SEAM(6);
#else
    PH(4, { scan_pass1(F); });
    PH(5, { scan_pass2(F); __syncthreads(); p0b_expert_weights(F); });
    PH(6, { scan_pass3(F); });
#endif
    PH(7, { pg8::Gemm g{WSP(bf16_t, WS_YA), WSP(bf16_t, WS_WT_OA), D, D, D}; pg8::StaticOrder S; S.init(T, D, F.G, (int)blockIdx.x);
        EpiMix<0> E{WSP(bf16_t, WS_P), WSP(float, WS_T1), nullptr, nullptr, D}; pg8::gemm_phase(F.lds, g, S, E); });
    PH(8, { pg8::Gemm g{WSP(bf16_t, WS_YB), WSP(bf16_t, WS_WT_OB), D, D, D}; pg8::StaticOrder S; S.init(T, D, F.G, (int)blockIdx.x);
        EpiMix<1> E{WSP(bf16_t, WS_P), WSP(float, WS_T1), WSP(bf16_t, WS_MIXIN), nullptr, D}; pg8::gemm_phase(F.lds, g, S, E); });
    PH(9, { pg8::Gemm g{WSP(bf16_t, WS_MIXIN), WSP(bf16_t, WS_WT_OUT), D, D, D}; pg8::StaticOrder S; S.init(T, D, F.G, (int)blockIdx.x);
        EpiMix<2> E{nullptr, WSP(float, WS_H1PRE), nullptr, F.A.in[0], D}; pg8::gemm_phase(F.lds, g, S, E); });
    PH(10, { p8_ln1(F); });
    PH(11, { pg8::Gemm g{WSP(bf16_t, WS_HR), WSP(bf16_t, WS_WT_R), HRK, HRK, HRK}; pg8::StaticOrder S; S.init(T, NE, F.G, (int)blockIdx.x);
        EpiMix<3> E{nullptr, WSP(float, WS_LOGITS), nullptr, nullptr, NE}; pg8::gemm_phase(F.lds, g, S, E); });
    PH(12, { p10_route(F); });
    PH(13, { p11_place(F); });
    PH(14, { pg8::Gemm g{WSP(bf16_t, WS_HR), WSP(bf16_t, WS_WT_GU), D, HRK, D};
        pg8::GroupedOrder<true> S{F.ctl + CW_BLKE, WSP(int, WS_ROWTOK), (int)__builtin_amdgcn_readfirstlane(ld_u32_sc1(F.ctl + CW_NBLK)), 2, F.G, (int)blockIdx.x, (size_t)512 * 1024 * 2};
        EpiAct E{WSP(bf16_t, WS_ACT)}; pg8::gemm_phase(F.lds, g, S, E); });
    PH(15, { pg8::Gemm g{WSP(bf16_t, WS_ACT), WSP(bf16_t, WS_WT_DN), 256, 256, 256};
        pg8::GroupedOrder<false> S{F.ctl + CW_BLKE, WSP(int, WS_ROWTOK), (int)__builtin_amdgcn_readfirstlane(ld_u32_sc1(F.ctl + CW_NBLK)), 4, F.G, (int)blockIdx.x, (size_t)1024 * 256 * 2};
        EpiDown E{WSP(bf16_t, WS_YR), WSP(float, WS_ROWGATE)}; pg8::gemm_phase(F.lds, g, S, E); });
    PH(16, { p14_combine(F); });
#undef PH
#undef IN
#undef SEAM
}

extern "C" void kernel_launch(void* const* d_in, const int* in_sizes, int n_in, void* d_out, int out_size, void* d_ws, size_t ws_size, hipStream_t stream) {
    static int grid = 0;
    if (grid == 0) {
        if (n_in != 30 || out_size != T * D || ws_size < WS_END) { fprintf(stderr, "kernel_launch: unexpected shapes: n_in %d out %d ws %zu (need %zu)\n", n_in, out_size, ws_size, (size_t)WS_END); grid = -1; return; }
        int dev = 0, cus = 0, per_cu = 0;
        if (hipGetDevice(&dev) != hipSuccess || hipDeviceGetAttribute(&cus, hipDeviceAttributeMultiprocessorCount, dev) != hipSuccess) { grid = -1; return; }
        if (hipFuncSetAttribute((const void*)mk_fwd, hipFuncAttributeMaxDynamicSharedMemorySize, LDS_BYTES) != hipSuccess) { fprintf(stderr, "kernel_launch: hipFuncSetAttribute failed\n"); grid = -1; return; }
        if (hipOccupancyMaxActiveBlocksPerMultiprocessor(&per_cu, (const void*)mk_fwd, 512, LDS_BYTES) != hipSuccess || per_cu < 1) { fprintf(stderr, "kernel_launch: occupancy query says %d\n", per_cu); }
        (void)hipGetLastError();
        grid = cus;
        if (grid > 1024) grid = 1024;
    }
    if (grid < 0) return;
    (void)hipMemsetAsync((char*)d_ws + WS_CTL, 0, CTL_ZERO_BYTES, stream);
    Args a{};
    for (int i = 0; i < 30; ++i) a.in[i] = (const float*)d_in[i];
    a.out = (float*)d_out; a.ws = (unsigned char*)d_ws;
#if MK_SPLIT
    for (int p = 0; p < N_PHASES; ++p) { a.ph_lo = p; a.ph_hi = p + 1; hipLaunchKernelGGL(mk_fwd, dim3(grid), dim3(512), LDS_BYTES, stream, a); }
#else
    a.ph_lo = 0; a.ph_hi = N_PHASES; hipLaunchKernelGGL(mk_fwd, dim3(grid), dim3(512), LDS_BYTES, stream, a);
#endif
}
```

```cpp
#include <hip/hip_runtime.h>
#include <cstdio>
#include <cstdint>

#ifndef MK_SPLIT
#define MK_SPLIT 0
#endif

#define LAS __attribute__((address_space(3)))
#define GAS __attribute__((address_space(1)))
typedef unsigned short bf16_t;
typedef short bf16x8 __attribute__((ext_vector_type(8)));
typedef float f32x4 __attribute__((ext_vector_type(4)));
typedef float f32x2 __attribute__((ext_vector_type(2)));
typedef unsigned u32x4 __attribute__((ext_vector_type(4)));
typedef unsigned u32x2 __attribute__((ext_vector_type(2)));

constexpr int T = 32768, D = 1024, SEQ = 8192, NH = 16, HD = 64;
constexpr int C_IN = 7456, NP = 7680;
constexpr int PC_R = 0, PC_K = 1024, PC_V = 2048, PC_L = 3072, PC_U = 3584, PC_GV = 4608, PC_GA = 5632, PC_GB = 6656;
constexpr int NE = 256, TOPK = 8;
constexpr int LK = 384;
constexpr int RMAX = 360448;
constexpr int HRK = 3072;
constexpr float LN_EPS = 1e-5f, GN_EPS = 64e-5f;
constexpr float ALPHA = 1.189207115002721f;
constexpr float ROUTED_SCALE = 2.5f;

constexpr size_t MiB = 1u << 20;
constexpr size_t WS_CTL = 0, CTL_ZERO_BYTES = 1 * MiB;
constexpr size_t WS_WT_IN = 2 * MiB;
constexpr size_t WS_WT_LORA = 17 * MiB;
constexpr size_t WS_WT_OA = 20 * MiB, WS_WT_OB = 22 * MiB, WS_WT_OUT = 24 * MiB;
constexpr size_t WS_WT_R = 26 * MiB;
constexpr size_t WS_WT_GU = 28 * MiB;
constexpr size_t WS_WT_DN = 285 * MiB;
constexpr size_t WS_H1 = 414 * MiB;
constexpr size_t WS_HR = 542 * MiB;
constexpr size_t WS_LOGITS = 734 * MiB;
constexpr size_t WS_TOPE = 766 * MiB;
constexpr size_t WS_TOPG = 767 * MiB;
constexpr size_t WS_SLOT = 768 * MiB;
constexpr size_t WS_CNT = 769 * MiB;
constexpr size_t WS_ROWTOK = 770 * MiB;
constexpr size_t WS_ROWGATE = 772 * MiB;
constexpr size_t WS_XB = 774 * MiB;
constexpr size_t WS_P = 838 * MiB;
constexpr size_t WS_LORAIN = 1318 * MiB;
constexpr size_t WS_LOGW = 1342 * MiB;
constexpr size_t WS_AA = 1470 * MiB;
constexpr size_t WS_GG = 1534 * MiB;
constexpr size_t WS_YA = 1598 * MiB;
constexpr size_t WS_YB = 1662 * MiB;
constexpr size_t WS_T1 = 1726 * MiB;
constexpr size_t WS_MIXIN = 1854 * MiB;
constexpr size_t WS_H1PRE = 1918 * MiB;
constexpr size_t WS_END = 2046 * MiB;
constexpr size_t WS_ACT = 774 * MiB;
constexpr size_t WS_YR = 950 * MiB;
constexpr size_t WS_PT = WS_H1;
constexpr size_t WS_QQ = WS_HR;
constexpr size_t WS_SC = WS_T1;
constexpr size_t WS_RH = WS_MIXIN;
constexpr size_t WS_Y0 = WS_H1PRE;
constexpr size_t WS_BV = WS_H1PRE + 64 * MiB;
static_assert(WS_ACT + (size_t)RMAX * 256 * 2 <= WS_YR && WS_YR + (size_t)RMAX * 1024 * 2 <= WS_END, "moe overlay");
static_assert(WS_WT_GU + (size_t)257 * 512 * 1024 * 2 <= WS_WT_DN && WS_WT_DN + (size_t)257 * 1024 * 256 * 2 <= WS_H1, "weights");
static_assert(WS_ROWGATE + (size_t)RMAX * 4 <= WS_XB && WS_ROWTOK + (size_t)RMAX * 4 <= WS_ROWGATE, "routing");
constexpr int CW_NBLK = 16;
constexpr int CW_SHBASE = 17;
constexpr int CW_CONVQ = 64;
constexpr int CW_GTOT = 512;
constexpr int CW_BLKE = 1024;
constexpr int CW_BAR = 8192;
static_assert((CW_BAR + 3456) * 4 <= (int)CTL_ZERO_BYTES, "ctl");

constexpr int RING_BYTES = 131072;
constexpr int LDS_BYTES = 163840;
constexpr int MISC_OFF = LDS_BYTES - 512;

__device__ __forceinline__ float bf2f(unsigned b) { return __uint_as_float(b << 16); }
typedef __bf16 bf16v2_t __attribute__((ext_vector_type(2)));
__device__ __forceinline__ unsigned cvt_pk_bf16(float lo, float hi) { const f32x2 v = {lo, hi}; const bf16v2_t b = __builtin_convertvector(v, bf16v2_t); return __builtin_bit_cast(unsigned, b); }
__device__ __forceinline__ unsigned f2bf(float f) { return cvt_pk_bf16(f, 0.f) & 0xffffu; }
__device__ __forceinline__ float wave_sum(float v) {
#pragma unroll
    for (int o = 1; o < 64; o <<= 1) v += __shfl_xor(v, o);
    return v;
}
__device__ __forceinline__ float sigmoidf_(float x) { return __builtin_amdgcn_rcpf(1.0f + __expf(-x)); }
__device__ __forceinline__ void unpack8(const u32x4 w, float (&f)[8]) {
    f[0] = bf2f(w.x & 0xffffu); f[1] = bf2f(w.x >> 16); f[2] = bf2f(w.y & 0xffffu); f[3] = bf2f(w.y >> 16);
    f[4] = bf2f(w.z & 0xffffu); f[5] = bf2f(w.z >> 16); f[6] = bf2f(w.w & 0xffffu); f[7] = bf2f(w.w >> 16);
}
__device__ __forceinline__ unsigned ld_u32_sc1(const unsigned* p) { return __hip_atomic_load(p, __ATOMIC_RELAXED, __HIP_MEMORY_SCOPE_AGENT); }

#define XB_TMO      128
#define XB_XCNT(j)  (256  + 64 * (j))
#define XB_XSUB(j)  (1280 + 64 * (j))
#define XB_XGEN(j)  (2304 + 64 * (j))
#define XB_TOP      3328
#define XB_TOPGEN   3392
#define XCD_BAR_WORDS 3456
#define XB_SPIN_CAP (1u << 18)
__device__ __forceinline__ unsigned xb_ld(unsigned* p)              { return __hip_atomic_load(p, __ATOMIC_RELAXED, __HIP_MEMORY_SCOPE_AGENT); }
__device__ __forceinline__ unsigned xb_add(unsigned* p, unsigned v) { return __hip_atomic_fetch_add(p, v, __ATOMIC_RELAXED, __HIP_MEMORY_SCOPE_AGENT); }
__device__ __forceinline__ unsigned xb_xcc_id() { return (unsigned)__builtin_amdgcn_s_getreg((3 << 11) | 20) & 0xFu; }
#define XB_SPIN(cond, bar) do { unsigned _sp = 0; while (cond) { __builtin_amdgcn_s_sleep(1); \
    if ((++_sp & 255u) == 0u) { if (xb_ld(&(bar)[XB_TMO])) break; if (_sp > XB_SPIN_CAP) { atomicAdd(&(bar)[XB_TMO], 1u); break; } } } } while (0)
struct XcdBarrier { unsigned* bar; unsigned x; volatile LAS unsigned* st; };
__device__ __forceinline__ XcdBarrier xcd_barrier_post(unsigned* bar, volatile LAS unsigned* st) {
    XcdBarrier b; b.bar = bar; b.x = xb_xcc_id(); b.st = st;
    if (threadIdx.x == 0) (void)xb_add(&bar[XB_XCNT(b.x)], 1u);
    return b;
}
__device__ __forceinline__ void xcd_barrier_complete(unsigned* bar, unsigned x, unsigned& nloc, unsigned& nx) {
    const unsigned G = gridDim.x * gridDim.y * gridDim.z;
    unsigned sum, cnt, mine, sp = 0u;
    for (;;) {
        sum = 0u; cnt = 0u; mine = 0u;
#pragma unroll
        for (unsigned j = 0; j < 16; ++j) { const unsigned c = xb_ld(&bar[XB_XCNT(j)]); sum += c; cnt += (c > 0u) ? 1u : 0u; mine = (j == x) ? c : mine; }
        if (sum == G) break;
        __builtin_amdgcn_s_sleep(1);
        if ((++sp & 255u) == 0u) { if (xb_ld(&bar[XB_TMO])) break; if (sp > XB_SPIN_CAP) { atomicAdd(&bar[XB_TMO], 1u); break; } }
    }
    nloc = mine > 0u ? mine : 1u; nx = cnt > 0u ? cnt : 1u;
}
__device__ __forceinline__ void xcd_barrier(const XcdBarrier& b) {
    asm volatile("s_waitcnt vmcnt(0)" ::: "memory");
    __syncthreads();
    if (threadIdx.x == 0) {
        unsigned* bar = b.bar;
        __builtin_amdgcn_s_waitcnt(0);
        unsigned nloc = b.st[0], nx = b.st[1];
        if (nloc == 0u) { xcd_barrier_complete(bar, b.x, nloc, nx); b.st[0] = nloc; b.st[1] = nx; }
        const unsigned old = xb_add(&bar[XB_XSUB(b.x)], 1u);
        const unsigned gen = old / nloc;
        if (old + 1u == (gen + 1u) * nloc) {
            __builtin_amdgcn_fence(__ATOMIC_RELEASE, "agent");
            asm volatile("s_waitcnt vmcnt(0)" ::: "memory");
            const unsigned og = xb_add(&bar[XB_TOP], 1u);
            const unsigned tg = og / nx;
            if (og + 1u == (tg + 1u) * nx) xb_add(&bar[XB_TOPGEN], 1u);
            else XB_SPIN(xb_ld(&bar[XB_TOPGEN]) == tg, bar);
            __builtin_amdgcn_fence(__ATOMIC_ACQUIRE, "agent");
            xb_add(&bar[XB_XGEN(b.x)], 1u);
            asm volatile("s_waitcnt vmcnt(0)" ::: "memory");
        } else {
            XB_SPIN(xb_ld(&bar[XB_XGEN(b.x)]) == gen, bar);
            __builtin_amdgcn_fence(__ATOMIC_ACQUIRE, "agent");
            asm volatile("s_waitcnt vmcnt(0)" ::: "memory");
        }
    }
    __syncthreads();
}

namespace pg8 {
constexpr int BM = 256, BK = 64, HALF = 128, HTB = HALF * BK * 2, STAGE_BYTES = 8 * HTB, NXCD = 8, WGM = 8;
__host__ __device__ __forceinline__ int lds_byte(int r, int c) { const int st = (r >> 4) * 2 + (c >> 5), rr = r & 15, cc = c & 31, ob = rr * 64 + cc * 2; return st * 1024 + (ob ^ (((ob >> 9) & 1) << 5)); }
__host__ __device__ __forceinline__ void stage_rc(int b, int& R, int& C) { const int st = b / 1024, sb = b % 1024, swz = sb ^ (((sb >> 9) & 1) << 5); R = (st >> 1) * 16 + swz / 64; C = (st & 1) * 32 + (swz % 64) / 2; }
__host__ __device__ __forceinline__ int perm32(int rho) { const int n = rho >> 4, i = rho & 15; return 8 * (i >> 2) + 4 * n + (i & 3); }

struct Unit { int pm, pn, aux; };
struct Gemm { const bf16_t* A; const bf16_t* Bt; int K, lda, ldb; };

struct StaticOrder {
    static constexpr bool GATHER = false;
    int nM, nN, nwg, G, c;
    __device__ void init(int M, int N, int G_, int c_) { nM = M / BM; nN = N / BM; nwg = nM * nN; G = G_; c = c_; }
    __device__ bool next(int i, Unit& u) const {
        const long L = (long)i * G + c; if (L >= nwg) return false;
        int wgid = (int)L; { const int q = nwg / NXCD, r = nwg % NXCD, xcd = wgid % NXCD, off = wgid / NXCD; wgid = (xcd < r ? xcd * (q + 1) : r * (q + 1) + (xcd - r) * q) + off; }
        const int nig = WGM * nN, gid = wgid / nig, fm = gid * WGM, gsz = (nM - fm) < WGM ? (nM - fm) : WGM;
        u.pm = fm + ((wgid % nig) % gsz); u.pn = (wgid % nig) / gsz; u.aux = 0; return true;
    }
    __device__ __forceinline__ const char* a_base(const Gemm& g, const Unit& u) const { return (const char*)g.A + (size_t)u.pm * BM * g.lda * 2; }
    __device__ __forceinline__ const char* b_base(const Gemm& g, const Unit& u) const { return (const char*)g.Bt + (size_t)u.pn * BM * g.ldb * 2; }
    __device__ __forceinline__ unsigned a_rowoff(const Gemm&, const Unit&, int) const { return 0u; }
};
template <bool GATH> struct GroupedOrder {
    static constexpr bool GATHER = GATH;
    const unsigned* blk_e; const int* row_tok; int nblk, nN, G, c; size_t wstride;
    __device__ bool next(int i, Unit& u) const {
        const int vc = (G % 8 == 0) ? (c % 8) * (G / 8) + c / 8 : c;
        const long L = (long)i * G + vc; if (L >= (long)nblk * nN) return false;
        u.pm = (int)(L / nN); u.pn = (int)(L % nN);
        u.aux = (int)__builtin_amdgcn_readfirstlane(ld_u32_sc1(blk_e + u.pm)); return true;
    }
    __device__ __forceinline__ const char* a_base(const Gemm& g, const Unit& u) const { return (const char*)g.A + (size_t)u.pm * BM * g.lda * 2; }
    __device__ __forceinline__ const char* b_base(const Gemm& g, const Unit& u) const { return (const char*)g.Bt + (size_t)u.aux * wstride + (size_t)u.pn * BM * g.ldb * 2; }
    __device__ __forceinline__ unsigned a_rowoff(const Gemm& g, const Unit& u, int r) const { return (unsigned)row_tok[u.pm * BM + r] * (unsigned)(g.lda * 2); }
};

template <class Epi, class Sched>
__device__ __forceinline__ void gemm_phase(LAS unsigned char* lds, const Gemm g, const Sched& S, const Epi& E) {
    int tid_o = threadIdx.x; asm volatile("" : "+v"(tid_o));
    const int tid = tid_o, wid = __builtin_amdgcn_readfirstlane(tid >> 6), lane = tid & 63, wr = wid >> 2, wc = wid & 3, fr = lane & 15, fq = lane >> 4;
    const int K = g.K, nt = K / BK;
    unsigned voffA[2], voffB[2]; int RA[2]; unsigned CA2[2];
#pragma unroll
    for (int i = 0; i < 2; ++i) { int R, C; stage_rc(tid * 16 + i * 8192, R, C); const int Rb = (R & ~31) + perm32(R & 31);
        voffA[i] = (unsigned)(R * g.lda + C) * 2u; voffB[i] = (unsigned)(Rb * g.ldb + C) * 2u; RA[i] = R; CA2[i] = (unsigned)C * 2u; }
    const size_t kstep = (size_t)(BK * 2);
    const size_t hstepA = (size_t)HALF * g.lda * 2, hstepB = (size_t)HALF * g.ldb * 2;
    const unsigned ldsw = (unsigned)wid * 1024u;
    const int aoff = lds_byte(wr * 64 + fr, fq * 8), boff = lds_byte(wc * 32 + fr, fq * 8);
#define PG8_SA(b, h) (((b) * 2 + (h)) * HTB)
#define PG8_SB(b, h) ((4 + (b) * 2 + (h)) * HTB)
#define PG8_STAGE(bufoff, gbase, voff) do { _Pragma("unroll") for (int _i = 0; _i < 2; ++_i) \
        __builtin_amdgcn_global_load_lds((const unsigned*)((const char*)(gbase) + (voff)[_i]), (LAS unsigned*)(lds + (bufoff) + ldsw + _i * 8192), 16, 0, 0); } while (0)
#define PG8_LDA(dst, b, h) do { _Pragma("unroll") for (int m = 0; m < 4; ++m) _Pragma("unroll") for (int k = 0; k < 2; ++k) dst[m][k] = *(const LAS bf16x8*)(lds + PG8_SA(b, h) + aoff + m * 2048 + k * 1024); } while (0)
#define PG8_LDB(dst, b, h) do { _Pragma("unroll") for (int n = 0; n < 2; ++n) _Pragma("unroll") for (int k = 0; k < 2; ++k) dst[n][k] = *(const LAS bf16x8*)(lds + PG8_SB(b, h) + boff + n * 2048 + k * 1024); } while (0)
#define PG8_MMA(ai, bj, At, Bt) do { __builtin_amdgcn_s_setprio(1); _Pragma("unroll") for (int m = 0; m < 4; ++m) _Pragma("unroll") for (int n = 0; n < 2; ++n) _Pragma("unroll") for (int k = 0; k < 2; ++k) \
        acc[ai][bj][m][n] = __builtin_amdgcn_mfma_f32_16x16x32_bf16(Bt[n][k], At[m][k], acc[ai][bj][m][n], 0, 0, 0); __builtin_amdgcn_s_setprio(0); } while (0)
#define PG8_WAIT_V(n) asm volatile("s_waitcnt vmcnt(" #n ")" ::: "memory")
#define PG8_WAIT_L(n) asm volatile("s_waitcnt lgkmcnt(" #n ")" ::: "memory")
#define PG8_BAR __builtin_amdgcn_s_barrier()
#define PG8_SCHED __builtin_amdgcn_sched_barrier(0)
    Unit cur, nxt; int ui = 0;
    if (!S.next(0, cur)) return;
    f32x4 acc[2][2][4][2];
#pragma unroll
    for (int a = 0; a < 2; ++a)
#pragma unroll
        for (int b = 0; b < 2; ++b)
#pragma unroll
            for (int m = 0; m < 4; ++m)
#pragma unroll
                for (int n = 0; n < 2; ++n) acc[a][b][m][n] = (f32x4){0.f, 0.f, 0.f, 0.f};
    bf16x8 At[4][2], B0[2][2], B1[2][2];
    unsigned gcur[2][2], gnxt[2][2];
    const char* cA = Sched::GATHER ? (const char*)g.A : S.a_base(g, cur); const char* cB = S.b_base(g, cur);
    if constexpr (Sched::GATHER) {
#pragma unroll
        for (int h = 0; h < 2; ++h)
#pragma unroll
            for (int i = 0; i < 2; ++i) { gcur[h][i] = S.a_rowoff(g, cur, h * HALF + RA[i]) + CA2[i]; gnxt[h][i] = gcur[h][i]; }
    }
#define PG8_STAGE_A(bufoff, base, h, GO) do { if constexpr (Sched::GATHER) { PG8_STAGE(bufoff, base, GO[h]); } else { PG8_STAGE(bufoff, (base) + (h) * hstepA, voffA); } } while (0)
    PG8_STAGE(PG8_SB(0, 0), cB, voffB); PG8_STAGE_A(PG8_SA(0, 0), cA, 0, gcur); PG8_STAGE(PG8_SB(0, 1), cB + hstepB, voffB); PG8_STAGE_A(PG8_SA(0, 1), cA, 1, gcur);
    if (wr == 1) PG8_BAR;
    PG8_WAIT_V(4); PG8_BAR;
    PG8_STAGE(PG8_SB(1, 0), cB + kstep, voffB); PG8_STAGE_A(PG8_SA(1, 0), cA + kstep, 0, gcur); PG8_STAGE(PG8_SB(1, 1), cB + hstepB + kstep, voffB);
    PG8_WAIT_V(6); PG8_BAR;
    for (;;) {
        const bool has_next = S.next(ui + 1, nxt);
        const char* nA = has_next ? (Sched::GATHER ? (const char*)g.A : S.a_base(g, nxt)) : cA; const char* nB = has_next ? S.b_base(g, nxt) : cB;
        if constexpr (Sched::GATHER) {
            if (has_next) {
#pragma unroll
                for (int h = 0; h < 2; ++h)
#pragma unroll
                    for (int i = 0; i < 2; ++i) gnxt[h][i] = S.a_rowoff(g, nxt, h * HALF + RA[i]) + CA2[i];
            }
        }
#pragma unroll 1
        for (int seg = 0; seg < (Epi::HAS_MID ? 2 : 1); ++seg) {
        const int tbeg = Epi::HAS_MID ? seg * (nt >> 1) : 0, tend = Epi::HAS_MID ? (seg + 1) * (nt >> 1) : nt;
        if constexpr (Epi::HAS_MID) { if (seg == 1) E.mid(acc, cur, wr, wc, fr, fq); }
#pragma unroll 1
        for (int t = tbeg; t < tend; t += 2) {
            const bool last = (t == nt - 2);
            const char* a1 = cA + (size_t)(t + 1) * kstep;
            const char* a2 = last ? nA : cA + (size_t)(t + 2) * kstep; const char* b2 = last ? nB : cB + (size_t)(t + 2) * kstep;
            const char* a3 = a2 + kstep; const char* b3 = b2 + kstep;
            unsigned g2[2][2];
            if constexpr (Sched::GATHER) {
#pragma unroll
                for (int h = 0; h < 2; ++h)
#pragma unroll
                    for (int i = 0; i < 2; ++i) g2[h][i] = last ? gnxt[h][i] : gcur[h][i];
            }
            PG8_LDB(B0, 0, 0); PG8_SCHED; PG8_LDA(At, 0, 0); PG8_STAGE_A(PG8_SA(1, 1), a1, 1, gcur);
            PG8_WAIT_L(8); PG8_BAR; PG8_WAIT_L(0); PG8_MMA(0, 0, At, B0); PG8_BAR; PG8_SCHED;
            PG8_LDB(B1, 0, 1); PG8_STAGE(PG8_SB(0, 0), b2, voffB);
            PG8_BAR; PG8_WAIT_L(0); PG8_MMA(0, 1, At, B1); PG8_BAR;
            PG8_LDA(At, 0, 1); PG8_STAGE_A(PG8_SA(0, 0), a2, 0, g2);
            PG8_BAR; PG8_WAIT_L(0); PG8_MMA(1, 0, At, B0); PG8_BAR; PG8_SCHED;
            PG8_STAGE(PG8_SB(0, 1), b2 + hstepB, voffB);
            PG8_WAIT_V(6); PG8_BAR; PG8_MMA(1, 1, At, B1); PG8_BAR;
            PG8_LDB(B0, 1, 0); PG8_SCHED; PG8_LDA(At, 1, 0); PG8_STAGE_A(PG8_SA(0, 1), a2, 1, g2);
            PG8_WAIT_L(8); PG8_BAR; PG8_WAIT_L(0); PG8_MMA(0, 0, At, B0); PG8_BAR; PG8_SCHED;
            PG8_LDB(B1, 1, 1); PG8_STAGE(PG8_SB(1, 0), b3, voffB);
            PG8_BAR; PG8_WAIT_L(0); PG8_MMA(0, 1, At, B1); PG8_BAR;
            PG8_LDA(At, 1, 1); PG8_STAGE_A(PG8_SA(1, 0), a3, 0, g2);
            PG8_BAR; PG8_WAIT_L(0); PG8_MMA(1, 0, At, B0); PG8_BAR; PG8_SCHED;
            PG8_STAGE(PG8_SB(1, 1), b3 + hstepB, voffB);
            PG8_WAIT_V(6); PG8_BAR; PG8_MMA(1, 1, At, B1); PG8_BAR;
        }
        }
        if (wr == 0) PG8_BAR;
        E(acc, cur, wr, wc, fr, fq);
        if (!has_next) break;
#pragma unroll
        for (int a = 0; a < 2; ++a)
#pragma unroll
            for (int b = 0; b < 2; ++b)
#pragma unroll
                for (int m = 0; m < 4; ++m)
#pragma unroll
                    for (int n = 0; n < 2; ++n) acc[a][b][m][n] = (f32x4){0.f, 0.f, 0.f, 0.f};
        cur = nxt; cA = nA; cB = nB; ++ui;
        if constexpr (Sched::GATHER) {
#pragma unroll
            for (int h = 0; h < 2; ++h)
#pragma unroll
                for (int i = 0; i < 2; ++i) gcur[h][i] = gnxt[h][i];
        }
        if (wr == 1) PG8_BAR;
    }
    PG8_WAIT_V(0);
    PG8_BAR;
#undef PG8_SA
#undef PG8_SB
#undef PG8_STAGE
#undef PG8_STAGE_A
#undef PG8_LDA
#undef PG8_LDB
#undef PG8_MMA
#undef PG8_WAIT_V
#undef PG8_WAIT_L
#undef PG8_BAR
#undef PG8_SCHED
}

__device__ __forceinline__ f32x2 gelu_pk(f32x2 v) {
    const f32x2 av = __builtin_elementwise_abs(v), d = av * 0.2316418882f + 1.0f;
    f32x2 t; t.x = __builtin_amdgcn_rcpf(d.x); t.y = __builtin_amdgcn_rcpf(d.y);
    f32x2 q = t * 0.5307027145f + (-0.7265760135f); q = q * t + 0.7107068705f; q = q * t + (-0.142248368f); q = q * t + 0.127414796f; q = q * t;
    const f32x2 s = (v * v) * (-0.72134752044f);
    f32x2 e; e.x = __builtin_amdgcn_exp2f(s.x); e.y = __builtin_amdgcn_exp2f(s.y);
    const f32x2 m = v * (q * e), r = v - m;
    f32x2 o; o.x = v.x < 0.f ? m.x : r.x; o.y = v.y < 0.f ? m.y : r.y; return o;
}
}
using pg8::Unit;

__device__ __forceinline__ u32x4 pack8(const f32x4 v0, const f32x4 v1) { u32x4 w; w.x = cvt_pk_bf16(v0[0], v0[1]); w.y = cvt_pk_bf16(v0[2], v0[3]); w.z = cvt_pk_bf16(v1[0], v1[1]); w.w = cvt_pk_bf16(v1[2], v1[3]); return w; }

struct EpiP {
    static constexpr bool HAS_MID = false;
    bf16_t* P;
    __device__ __forceinline__ void operator()(const f32x4 (&acc)[2][2][4][2], const Unit& u, int wr, int wc, int fr, int fq) const {
        const int row0 = u.pm * 256 + wr * 64 + fr, col0 = u.pn * 256 + wc * 32 + 8 * fq;
        const int act = u.pn < 14 ? 0 : (u.pn < 22 ? 1 : 2);
#pragma unroll
        for (int ai = 0; ai < 2; ++ai)
#pragma unroll
            for (int m = 0; m < 4; ++m) { const int row = row0 + ai * 128 + m * 16;
#pragma unroll
                for (int bj = 0; bj < 2; ++bj) { f32x4 v0 = acc[ai][bj][m][0], v1 = acc[ai][bj][m][1];
                    if (act == 2) {
#pragma unroll
                        for (int j = 0; j < 4; ++j) { v0[j] = sigmoidf_(v0[j]); v1[j] = sigmoidf_(v1[j]); } }
                    *(u32x4*)(P + (size_t)row * NP + col0 + bj * 128) = pack8(v0, v1); } }
    }
};
struct EpiLora {
    static constexpr bool HAS_MID = false;
    float* LOGW; bf16_t* AA; bf16_t* GG; const float* w0; const float* a0;
    __device__ __forceinline__ void operator()(const f32x4 (&acc)[2][2][4][2], const Unit& u, int wr, int wc, int fr, int fq) const {
        const int row0 = u.pm * 256 + wr * 64 + fr, seg = u.pn >> 2, colt = (u.pn & 3) * 256 + wc * 32 + 8 * fq;
        const float* bsrc = seg == 0 ? w0 : a0;
        f32x4 bb[2][2];
#pragma unroll
        for (int bj = 0; bj < 2; ++bj) { bb[bj][0] = *(const f32x4*)(bsrc + colt + bj * 128); bb[bj][1] = *(const f32x4*)(bsrc + colt + bj * 128 + 4); }
#pragma unroll
        for (int ai = 0; ai < 2; ++ai)
#pragma unroll
            for (int m = 0; m < 4; ++m) { const int row = row0 + ai * 128 + m * 16;
#pragma unroll
                for (int bj = 0; bj < 2; ++bj) { f32x4 v0 = acc[ai][bj][m][0], v1 = acc[ai][bj][m][1];
                    const int col = colt + bj * 128;
                    if (seg == 0) {
#pragma unroll
                        for (int j = 0; j < 4; ++j) {
                            { const float z = bb[bj][0][j] + v0[j]; const float sp = fmaxf(-z, 0.f) + __logf(1.0f + __expf(-fabsf(z))); v0[j] = -__expf(-sp - 0.5f); }
                            { const float z = bb[bj][1][j] + v1[j]; const float sp = fmaxf(-z, 0.f) + __logf(1.0f + __expf(-fabsf(z))); v1[j] = -__expf(-sp - 0.5f); } }
                        float* o = LOGW + (size_t)row * D + col; *(f32x4*)o = v0; *(f32x4*)(o + 4) = v1;
                    } else if (seg == 1) {
#pragma unroll
                        for (int j = 0; j < 4; ++j) { v0[j] = sigmoidf_(bb[bj][0][j] + v0[j]); v1[j] = sigmoidf_(bb[bj][1][j] + v1[j]); }
                        *(u32x4*)(AA + (size_t)row * D + col) = pack8(v0, v1);
                    } else {
                        *(u32x4*)(GG + (size_t)row * D + col) = pack8(v0, v1);
                    }
                    __builtin_amdgcn_sched_barrier(0); } }
    }
};
template <int MODE> struct EpiMix {
    static constexpr bool HAS_MID = false;
    const bf16_t* P; float* F; bf16_t* Bo; const float* X; int ldc;
    __device__ __forceinline__ void operator()(const f32x4 (&acc)[2][2][4][2], const Unit& u, int wr, int wc, int fr, int fq) const {
        const int row0 = u.pm * 256 + wr * 64 + fr, col0 = u.pn * 256 + wc * 32 + 8 * fq;
#pragma unroll
        for (int ai = 0; ai < 2; ++ai)
#pragma unroll
            for (int m = 0; m < 4; ++m) { const int row = row0 + ai * 128 + m * 16;
#pragma unroll
                for (int bj = 0; bj < 2; ++bj) { f32x4 v0 = acc[ai][bj][m][0], v1 = acc[ai][bj][m][1];
                    const int col = col0 + bj * 128;
                    if (MODE == 0 || MODE == 1) {
                        const u32x4 gw = *(const u32x4*)(P + (size_t)row * NP + (MODE == 0 ? PC_GA : PC_GB) + col); float gf[8]; unpack8(gw, gf);
#pragma unroll
                        for (int j = 0; j < 4; ++j) { v0[j] *= gf[j]; v1[j] *= gf[4 + j]; }
                    }
                    if (MODE == 0) { float* o = F + (size_t)row * D + col; *(f32x4*)o = v0; *(f32x4*)(o + 4) = v1; }
                    if (MODE == 1) { const float* t1 = F + (size_t)row * D + col; v0 = v0 + *(const f32x4*)t1; v1 = v1 + *(const f32x4*)(t1 + 4); *(u32x4*)(Bo + (size_t)row * D + col) = pack8(v0, v1); }
                    if (MODE == 2) { const float* xr = X + (size_t)row * D + col; v0 = v0 + ALPHA * *(const f32x4*)xr; v1 = v1 + ALPHA * *(const f32x4*)(xr + 4);
                        float* o = F + (size_t)row * D + col; *(f32x4*)o = v0; *(f32x4*)(o + 4) = v1; }
                    if (MODE == 3) { float* o = F + (size_t)row * ldc + col; *(f32x4*)o = v0; *(f32x4*)(o + 4) = v1; } } }
    }
};
struct EpiGate {
    static constexpr bool HAS_MID = true;
    const bf16_t* P; bf16_t* Bo;
    __device__ __forceinline__ void mid(f32x4 (&acc)[2][2][4][2], const Unit& u, int wr, int wc, int fr, int fq) const {
        const int row0 = u.pm * 256 + wr * 64 + fr, col0 = u.pn * 256 + wc * 32 + 8 * fq;
#pragma unroll
        for (int ai = 0; ai < 2; ++ai)
#pragma unroll
            for (int m = 0; m < 4; ++m) { const int row = row0 + ai * 128 + m * 16;
#pragma unroll
                for (int bj = 0; bj < 2; ++bj) { float ga[8], gb[8];
                    unsigned off = (unsigned)(row * NP + col0 + bj * 128 + PC_GA); asm volatile("" : "+v"(off));
                    unpack8(*(const u32x4*)(P + off), ga); unpack8(*(const u32x4*)(P + off + (PC_GB - PC_GA)), gb);
#pragma unroll
                    for (int j = 0; j < 4; ++j) { acc[ai][bj][m][0][j] *= ga[j] * __builtin_amdgcn_rcpf(fmaxf(gb[j], 1e-30f)); acc[ai][bj][m][1][j] *= ga[4 + j] * __builtin_amdgcn_rcpf(fmaxf(gb[4 + j], 1e-30f)); }
                    asm volatile("" : "+v"(acc[ai][bj][m][0]), "+v"(acc[ai][bj][m][1]) :: "memory"); __builtin_amdgcn_sched_barrier(0); } }
    }
    __device__ __forceinline__ void operator()(const f32x4 (&acc)[2][2][4][2], const Unit& u, int wr, int wc, int fr, int fq) const {
        const int row0 = u.pm * 256 + wr * 64 + fr, col0 = u.pn * 256 + wc * 32 + 8 * fq;
#pragma unroll
        for (int ai = 0; ai < 2; ++ai)
#pragma unroll
            for (int m = 0; m < 4; ++m) { const int row = row0 + ai * 128 + m * 16;
#pragma unroll
                for (int bj = 0; bj < 2; ++bj) { const int col = col0 + bj * 128; float gb[8]; unpack8(*(const u32x4*)(P + (size_t)row * NP + PC_GB + col), gb);
                    f32x4 v0 = acc[ai][bj][m][0], v1 = acc[ai][bj][m][1];
#pragma unroll
                    for (int j = 0; j < 4; ++j) { v0[j] *= fmaxf(gb[j], 1e-30f); v1[j] *= fmaxf(gb[4 + j], 1e-30f); }
                    *(u32x4*)(Bo + (size_t)row * D + col) = pack8(v0, v1); } }
    }
};
struct EpiAct {
    static constexpr bool HAS_MID = false;
    bf16_t* ACT;
    __device__ __forceinline__ void operator()(const f32x4 (&acc)[2][2][4][2], const Unit& u, int wr, int wc, int fr, int fq) const {
        const int row0 = u.pm * 256 + wr * 64 + fr, col = u.pn * 128 + wc * 32 + 8 * fq;
#pragma unroll
        for (int ai = 0; ai < 2; ++ai)
#pragma unroll
            for (int m = 0; m < 4; ++m) { const int row = row0 + ai * 128 + m * 16;
                f32x4 g0 = acc[ai][0][m][0], g1 = acc[ai][0][m][1]; const f32x4 u0 = acc[ai][1][m][0], u1 = acc[ai][1][m][1];
#pragma unroll
                for (int j = 0; j < 4; ++j) { g0[j] = g0[j] * sigmoidf_(g0[j]) * u0[j]; g1[j] = g1[j] * sigmoidf_(g1[j]) * u1[j]; }
                *(u32x4*)(ACT + (size_t)row * 256 + col) = pack8(g0, g1); }
    }
};
struct EpiDown {
    static constexpr bool HAS_MID = false;
    bf16_t* YR; const float* row_gate;
    __device__ __forceinline__ void operator()(const f32x4 (&acc)[2][2][4][2], const Unit& u, int wr, int wc, int fr, int fq) const {
        const int row0 = u.pm * 256 + wr * 64 + fr, col0 = u.pn * 256 + wc * 32 + 8 * fq;
#pragma unroll
        for (int ai = 0; ai < 2; ++ai)
#pragma unroll
            for (int m = 0; m < 4; ++m) { const int row = row0 + ai * 128 + m * 16; const float gt = row_gate[row];
#pragma unroll
                for (int bj = 0; bj < 2; ++bj) { const f32x4 v0 = acc[ai][bj][m][0] * gt, v1 = acc[ai][bj][m][1] * gt;
                    *(u32x4*)(YR + (size_t)row * D + col0 + bj * 128) = pack8(v0, v1); } }
    }
};

struct Args { const float* in[30]; float* out; unsigned char* ws; int ph_lo, ph_hi; };
struct Frame {
    LAS unsigned char* lds;
    int tid, lane, wave, G, gw, NGW;
    const __attribute__((address_space(4))) char* ka; float* out; unsigned char* ws; unsigned* ctl;
    __device__ __forceinline__ const float* in(int i) const { return *(const float* const __attribute__((address_space(4)))*)(ka + 8 * i); }
};
#define WSP(T_, off) ((T_*)(F.ws + (off)))

struct TrItem { const float* W; int N, k0, n0; bf16_t* WT; int ldo, drow0; };
__device__ __forceinline__ void tr_load(f32x4 (&v)[8], const TrItem& t, int lane) {
#pragma unroll
    for (int i = 0; i < 8; ++i) v[i] = *(const f32x4*)(t.W + (size_t)(t.k0 + (lane >> 3) + 8 * i) * t.N + t.n0 + 4 * (lane & 7));
}
__device__ __forceinline__ void tr_store(const f32x4 (&v)[8], const TrItem& t, LAS float* scr, int lane) {
#pragma unroll
    for (int i = 0; i < 8; ++i) { LAS float* d = scr + ((lane >> 3) + 8 * i) * 33 + 4 * (lane & 7); d[0] = v[i][0]; d[1] = v[i][1]; d[2] = v[i][2]; d[3] = v[i][3]; }
    asm volatile("s_waitcnt lgkmcnt(0)" ::: "memory");
    const int c = lane & 7;
#pragma unroll
    for (int j = 0; j < 4; ++j) { const int n = (lane >> 3) + 8 * j; const LAS float* s = scr + (8 * c) * 33 + n;
        u32x4 o; o.x = cvt_pk_bf16(s[0 * 33], s[1 * 33]); o.y = cvt_pk_bf16(s[2 * 33], s[3 * 33]); o.z = cvt_pk_bf16(s[4 * 33], s[5 * 33]); o.w = cvt_pk_bf16(s[6 * 33], s[7 * 33]);
        *(u32x4*)(t.WT + (size_t)(t.drow0 + n) * t.ldo + t.k0 + 8 * c) = o; }
    asm volatile("s_waitcnt lgkmcnt(0)" ::: "memory");
}
constexpr int I_GU = 16 * 16, I_DN = 4 * 32, N_EXPERT_ITEMS = 257 * I_GU + 257 * I_DN;
__device__ __forceinline__ TrItem expert_item(Frame& F, int it) {
    TrItem t; int r = it;
    if (r < 257 * I_GU) { const int e = r / I_GU, q = r % I_GU, kb = q / 16, nb = q % 16, n0 = nb * 32;
        t.W = e < 256 ? F.in(24) + (size_t)e * 1024 * 512 : F.in(26); t.N = 512; t.k0 = kb * 64; t.n0 = n0;
        const int half = n0 >> 8, idx = n0 & 255; t.drow0 = (idx >> 7) * 256 + half * 128 + (idx & 127);
        t.WT = WSP(bf16_t, WS_WT_GU) + (size_t)e * 512 * 1024; t.ldo = 1024; return t; }
    r -= 257 * I_GU;
    { const int e = r / I_DN, q = r % I_DN, kb = q / 32, nb = q % 32;
        t.W = e < 256 ? F.in(25) + (size_t)e * 256 * 1024 : F.in(27); t.N = 1024; t.k0 = kb * 64; t.n0 = nb * 32; t.drow0 = nb * 32;
        t.WT = WSP(bf16_t, WS_WT_DN) + (size_t)e * 1024 * 256; t.ldo = 256; return t; }
}
__device__ __forceinline__ void p0b_expert_weights(Frame& F) {
    LAS float* scr = (LAS float*)(F.lds + F.wave * 8448);
    for (;;) {
        int base = 0; if (F.lane == 0) base = (int)__hip_atomic_fetch_add(F.ctl + CW_CONVQ, 16u, __ATOMIC_RELAXED, __HIP_MEMORY_SCOPE_AGENT);
        base = __builtin_amdgcn_readfirstlane(base);
        if (base >= N_EXPERT_ITEMS) break;
        const int lim = base + 16 < N_EXPERT_ITEMS ? base + 16 : N_EXPERT_ITEMS;
        f32x4 va[8], vb[8];
        TrItem ta = expert_item(F, base), tb = ta; tr_load(va, ta, F.lane);
#pragma unroll 1
        for (int it = base; it < lim; it += 2) {
            const bool hb = it + 1 < lim; tb = expert_item(F, hb ? it + 1 : it); tr_load(vb, tb, F.lane);
            tr_store(va, ta, scr, F.lane);
            const bool ha = it + 2 < lim; ta = expert_item(F, ha ? it + 2 : it); tr_load(va, ta, F.lane);
            if (hb) tr_store(vb, tb, scr, F.lane);
        }
    }
}
__device__ __forceinline__ void p0_prologue(Frame& F) {
    LAS float* scr = (LAS float*)(F.lds + F.wave * 8448);
    constexpr int I_IN = 16 * 233, I_SQ = 16 * 32;
    constexpr int NITEMS = I_IN + 3 * I_SQ;
    for (int it = F.gw; it < NITEMS; it += F.NGW) {
        int r = it; TrItem t; f32x4 v[8];
        if (r < I_IN) { const int kb = r / 233, nb = r % 233, n0 = nb * 32; t = TrItem{F.in(1), C_IN, kb * 64, n0, WSP(bf16_t, WS_WT_IN), D, n0 < 3360 ? n0 : n0 + 224}; }
        else { r -= I_IN; const int w = r / I_SQ, q = r % I_SQ, kb = q / 32, nb = q % 32;
            t = TrItem{w == 0 ? F.in(17) : (w == 1 ? F.in(18) : F.in(19)), D, kb * 64, nb * 32, w == 2 ? WSP(bf16_t, WS_WT_OUT) : WSP(bf16_t, WS_WT_OA) + w * 1024, w == 2 ? D : 2048, nb * 32}; }
        tr_load(v, t, F.lane); tr_store(v, t, scr, F.lane);
    }
    const size_t gt = (size_t)blockIdx.x * 512 + F.tid, NT = (size_t)F.G * 512;
    { bf16_t* w = WSP(bf16_t, WS_WT_IN) + (size_t)3360 * D; for (size_t i = gt; i < (size_t)224 * D / 8; i += NT) ((u32x4*)w)[i] = (u32x4){0u, 0u, 0u, 0u}; }
    { bf16_t* w = WSP(bf16_t, WS_WT_LORA);
      for (size_t i = gt; i < (size_t)3072 * LK; i += NT) { const int n = (int)(i / LK), k = (int)(i % LK); float v = 0.f;
          if (n < 1024) { if (k < 64) v = F.in(4)[(size_t)k * D + n]; }
          else if (n < 2048) { if (k >= 64 && k < 128) v = F.in(6)[(size_t)(k - 64) * D + (n - 1024)]; }
          else { if (k >= 128 && k < 288) v = F.in(7)[(size_t)(k - 128) * D + (n - 2048)]; }
          w[i] = (bf16_t)f2bf(v); } }
    { bf16_t* w = WSP(bf16_t, WS_WT_R);
      for (size_t i = gt; i < (size_t)256 * HRK; i += NT) { const int n = (int)(i / HRK), k = (int)(i % HRK), kk = k & 1023, seg = k >> 10;
          const float v = F.in(22)[(size_t)kk * NE + n]; const unsigned hi = f2bf(v); const float lo = v - bf2f(hi);
          w[i] = (bf16_t)(seg == 2 ? f2bf(lo) : hi); } }
    { const f32x4* x = (const f32x4*)F.in(0); u32x2* xb = WSP(u32x2, WS_XB);
      for (size_t i = gt; i < (size_t)T * D / 4; i += NT) { const f32x4 v = x[i]; u32x2 o; o.x = cvt_pk_bf16(v[0], v[1]); o.y = cvt_pk_bf16(v[2], v[3]); xb[i] = o; } }
}

__device__ __forceinline__ void p2_lora_in(Frame& F) {
    const bf16_t* P = WSP(bf16_t, WS_P); bf16_t* L = WSP(bf16_t, WS_LORAIN); const float* mu = F.in(2);
    for (int t = F.gw; t < T; t += F.NGW) {
        const bool first = (t % SEQ) == 0;
#pragma unroll
        for (int j = 0; j < 6; ++j) { const int c = F.lane + 64 * j; float v = 0.f;
            if (c < 288) { const float cur = bf2f(P[(size_t)t * NP + PC_L + c]); const float prev = first ? 0.f : bf2f(P[(size_t)(t - 1) * NP + PC_L + c]);
                const float m = cur + mu[3072 + c] * (prev - cur);
                v = c < 64 ? tanhf(m) : (c < 128 ? m : sigmoidf_(m)); }
            L[(size_t)t * LK + c] = (bf16_t)f2bf(v); }
    }
}

__device__ __forceinline__ void p2_gmlp(Frame& F) {
    const bf16_t* P = WSP(bf16_t, WS_P); bf16_t* YB = WSP(bf16_t, WS_YA);
    const float* lnw = F.in(13); const float* lnb = F.in(14); const float* sw = F.in(15); const float* sb = F.in(16);
    LAS bf16_t* VT = (LAS bf16_t*)F.lds;
    LAS float* ST = (LAS float*)(F.lds + 36864);
    const int lane = F.lane, wave = F.wave, fr = lane & 15, fq = lane >> 4;
    for (int ch = blockIdx.x; ch < T / 128; ch += F.G) {
        const int t0 = ch * 128;
        for (int i = 0; i < 16; ++i) { const int tl = wave * 16 + i; const bf16_t* vr = P + (size_t)(t0 + tl) * NP + PC_GV;
            float f0[8], f1[8]; unpack8(*(const u32x4*)(vr + lane * 8), f0); unpack8(*(const u32x4*)(vr + 512 + lane * 8), f1);
#pragma unroll
            for (int j = 0; j < 8; j += 2) { const f32x2 a = pg8::gelu_pk((f32x2){f0[j], f0[j + 1]}), b = pg8::gelu_pk((f32x2){f1[j], f1[j + 1]}); f0[j] = a.x; f0[j + 1] = a.y; f1[j] = b.x; f1[j + 1] = b.y; }
            float s = 0.f;
#pragma unroll
            for (int j = 0; j < 8; ++j) s += f0[j] + f1[j];
            const float mean = wave_sum(s) * (1.f / 1024.f); float q = 0.f;
#pragma unroll
            for (int j = 0; j < 8; ++j) { const float a = f0[j] - mean, b = f1[j] - mean; q += a * a + b * b; }
            const float rstd = 1.0f / sqrtf(wave_sum(q) * (1.f / 1024.f) + LN_EPS);
            if (lane == 0) { ST[tl * 2] = mean; ST[tl * 2 + 1] = rstd; } }
        __syncthreads();
        for (int g = 0; g < 8; ++g) {
            { const int s = F.tid >> 2, d0 = (F.tid & 3) * 32; const float mean = ST[s * 2], rstd = ST[s * 2 + 1];
              const bf16_t* vr = P + (size_t)(t0 + s) * NP + PC_GV + g * 128 + d0;
#pragma unroll
              for (int q4 = 0; q4 < 4; ++q4) { float f[8]; unpack8(*(const u32x4*)(vr + q4 * 8), f);
#pragma unroll
                  for (int j = 0; j < 8; j += 2) { const f32x2 a = pg8::gelu_pk((f32x2){f[j], f[j + 1]}); f[j] = a.x; f[j + 1] = a.y; }
#pragma unroll
                  for (int j = 0; j < 8; ++j) { const int d = d0 + q4 * 8 + j; const float v = (f[j] - mean) * rstd * lnw[g * 128 + d] + lnb[g * 128 + d];
                      VT[d * 136 + s] = (bf16_t)f2bf(v); } } }
            __syncthreads();
            f32x4 acc[8];
#pragma unroll
            for (int n = 0; n < 8; ++n) acc[n] = (f32x4){0.f, 0.f, 0.f, 0.f};
            const int tl = wave * 16 + fr;
            const float* wrow = sw + ((size_t)g * 128 + tl) * 128;
#pragma unroll
            for (int ks = 0; ks < 4; ++ks) {
                if (ks * 32 <= wave * 16 + 15) {
                    const int s0 = ks * 32 + fq * 8;
                    const f32x4 w0 = *(const f32x4*)(wrow + s0), w1 = *(const f32x4*)(wrow + s0 + 4);
                    float wf[8] = {w0[0], w0[1], w0[2], w0[3], w1[0], w1[1], w1[2], w1[3]};
#pragma unroll
                    for (int j = 0; j < 8; ++j) wf[j] = (s0 + j <= tl) ? wf[j] : 0.f;
                    u32x4 aw; aw.x = cvt_pk_bf16(wf[0], wf[1]); aw.y = cvt_pk_bf16(wf[2], wf[3]); aw.z = cvt_pk_bf16(wf[4], wf[5]); aw.w = cvt_pk_bf16(wf[6], wf[7]);
                    const bf16x8 af = __builtin_bit_cast(bf16x8, aw);
#pragma unroll
                    for (int n = 0; n < 8; ++n) { const bf16x8 bfrag = *(const LAS bf16x8*)(VT + (n * 16 + fr) * 136 + s0);
                        acc[n] = __builtin_amdgcn_mfma_f32_16x16x32_bf16(bfrag, af, acc[n], 0, 0, 0); }
                }
            }
            const float bias = sb[g * 128 + tl];
            const bf16_t* ur = P + (size_t)(t0 + tl) * NP + PC_U + g * 128; bf16_t* yr = YB + (size_t)(t0 + tl) * 2048 + 1024 + g * 128;
#pragma unroll
            for (int n = 0; n < 8; ++n) { const int d = n * 16 + 4 * fq; const u32x2 uw = *(const u32x2*)(ur + d);
                const f32x2 u01 = pg8::gelu_pk((f32x2){bf2f(uw.x & 0xffffu), bf2f(uw.x >> 16)}), u23 = pg8::gelu_pk((f32x2){bf2f(uw.y & 0xffffu), bf2f(uw.y >> 16)});
                const float o0 = u01.x * (acc[n][0] + bias), o1 = u01.y * (acc[n][1] + bias), o2 = u23.x * (acc[n][2] + bias), o3 = u23.y * (acc[n][3] + bias);
                u32x2 o; o.x = cvt_pk_bf16(o0, o1); o.y = cvt_pk_bf16(o2, o3); *(u32x2*)(yr + d) = o; }
            __syncthreads();
        }
    }
}

constexpr int NCH2 = SEQ / 32;
constexpr int TS2 = 68;
constexpr int WTILE = 32 * TS2 * 2;
constexpr int WLDS = 4 * WTILE + 256;
constexpr int SH_OFF = 8 * WLDS;
constexpr int SH_W_STRIDE = 72;
constexpr int SH_PRM = SH_OFF + 2 * 64 * SH_W_STRIDE * 2;
constexpr int SH_G_STRIDE = 168;
static_assert(SH_PRM + 8 * 64 * 4 <= MISC_OFF && SH_OFF + 64 * SH_G_STRIDE * 2 + 2 * 64 * 4 <= MISC_OFF, "scan LDS");
typedef __attribute__((address_space(3))) bf16_t lbf16;
typedef short s16x4 __attribute__((ext_vector_type(4)));
__device__ __forceinline__ f32x4 mfma16(const bf16x8 a, const bf16x8 b, const f32x4 c) { return __builtin_amdgcn_mfma_f32_16x16x32_bf16(a, b, c, 0, 0, 0); }
__device__ __forceinline__ u32x2 pk4(const f32x4 v) { u32x2 o; o.x = cvt_pk_bf16(v[0], v[1]); o.y = cvt_pk_bf16(v[2], v[3]); return o; }
__device__ __forceinline__ bf16x8 mkfrag(const u32x2 lo, const u32x2 hi) { u32x4 t; t.x = lo.x; t.y = lo.y; t.z = hi.x; t.w = hi.y; return __builtin_bit_cast(bf16x8, t); }
__device__ __forceinline__ f32x4 up4(const u32x2 w) { return (f32x4){bf2f(w.x & 0xffffu), bf2f(w.x >> 16), bf2f(w.y & 0xffffu), bf2f(w.y >> 16)}; }
__device__ __forceinline__ void unfrag(const bf16x8 f, f32x4& lo, f32x4& hi) { const u32x4 t = __builtin_bit_cast(u32x4, f); u32x2 a; a.x = t.x; a.y = t.y; u32x2 b; b.x = t.z; b.y = t.w; lo = up4(a); hi = up4(b); }
__device__ __forceinline__ bf16x8 tr_frag(const lbf16* tile, int ct, int fr, int fq) {
    const lbf16* p = tile + (4 * fq + (fr >> 2)) * TS2 + 16 * ct + 4 * (fr & 3);
    const s16x4 lo = __builtin_amdgcn_ds_read_tr16_b64_v4i16((LAS s16x4*)p), hi = __builtin_amdgcn_ds_read_tr16_b64_v4i16((LAS s16x4*)(p + 16 * TS2));
    return __builtin_shufflevector(lo, hi, 0, 1, 2, 3, 4, 5, 6, 7);
}
__device__ __forceinline__ void prod32(const bf16x8 (&X)[2], const bf16x8 (&Y)[2], const bf16x8* init, bf16x8 (&R)[2]) {
#pragma unroll
    for (int mt = 0; mt < 2; ++mt) { f32x4 d0 = (f32x4){0.f, 0.f, 0.f, 0.f}, d1 = d0; if (init) unfrag(init[mt], d0, d1);
        d0 = mfma16(Y[0], X[mt], d0); d1 = mfma16(Y[1], X[mt], d1); R[mt] = mkfrag(pk4(d0), pk4(d1)); }
}
#define WAVE_LDS_SYNC() do { asm volatile("s_waitcnt lgkmcnt(0)" ::: "memory"); __builtin_amdgcn_wave_barrier(); } while (0)

__device__ __forceinline__ void scan_pass1(Frame& F) {
    const bf16_t* P = WSP(bf16_t, WS_P);
    bf16_t* PT = WSP(bf16_t, WS_PT); bf16_t* QQ = WSP(bf16_t, WS_QQ); bf16_t* RH = WSP(bf16_t, WS_RH); bf16_t* Y0 = WSP(bf16_t, WS_Y0); bf16_t* BV = WSP(bf16_t, WS_BV);
    const float* mu = F.in(2);
    lbf16* tA = (lbf16*)(F.lds + F.wave * WLDS); lbf16* tB = tA + 32 * TS2; lbf16* tK = tB + 32 * TS2; lbf16* tV = tK + 32 * TS2;
    LAS float* WLs = (LAS float*)(F.lds + F.wave * WLDS + 4 * WTILE);
    const int bh = blockIdx.x & 63, b = bh >> 4, h = bh & 15, cstep = 8 * (F.G >> 6);
    lbf16* shW = (lbf16*)(F.lds + SH_OFF); LAS float* shP = (LAS float*)(F.lds + SH_PRM);
    { const bf16_t* WTL = WSP(bf16_t, WS_WT_LORA);
      for (int i = F.tid; i < 2 * 64 * 8; i += 512) { const int sg = i >> 9, n = (i >> 3) & 63, ch8 = i & 7;
          *(LAS u32x4*)(shW + (sg * 64 + n) * SH_W_STRIDE + ch8 * 8) = *(const u32x4*)(WTL + (size_t)(sg * 1024 + h * 64 + n) * LK + sg * 64 + ch8 * 8); }
      if (F.tid < 512) { const int pi = F.tid >> 6, ch = F.tid & 63; const float* srcp = pi < 3 ? mu + pi * 1024 : F.in(pi == 3 ? 8 : (pi == 4 ? 9 : (pi == 5 ? 10 : (pi == 6 ? 3 : 5))));
          shP[pi * 64 + ch] = srcp[h * 64 + ch]; } }
    __syncthreads();
#pragma unroll 1
    for (int c = 8 * (blockIdx.x >> 6) + F.wave; c < NCH2; c += cstep) {
        int lane_o = F.lane; asm volatile("" : "+v"(lane_o));
        const int lane = lane_o, fr = lane & 15, fq = lane >> 4;
        const int item = c * 64 + bh;
        const size_t tok0 = (size_t)b * SEQ + (size_t)c * 32;
        bf16x8 fR[2][2];
        {
            const bf16_t* LIN = WSP(bf16_t, WS_LORAIN);
            float carry[2][8];
#pragma unroll
            for (int ks = 0; ks < 2; ++ks)
#pragma unroll
                for (int j = 0; j < 8; ++j) carry[ks][j] = 0.f;
#pragma unroll
            for (int rt = 0; rt < 2; ++rt) {
                const size_t row = tok0 + 16 * rt + fr; const bool first = (c == 0 && rt == 0 && fr == 0); const size_t prow = first ? row : row - 1;
                float r[2][8], k[2][8], v[2][8], a[2][8], lw[2][8];
                {
                    bf16x8 lf[2][2];
#pragma unroll
                    for (int sg = 0; sg < 2; ++sg)
#pragma unroll
                        for (int kq = 0; kq < 2; ++kq) lf[sg][kq] = *(const bf16x8*)(LIN + row * LK + sg * 64 + 32 * kq + 8 * fq);
#pragma unroll
                    for (int nt = 0; nt < 4; ++nt) { f32x4 dw = (f32x4){0.f, 0.f, 0.f, 0.f}, da = dw;
#pragma unroll
                        for (int kq = 0; kq < 2; ++kq) {
                            dw = mfma16(*(const LAS bf16x8*)(shW + (16 * nt + fr) * SH_W_STRIDE + 32 * kq + 8 * fq), lf[0][kq], dw);
                            da = mfma16(*(const LAS bf16x8*)(shW + (64 + 16 * nt + fr) * SH_W_STRIDE + 32 * kq + 8 * fq), lf[1][kq], da); }
                        const int cc = 16 * nt + 4 * fq; const f32x4 w0 = *(const LAS f32x4*)(shP + 6 * 64 + cc), a0 = *(const LAS f32x4*)(shP + 7 * 64 + cc);
#pragma unroll
                        for (int rg = 0; rg < 4; ++rg) { const float z = w0[rg] + dw[rg]; const float sp = fmaxf(-z, 0.f) + __logf(1.0f + __expf(-fabsf(z)));
                            lw[nt >> 1][4 * (nt & 1) + rg] = -__expf(-sp - 0.5f); a[nt >> 1][4 * (nt & 1) + rg] = sigmoidf_(a0[rg] + da[rg]); } }
                }
#pragma unroll
                for (int ks = 0; ks < 2; ++ks) {
#pragma unroll
                    for (int hf = 0; hf < 2; ++hf) { const int col = h * 64 + 32 * ks + 16 * hf + 4 * fq;
                        { const f32x4 cur = up4(*(const u32x2*)(P + row * NP + PC_R + col)); f32x4 prv = up4(*(const u32x2*)(P + prow * NP + PC_R + col)); if (first) prv = (f32x4){0.f, 0.f, 0.f, 0.f};
                          const f32x4 m4 = *(const LAS f32x4*)(shP + 0 * 64 + (col - h * 64)), o = cur + m4 * (prv - cur);
#pragma unroll
                          for (int j = 0; j < 4; ++j) r[ks][4 * hf + j] = o[j]; }
                        { const f32x4 cur = up4(*(const u32x2*)(P + row * NP + PC_K + col)); f32x4 prv = up4(*(const u32x2*)(P + prow * NP + PC_K + col)); if (first) prv = (f32x4){0.f, 0.f, 0.f, 0.f};
                          const f32x4 m4 = *(const LAS f32x4*)(shP + 1 * 64 + (col - h * 64)), o = cur + m4 * (prv - cur);
#pragma unroll
                          for (int j = 0; j < 4; ++j) k[ks][4 * hf + j] = o[j]; }
                        { const f32x4 cur = up4(*(const u32x2*)(P + row * NP + PC_V + col)); f32x4 prv = up4(*(const u32x2*)(P + prow * NP + PC_V + col)); if (first) prv = (f32x4){0.f, 0.f, 0.f, 0.f};
                          const f32x4 m4 = *(const LAS f32x4*)(shP + 2 * 64 + (col - h * 64)), o = cur + m4 * (prv - cur);
#pragma unroll
                          for (int j = 0; j < 4; ++j) v[ks][4 * hf + j] = o[j]; } }
                    asm volatile("" ::: "memory"); }
                float kk[2][8], n2 = 0.f, bon = 0.f;
#pragma unroll
                for (int ks = 0; ks < 2; ++ks)
#pragma unroll
                    for (int hf = 0; hf < 2; ++hf) { const f32x4 kk4 = *(const LAS f32x4*)(shP + 3 * 64 + 32 * ks + 16 * hf + 4 * fq);
#pragma unroll
                        for (int j = 0; j < 4; ++j) { kk[ks][4 * hf + j] = k[ks][4 * hf + j] * kk4[j]; n2 += kk[ks][4 * hf + j] * kk[ks][4 * hf + j]; } }
                n2 += __shfl_xor(n2, 16); n2 += __shfl_xor(n2, 32);
                const float inv = 1.0f / fmaxf(sqrtf(n2), 1e-12f);
#pragma unroll
                for (int ks = 0; ks < 2; ++ks)
#pragma unroll
                    for (int hf = 0; hf < 2; ++hf) { const int cc = 32 * ks + 16 * hf + 4 * fq; const f32x4 ka4 = *(const LAS f32x4*)(shP + 4 * 64 + cc), rk4 = *(const LAS f32x4*)(shP + 5 * 64 + cc);
#pragma unroll
                        for (int j = 0; j < 4; ++j) { const int q = 4 * hf + j; kk[ks][q] *= inv; k[ks][q] = k[ks][q] * (1.0f + (a[ks][q] - 1.0f) * ka4[j]); bon += r[ks][q] * k[ks][q] * rk4[j]; } }
                bon += __shfl_xor(bon, 16); bon += __shfl_xor(bon, 32);
#pragma unroll
                for (int ks = 0; ks < 2; ++ks)
#pragma unroll
                    for (int hf = 0; hf < 2; ++hf) { const int cl = 32 * ks + 16 * hf + 4 * fq; const f32x4 v4 = (f32x4){v[ks][4 * hf], v[ks][4 * hf + 1], v[ks][4 * hf + 2], v[ks][4 * hf + 3]};
                        *(u32x2*)(BV + row * D + h * 64 + cl) = pk4(v4 * bon);
                        *(LAS u32x2*)(tV + (16 * rt + fr) * TS2 + cl) = pk4(v4); }
#pragma unroll
                for (int ks = 0; ks < 2; ++ks)
#pragma unroll
                    for (int j = 0; j < 8; ++j) { float x = lw[ks][j];
#pragma unroll
                        for (int d = 1; d < 16; d <<= 1) { const float y = __shfl_up(x, d, 16); x += (fr >= d) ? y : 0.f; }
                        const float tot = __shfl(x, (lane & 48) | 15); const float cw = x + carry[ks][j]; carry[ks][j] += tot;
                        const float e1 = __expf(cw), e2 = __expf(-cw), e3 = __expf(cw - lw[ks][j]);
                        const float at = -kk[ks][j] * e3, bt = kk[ks][j] * a[ks][j] * e2, kt = k[ks][j] * e2, rr = r[ks][j] * e1;
                        r[ks][j] = rr; a[ks][j] = at; lw[ks][j] = bt; k[ks][j] = kt;
                        if (rt == 1) { const float wl = __shfl(e1, (lane & 48) | 15); if (fr == 0) WLs[32 * ks + 16 * (j >> 2) + 4 * fq + (j & 3)] = wl; }
                        if (j == 7) __builtin_amdgcn_sched_barrier(0); }
#pragma unroll
                for (int ks = 0; ks < 2; ++ks) {
                    fR[rt][ks] = mkfrag(pk4((f32x4){r[ks][0], r[ks][1], r[ks][2], r[ks][3]}), pk4((f32x4){r[ks][4], r[ks][5], r[ks][6], r[ks][7]}));
#pragma unroll
                    for (int hf = 0; hf < 2; ++hf) { const int o = (16 * rt + fr) * TS2 + 32 * ks + 16 * hf + 4 * fq;
                        *(LAS u32x2*)(tA + o) = pk4((f32x4){a[ks][4 * hf], a[ks][4 * hf + 1], a[ks][4 * hf + 2], a[ks][4 * hf + 3]});
                        *(LAS u32x2*)(tB + o) = pk4((f32x4){lw[ks][4 * hf], lw[ks][4 * hf + 1], lw[ks][4 * hf + 2], lw[ks][4 * hf + 3]});
                        *(LAS u32x2*)(tK + o) = pk4((f32x4){k[ks][4 * hf], k[ks][4 * hf + 1], k[ks][4 * hf + 2], k[ks][4 * hf + 3]}); } }
            }
        }
        WAVE_LDS_SYNC();
        bf16x8 Nn[2], Nt[2], Tm[2], Aak[2], Arb[2], Ark[2];
        {
            bf16x8 fA[2][2], fB[2][2], fK[2][2];
#pragma unroll
            for (int rt = 0; rt < 2; ++rt)
#pragma unroll
                for (int ks = 0; ks < 2; ++ks) { const int o = (16 * rt + fr) * TS2 + 32 * ks + 4 * fq;
                    fA[rt][ks] = mkfrag(*(const LAS u32x2*)(tA + o), *(const LAS u32x2*)(tA + o + 16)); fB[rt][ks] = mkfrag(*(const LAS u32x2*)(tB + o), *(const LAS u32x2*)(tB + o + 16));
                    fK[rt][ks] = mkfrag(*(const LAS u32x2*)(tK + o), *(const LAS u32x2*)(tK + o + 16)); }
#pragma unroll
            for (int tt = 0; tt < 2; ++tt) {
                f32x4 dab[2], dak[2], drb[2], drk[2];
#pragma unroll
                for (int st = 0; st < 2; ++st) { dab[st] = (f32x4){0.f, 0.f, 0.f, 0.f}; dak[st] = dab[st]; drb[st] = dab[st]; drk[st] = dab[st];
#pragma unroll
                    for (int ks = 0; ks < 2; ++ks) { dab[st] = mfma16(fB[st][ks], fA[tt][ks], dab[st]); dak[st] = mfma16(fK[st][ks], fA[tt][ks], dak[st]);
                        drb[st] = mfma16(fB[st][ks], fR[tt][ks], drb[st]); drk[st] = mfma16(fK[st][ks], fR[tt][ks], drk[st]); }
                    const int t = 16 * tt + fr;
#pragma unroll
                    for (int rg = 0; rg < 4; ++rg) { const int s = 16 * st + 4 * fq + rg;
                        dab[st][rg] = (s < t) ? dab[st][rg] : 0.f; dak[st][rg] = (s < t) ? dak[st][rg] : 0.f; drb[st][rg] = (s <= t) ? drb[st][rg] : 0.f; drk[st][rg] = (s <= t) ? drk[st][rg] : 0.f; } }
                Nn[tt] = mkfrag(pk4(dab[0]), pk4(dab[1])); Aak[tt] = mkfrag(pk4(dak[0]), pk4(dak[1])); Arb[tt] = mkfrag(pk4(drb[0]), pk4(drb[1])); Ark[tt] = mkfrag(pk4(drk[0]), pk4(drk[1]));
                const int t = 16 * tt + fr;
#pragma unroll
                for (int st = 0; st < 2; ++st)
#pragma unroll
                    for (int rg = 0; rg < 4; ++rg) dab[st][rg] += (16 * st + 4 * fq + rg == t) ? 1.f : 0.f;
                Tm[tt] = mkfrag(pk4(dab[0]), pk4(dab[1]));
            }
#pragma unroll
            for (int st = 0; st < 2; ++st) {
                f32x4 dt[2];
#pragma unroll
                for (int tt = 0; tt < 2; ++tt) { dt[tt] = (f32x4){0.f, 0.f, 0.f, 0.f};
#pragma unroll
                    for (int ks = 0; ks < 2; ++ks) dt[tt] = mfma16(fA[tt][ks], fB[st][ks], dt[tt]);
                    const int s = 16 * st + fr;
#pragma unroll
                    for (int rg = 0; rg < 4; ++rg) { const int t = 16 * tt + 4 * fq + rg; dt[tt][rg] = (s < t) ? dt[tt][rg] : 0.f; } }
                Nt[st] = mkfrag(pk4(dt[0]), pk4(dt[1]));
            }
        }
        bf16x8 VT[4];
#pragma unroll
        for (int it = 0; it < 4; ++it) VT[it] = tr_frag(tV, it, fr, fq);
        WAVE_LDS_SYNC();
#pragma unroll
        for (int rt = 0; rt < 2; ++rt)
#pragma unroll
            for (int ks = 0; ks < 2; ++ks) { const u32x4 w4 = __builtin_bit_cast(u32x4, fR[rt][ks]); u32x2 lo; lo.x = w4.x; lo.y = w4.y; u32x2 hi; hi.x = w4.z; hi.y = w4.w;
                const int o = (16 * rt + fr) * TS2 + 32 * ks + 4 * fq; *(LAS u32x2*)(tV + o) = lo; *(LAS u32x2*)(tV + o + 16) = hi; }
        {
            bf16x8 N2[2], N2t[2], T2[2];
            prod32(Nn, Nt, nullptr, N2); prod32(Nt, Nn, nullptr, N2t);
            prod32(Tm, N2t, Tm, T2); prod32(N2, N2t, nullptr, Nn); prod32(N2t, N2, nullptr, Nt);
            prod32(T2, Nt, T2, Tm); prod32(Nn, Nt, nullptr, N2); prod32(Nt, Nn, nullptr, N2t);
            prod32(Tm, N2t, Tm, T2); prod32(N2, N2t, nullptr, Nn); prod32(N2t, N2, nullptr, Nt);
            prod32(T2, Nt, T2, Tm);
        }
        bf16x8 U0T[4], AhT[4];
#pragma unroll
        for (int it = 0; it < 4; ++it) {
            f32x4 d0 = (f32x4){0.f, 0.f, 0.f, 0.f}, d1 = d0; d0 = mfma16(Aak[0], VT[it], d0); d1 = mfma16(Aak[1], VT[it], d1);
            const bf16x8 x1 = mkfrag(pk4(d0), pk4(d1));
            d0 = (f32x4){0.f, 0.f, 0.f, 0.f}; d1 = d0; d0 = mfma16(Tm[0], x1, d0); d1 = mfma16(Tm[1], x1, d1);
            U0T[it] = mkfrag(pk4(d0), pk4(d1)); }
#pragma unroll
        for (int jt = 0; jt < 4; ++jt) { const bf16x8 at = tr_frag(tA, jt, fr, fq);
            f32x4 d0 = (f32x4){0.f, 0.f, 0.f, 0.f}, d1 = d0; d0 = mfma16(Tm[0], at, d0); d1 = mfma16(Tm[1], at, d1);
            AhT[jt] = mkfrag(pk4(d0), pk4(d1)); }
        WAVE_LDS_SYNC();
        const size_t tile = (size_t)item * 4096;
#pragma unroll
        for (int tt = 0; tt < 2; ++tt) {
            const size_t base = (tok0 + 16 * tt + fr) * D + h * 64;
#pragma unroll
            for (int nt = 0; nt < 4; ++nt) {
                f32x4 d = (f32x4){0.f, 0.f, 0.f, 0.f}; d = mfma16(U0T[nt], Arb[tt], d); d = mfma16(VT[nt], Ark[tt], d);
                *(u32x2*)(Y0 + base + 16 * nt + 4 * fq) = pk4(d); }
#pragma unroll
            for (int nt = 0; nt < 4; ++nt) {
                f32x4 d = up4(*(const LAS u32x2*)(tV + (16 * tt + fr) * TS2 + 16 * nt + 4 * fq)); d = mfma16(AhT[nt], Arb[tt], d);
                *(u32x2*)(RH + base + 16 * nt + 4 * fq) = pk4(d); }
        }
        {
            bf16x8 BT[4];
#pragma unroll
            for (int jt = 0; jt < 4; ++jt) BT[jt] = tr_frag(tB, jt, fr, fq);
#pragma unroll
            for (int mt = 0; mt < 4; ++mt) {
                const float wl = WLs[16 * mt + fr];
#pragma unroll
                for (int nt = 0; nt < 4; ++nt) { f32x4 d = (f32x4){0.f, 0.f, 0.f, 0.f}; d = mfma16(AhT[nt], BT[mt], d);
#pragma unroll
                    for (int rg = 0; rg < 4; ++rg) d[rg] = (d[rg] + ((16 * nt + 4 * fq + rg == 16 * mt + fr) ? 1.f : 0.f)) * wl;
                    *(u32x2*)(PT + tile + (16 * mt + fr) * 64 + 16 * nt + 4 * fq) = pk4(d); } }
            bf16x8 KT[4];
#pragma unroll
            for (int jt = 0; jt < 4; ++jt) KT[jt] = tr_frag(tK, jt, fr, fq);
#pragma unroll
            for (int mt = 0; mt < 4; ++mt) {
#pragma unroll
                for (int nt = 0; nt < 4; ++nt) { f32x4 d = (f32x4){0.f, 0.f, 0.f, 0.f}; d = mfma16(BT[nt], U0T[mt], d); d = mfma16(KT[nt], VT[mt], d);
                    d = d * *(const LAS f32x4*)(WLs + 16 * nt + 4 * fq);
                    *(u32x2*)(QQ + tile + (16 * mt + fr) * 64 + 16 * nt + 4 * fq) = pk4(d); } }
        }
        WAVE_LDS_SYNC();
    }
}

constexpr int RING_NS = 8, RING_D = 6, SLOT_B = 16384;
__device__ __forceinline__ void scan_pass2(Frame& F) {
    const bf16_t* PT = WSP(bf16_t, WS_PT); const bf16_t* QQ = WSP(bf16_t, WS_QQ); bf16_t* SC = WSP(bf16_t, WS_SC);
    const int lane = F.lane, w = F.wave, fr = lane & 15, fq = lane >> 4;
#pragma unroll 1
    for (int bh = blockIdx.x; bh < 64; bh += F.G) {
        const char* ptg = (const char*)(PT + (size_t)bh * 4096); const char* qqg = (const char*)(QQ + (size_t)bh * 4096);
        const int lw4 = (w - 4) * 4;
        auto issue = [&](int step) {
            const int cs = step < NCH2 ? step : NCH2 - 1; LAS unsigned char* slot = F.lds + (step % RING_NS) * SLOT_B;
#pragma unroll
            for (int i = 0; i < 4; ++i) { const int G = (lw4 + i) * 64 + lane, g = G & 511, row = g >> 3, ch = (g & 7) ^ (row & 7);
                const char* srcp = (G < 512 ? ptg : qqg) + (size_t)cs * (64 * 8192) + row * 128 + ch * 16;
                __builtin_amdgcn_global_load_lds((const unsigned*)srcp, (LAS unsigned*)(slot + (lw4 + i) * 1024), 16, 0, 0); }
        };
        if (w >= 4) {
#pragma unroll
            for (int s = 0; s < RING_D; ++s) issue(s);
        }
        f32x4 acc[4];
#pragma unroll
        for (int m = 0; m < 4; ++m) acc[m] = (f32x4){0.f, 0.f, 0.f, 0.f};
        const int irow = 16 * w + fr;
#pragma unroll 1
        for (int c = 0; c < NCH2; ++c) {
            if (w >= 4) asm volatile("s_waitcnt vmcnt(20)" ::: "memory");
            __builtin_amdgcn_s_barrier();
            asm volatile("" ::: "memory");
            if (w < 4) {
                const LAS unsigned char* slot = F.lds + (c % RING_NS) * SLOT_B;
                u32x2 pa[4][2][2], qa[4];
#pragma unroll
                for (int m = 0; m < 4; ++m) { const int row = 16 * m + fr;
                    qa[m] = *(const LAS u32x2*)(slot + 8192 + irow * 128 + (((2 * m + (fq >> 1)) ^ (irow & 7)) * 16) + (fq & 1) * 8);
#pragma unroll
                    for (int ks = 0; ks < 2; ++ks)
#pragma unroll
                        for (int hf = 0; hf < 2; ++hf) pa[m][ks][hf] = *(const LAS u32x2*)(slot + row * 128 + (((4 * ks + 2 * hf + (fq >> 1)) ^ (row & 7)) * 16) + (fq & 1) * 8); }
                u32x2 sp[4];
#pragma unroll
                for (int m = 0; m < 4; ++m) sp[m] = pk4(acc[m]);
                bf16_t* sc = SC + (size_t)(c * 64 + bh) * 4096 + irow * 64;
#pragma unroll
                for (int m = 0; m < 4; ++m) *(u32x2*)(sc + 16 * m + 4 * fq) = sp[m];
                const bf16x8 bop0 = mkfrag(sp[0], sp[1]), bop1 = mkfrag(sp[2], sp[3]);
                asm volatile("s_waitcnt lgkmcnt(0)" ::: "memory");
#pragma unroll
                for (int m = 0; m < 4; ++m) { f32x4 a0 = up4(qa[m]);
                    a0 = mfma16(mkfrag(pa[m][0][0], pa[m][0][1]), bop0, a0); a0 = mfma16(mkfrag(pa[m][1][0], pa[m][1][1]), bop1, a0); acc[m] = a0; }
            } else {
                issue(c + RING_D);
            }
        }
        if (w >= 4) asm volatile("s_waitcnt vmcnt(0)" ::: "memory");
        __builtin_amdgcn_s_barrier();
    }
}

struct P3In { bf16x8 sa[4][2]; bf16x8 rb[2][2]; };
__device__ __forceinline__ void p3_load(P3In& I, const bf16_t* SC, const bf16_t* RH, int c, int bh, int fr, int fq) {
    const int b = bh >> 4, h = bh & 15; const size_t tok0 = (size_t)b * SEQ + (size_t)c * 32; const bf16_t* sc = SC + (size_t)(c * 64 + bh) * 4096;
#pragma unroll
    for (int nt = 0; nt < 4; ++nt)
#pragma unroll
        for (int ks = 0; ks < 2; ++ks) I.sa[nt][ks] = *(const bf16x8*)(sc + (16 * nt + fr) * 64 + 32 * ks + 8 * fq);
#pragma unroll
    for (int mt = 0; mt < 2; ++mt) { const size_t base = (tok0 + 16 * mt + fr) * D + h * 64;
#pragma unroll
        for (int ks = 0; ks < 2; ++ks) I.rb[mt][ks] = *(const bf16x8*)(RH + base + 32 * ks + 8 * fq); }
}
__device__ __forceinline__ void scan_pass3(Frame& F) {
    const bf16_t* SC = WSP(bf16_t, WS_SC); const bf16_t* RH = WSP(bf16_t, WS_RH); const bf16_t* Y0 = WSP(bf16_t, WS_Y0); const bf16_t* BV = WSP(bf16_t, WS_BV);
    const bf16_t* LIN = WSP(bf16_t, WS_LORAIN);
    bf16_t* YA = WSP(bf16_t, WS_YA);
    const int bh = blockIdx.x & 63, b = bh >> 4, h = bh & 15, cstep = 8 * (F.G >> 6);
    lbf16* shG = (lbf16*)(F.lds + SH_OFF); LAS float* shN = (LAS float*)(F.lds + SH_OFF + 64 * SH_G_STRIDE * 2);
    { const bf16_t* WTL = WSP(bf16_t, WS_WT_LORA);
      for (int i = F.tid; i < 64 * 20; i += 512) { const int n = i / 20, ch8 = i % 20;
          *(LAS u32x4*)(shG + n * SH_G_STRIDE + ch8 * 8) = *(const u32x4*)(WTL + (size_t)(2048 + h * 64 + n) * LK + 128 + ch8 * 8); }
      if (F.tid < 128) shN[F.tid] = (F.tid < 64 ? F.in(11) : F.in(12))[h * 64 + (F.tid & 63)]; }
    __syncthreads();
    P3In cur, nxt;
    const int c0 = 8 * (blockIdx.x >> 6) + F.wave;
    if (c0 < NCH2) p3_load(cur, SC, RH, c0, bh, F.lane & 15, F.lane >> 4);
#pragma unroll 1
    for (int c = c0; c < NCH2; c += cstep) {
        int lane_o = F.lane; asm volatile("" : "+v"(lane_o));
        const int lane = lane_o, fr = lane & 15, fq = lane >> 4;
        p3_load(nxt, SC, RH, (c + cstep < NCH2) ? c + cstep : c, bh, fr, fq);
        const size_t tok0 = (size_t)b * SEQ + (size_t)c * 32;
#pragma unroll
        for (int mt = 0; mt < 2; ++mt) {
            const size_t base = (tok0 + 16 * mt + fr) * D + h * 64, ybase = (tok0 + 16 * mt + fr) * 2048 + h * 64;
            bf16x8 lg[5]; u32x2 y0w[4], bvw[4];
#pragma unroll
            for (int kq = 0; kq < 5; ++kq) lg[kq] = *(const bf16x8*)(LIN + (tok0 + 16 * mt + fr) * LK + 128 + 32 * kq + 8 * fq);
#pragma unroll
            for (int nt = 0; nt < 4; ++nt) { y0w[nt] = *(const u32x2*)(Y0 + base + 16 * nt + 4 * fq); bvw[nt] = *(const u32x2*)(BV + base + 16 * nt + 4 * fq); }
            f32x4 gg[4];
#pragma unroll
            for (int nt = 0; nt < 4; ++nt) { f32x4 d = (f32x4){0.f, 0.f, 0.f, 0.f};
#pragma unroll
                for (int kq = 0; kq < 5; ++kq) d = mfma16(*(const LAS bf16x8*)(shG + (16 * nt + fr) * SH_G_STRIDE + 32 * kq + 8 * fq), lg[kq], d);
                gg[nt] = d; }
            f32x4 y[4];
#pragma unroll
            for (int nt = 0; nt < 4; ++nt) { y[nt] = up4(y0w[nt]);
#pragma unroll
                for (int ks = 0; ks < 2; ++ks) y[nt] = mfma16(cur.sa[nt][ks], cur.rb[mt][ks], y[nt]); }
            float s = 0.f;
#pragma unroll
            for (int nt = 0; nt < 4; ++nt) s += (y[nt][0] + y[nt][1]) + (y[nt][2] + y[nt][3]);
            s += __shfl_xor(s, 16); s += __shfl_xor(s, 32);
            const float mean = s * (1.f / 64.f); float q = 0.f;
#pragma unroll
            for (int nt = 0; nt < 4; ++nt) { y[nt] = y[nt] - mean; q += (y[nt][0] * y[nt][0] + y[nt][1] * y[nt][1]) + (y[nt][2] * y[nt][2] + y[nt][3] * y[nt][3]); }
            q += __shfl_xor(q, 16); q += __shfl_xor(q, 32);
            const float rstd = 1.0f / sqrtf(q * (1.f / 64.f) + GN_EPS);
#pragma unroll
            for (int nt = 0; nt < 4; ++nt) { const f32x4 bv = up4(bvw[nt]);
                const f32x4 gw4 = *(const LAS f32x4*)(shN + 16 * nt + 4 * fq), gb4 = *(const LAS f32x4*)(shN + 64 + 16 * nt + 4 * fq);
                const f32x4 o = (y[nt] * rstd * gw4 + gb4 + bv) * gg[nt];
                *(u32x2*)(YA + ybase + 16 * nt + 4 * fq) = pk4(o); }
            asm volatile("" ::: "memory");
        }
        cur = nxt;
    }
}

__device__ __forceinline__ void p8_ln1(Frame& F) {
    const float* HP = WSP(float, WS_H1PRE); float* H1 = WSP(float, WS_H1); bf16_t* HR = WSP(bf16_t, WS_HR);
    const float* lw = F.in(20); const float* lb = F.in(21);
    for (int t = F.gw; t < T; t += F.NGW) {
        const f32x4* xr = (const f32x4*)(HP + (size_t)t * D) + F.lane; f32x4 v[4]; float s = 0.f;
#pragma unroll
        for (int j = 0; j < 4; ++j) { v[j] = xr[64 * j]; s += (v[j][0] + v[j][1]) + (v[j][2] + v[j][3]); }
        const float mean = wave_sum(s) * (1.f / D); float q = 0.f;
#pragma unroll
        for (int j = 0; j < 4; ++j) { v[j] = v[j] - mean; q += (v[j][0] * v[j][0] + v[j][1] * v[j][1]) + (v[j][2] * v[j][2] + v[j][3] * v[j][3]); }
        const float rstd = 1.0f / sqrtf(wave_sum(q) * (1.f / D) + LN_EPS);
#pragma unroll
        for (int j = 0; j < 4; ++j) { const int col = 4 * F.lane + 256 * j; const f32x4 w = *(const f32x4*)(lw + col), bb = *(const f32x4*)(lb + col);
            const f32x4 o = v[j] * rstd * w + bb; *(f32x4*)(H1 + (size_t)t * D + col) = o;
            const unsigned h01 = cvt_pk_bf16(o[0], o[1]), h23 = cvt_pk_bf16(o[2], o[3]);
            const float l0 = o[0] - bf2f(h01 & 0xffffu), l1 = o[1] - bf2f(h01 >> 16), l2 = o[2] - bf2f(h23 & 0xffffu), l3 = o[3] - bf2f(h23 >> 16);
            u32x2 hi; hi.x = h01; hi.y = h23; u32x2 lo; lo.x = cvt_pk_bf16(l0, l1); lo.y = cvt_pk_bf16(l2, l3);
            bf16_t* hr = HR + (size_t)t * HRK + col; *(u32x2*)hr = hi; *(u32x2*)(hr + 1024) = lo; *(u32x2*)(hr + 2048) = hi; }
    }
}

__device__ __forceinline__ void p10_route(Frame& F) {
    const float* LG = WSP(float, WS_LOGITS); const float* rb = F.in(23);
    int* TE = WSP(int, WS_TOPE); float* TG = WSP(float, WS_TOPG); int* CNT = WSP(int, WS_CNT);
    LAS int* hist = (LAS int*)F.lds;
    if (F.tid < 256) hist[F.tid] = 0;
    __syncthreads();
    const int TPB = (T + F.G - 1) / F.G, tb = blockIdx.x * TPB, te = (tb + TPB < T) ? tb + TPB : T;
    const int lane = F.lane; const float NINF = -__builtin_inff();
    const f32x4 bias = *(const f32x4*)(rb + 4 * lane);
    for (int t = tb + F.wave; t < te; t += 8) {
        const f32x4 lg = *(const f32x4*)(LG + (size_t)t * NE + 4 * lane);
        float sc[4], chv[4];
#pragma unroll
        for (int j = 0; j < 4; ++j) { sc[j] = 1.0f / (1.0f + expf(-lg[j])); chv[j] = sc[j] + bias[j]; }
        float m1 = NINF, m2 = NINF;
#pragma unroll
        for (int j = 0; j < 4; ++j) { if (chv[j] > m1) { m2 = m1; m1 = chv[j]; } else if (chv[j] > m2) m2 = chv[j]; }
#pragma unroll
        for (int o = 1; o < 8; o <<= 1) { const float b1 = __shfl_xor(m1, o), b2 = __shfl_xor(m2, o); const float n1 = fmaxf(m1, b1), n2 = fmaxf(fminf(m1, b1), fmaxf(m2, b2)); m1 = n1; m2 = n2; }
        const float gs = m1 + m2; const int g = lane >> 3; int rank = 0;
#pragma unroll
        for (int gg = 0; gg < 8; ++gg) { const float o = __shfl(gs, gg * 8); rank += (o > gs || (o == gs && gg < g)) ? 1 : 0; }
        const bool sel = rank < 4;
#pragma unroll
        for (int j = 0; j < 4; ++j) chv[j] = sel ? chv[j] : NINF;
        int my_e = 0; float my_s = 0.f, ssum = 0.f;
#pragma unroll
        for (int k = 0; k < TOPK; ++k) {
            float bv = chv[0]; int bi = 4 * lane;
#pragma unroll
            for (int j = 1; j < 4; ++j) if (chv[j] > bv) { bv = chv[j]; bi = 4 * lane + j; }
#pragma unroll
            for (int o = 1; o < 64; o <<= 1) { const float ov = __shfl_xor(bv, o); const int oi = __shfl_xor(bi, o); if (ov > bv || (ov == bv && oi < bi)) { bv = ov; bi = oi; } }
            const int j = bi & 3; const float scs = j == 0 ? sc[0] : (j == 1 ? sc[1] : (j == 2 ? sc[2] : sc[3]));
            const float sk = __shfl(scs, bi >> 2);
            if (lane == (bi >> 2)) { if (j == 0) chv[0] = NINF; else if (j == 1) chv[1] = NINF; else if (j == 2) chv[2] = NINF; else chv[3] = NINF; }
            ssum += sk; if (lane == k) { my_e = bi; my_s = sk; }
        }
        if (lane < TOPK) { TE[(size_t)t * TOPK + lane] = my_e; TG[(size_t)t * TOPK + lane] = my_s / ssum * ROUTED_SCALE; __hip_atomic_fetch_add(&hist[my_e], 1, __ATOMIC_RELAXED, __HIP_MEMORY_SCOPE_WORKGROUP); }
    }
    __syncthreads();
    if (F.tid < 256) CNT[(size_t)blockIdx.x * NE + F.tid] = (int)__hip_atomic_fetch_add(F.ctl + CW_GTOT + F.tid, (unsigned)hist[F.tid], __ATOMIC_RELAXED, __HIP_MEMORY_SCOPE_AGENT);
}

__device__ __forceinline__ void p11_place(Frame& F) {
    const int* TE = WSP(int, WS_TOPE); const float* TG = WSP(float, WS_TOPG); const int* CNT = WSP(int, WS_CNT);
    int* SLOT = WSP(int, WS_SLOT); int* RT = WSP(int, WS_ROWTOK); float* RG = WSP(float, WS_ROWGATE);
    LAS int* tot = (LAS int*)F.lds; LAS int* mine = tot + 256; LAS int* start = tot + 512; LAS int* cursor = tot + 1024;
    const int b = blockIdx.x;
    if (F.tid < 256) { tot[F.tid] = (int)ld_u32_sc1(F.ctl + CW_GTOT + F.tid); mine[F.tid] = CNT[(size_t)b * NE + F.tid]; cursor[F.tid] = 0; }
    __syncthreads();
    if (F.tid == 0) { int s = 0; for (int e = 0; e < NE; ++e) { start[e] = s; s += (tot[e] + 255) & ~255; } start[NE] = s; start[NE + 1] = s + T; }
    __syncthreads();
    const int TPB = (T + F.G - 1) / F.G, tb = b * TPB, te = (tb + TPB < T) ? tb + TPB : T;
    for (int i = tb * TOPK + F.tid; i < te * TOPK; i += 512) { const int e = TE[i]; const int pos = __hip_atomic_fetch_add(&cursor[e], 1, __ATOMIC_RELAXED, __HIP_MEMORY_SCOPE_WORKGROUP); const int row = start[e] + mine[e] + pos;
        RT[row] = i / TOPK; RG[row] = TG[i]; SLOT[i] = row; }
    const int shb = start[NE];
    for (int t = tb + F.tid; t < te; t += 512) { RT[shb + t] = t; RG[shb + t] = 1.0f; }
    for (int e = b; e < NE; e += F.G) { for (int r = start[e] + tot[e] + F.tid; r < start[e + 1]; r += 512) { RT[r] = 0; RG[r] = 0.f; } }
    if (b == 0) {
        if (F.tid < 257) { for (int pm = start[F.tid] >> 8; pm < (start[F.tid + 1] >> 8); ++pm) F.ctl[CW_BLKE + pm] = (unsigned)F.tid; }
        if (F.tid == 0) { F.ctl[CW_NBLK] = (unsigned)(start[NE + 1] >> 8); F.ctl[CW_SHBASE] = (unsigned)shb; }
    }
}

__device__ __forceinline__ void p14_combine(Frame& F) {
    const float* H1 = WSP(float, WS_H1); const bf16_t* YR = WSP(bf16_t, WS_YR); const int* SLOT = WSP(int, WS_SLOT);
    const float* lw = F.in(28); const float* lb = F.in(29);
    const int shb = (int)__builtin_amdgcn_readfirstlane(ld_u32_sc1(F.ctl + CW_SHBASE));
    for (int t = F.gw; t < T; t += F.NGW) {
        f32x4 v[4];
#pragma unroll
        for (int j = 0; j < 4; ++j) v[j] = ALPHA * *(const f32x4*)(H1 + (size_t)t * D + 4 * F.lane + 256 * j);
#pragma unroll
        for (int k = 0; k <= TOPK; ++k) { const int row = k < TOPK ? SLOT[(size_t)t * TOPK + k] : shb + t; const bf16_t* yr = YR + (size_t)row * D + 4 * F.lane;
#pragma unroll
            for (int j = 0; j < 4; ++j) { const u32x2 w = *(const u32x2*)(yr + 256 * j); v[j][0] += bf2f(w.x & 0xffffu); v[j][1] += bf2f(w.x >> 16); v[j][2] += bf2f(w.y & 0xffffu); v[j][3] += bf2f(w.y >> 16); } }
        float s = 0.f;
#pragma unroll
        for (int j = 0; j < 4; ++j) s += (v[j][0] + v[j][1]) + (v[j][2] + v[j][3]);
        const float mean = wave_sum(s) * (1.f / D); float q = 0.f;
#pragma unroll
        for (int j = 0; j < 4; ++j) { v[j] = v[j] - mean; q += (v[j][0] * v[j][0] + v[j][1] * v[j][1]) + (v[j][2] * v[j][2] + v[j][3] * v[j][3]); }
        const float rstd = 1.0f / sqrtf(wave_sum(q) * (1.f / D) + LN_EPS);
#pragma unroll
        for (int j = 0; j < 4; ++j) { const int col = 4 * F.lane + 256 * j; const f32x4 w = *(const f32x4*)(lw + col), bb = *(const f32x4*)(lb + col);
            *(f32x4*)(F.out + (size_t)t * D + col) = v[j] * rstd * w + bb; }
    }
}

constexpr int N_PHASES = 17;
#ifndef SCAN_SEQ
#define SCAN_SEQ 0
#endif
__global__ void __launch_bounds__(512, 2) mk_fwd(Args args) {
    extern __shared__ __attribute__((aligned(16))) unsigned char lds_raw[];
    const int tid_ = threadIdx.x, wave_ = __builtin_amdgcn_readfirstlane(tid_ >> 6);
    Frame F{(LAS unsigned char*)lds_raw, tid_, tid_ & 63, wave_, (int)gridDim.x, (int)blockIdx.x * 8 + wave_, (int)gridDim.x * 8, (const __attribute__((address_space(4))) char*)__builtin_amdgcn_kernarg_segment_ptr(), args.out, args.ws, (unsigned*)(args.ws + WS_CTL)};
    volatile LAS unsigned* MISC = (volatile LAS unsigned*)(F.lds + MISC_OFF);
    for (int u = F.tid; u < (LDS_BYTES - RING_BYTES) / 4; u += 512) ((LAS unsigned*)(F.lds + RING_BYTES))[u] = 0u;
    __syncthreads();
    XcdBarrier bar; bar.bar = F.ctl + CW_BAR; bar.x = 0; bar.st = nullptr;
    if (!MK_SPLIT) bar = xcd_barrier_post(F.ctl + CW_BAR, MISC + 8);
    const int lo = args.ph_lo, hi = args.ph_hi;
#ifndef PH_MASK
#define PH_MASK 0x1ffff
#endif
#define IN(k) (((PH_MASK >> (k)) & 1) && lo <= (k) && (k) < hi)
#define SEAM(k) do { if (IN(k) && IN((k) + 1)) xcd_barrier(bar); } while (0)

#ifndef REP_MASK
#define REP_MASK 0
#endif
#define PH(k, ...) do { if (IN(k)) { { int t_ = F.wave * 64 + (int)__builtin_amdgcn_mbcnt_hi(~0u, __builtin_amdgcn_mbcnt_lo(~0u, 0u)); asm volatile("" : "+v"(t_)); F.tid = t_; F.lane = t_ & 63; auto k_ = (const __attribute__((address_space(4))) char*)__builtin_amdgcn_kernarg_segment_ptr(); asm volatile("" : "+s"(k_)); F.ka = k_; } __VA_ARGS__ if ((REP_MASK >> (k)) & 1) { xcd_barrier(bar); __VA_ARGS__ } } SEAM(k); } while (0)
    PH(0, { p0_prologue(F); });
    PH(1, { pg8::Gemm g{WSP(bf16_t, WS_XB), WSP(bf16_t, WS_WT_IN), D, D, D}; pg8::StaticOrder S; S.init(T, NP, F.G, (int)blockIdx.x);
        EpiP E{WSP(bf16_t, WS_P)}; pg8::gemm_phase(F.lds, g, S, E); });
    PH(2, { p2_lora_in(F); p2_gmlp(F); });
    PH(4, { scan_pass1(F); });
    PH(5, { scan_pass2(F); __syncthreads(); p0b_expert_weights(F); });
    PH(6, { scan_pass3(F); });
    PH(7, { pg8::Gemm g{WSP(bf16_t, WS_YA), WSP(bf16_t, WS_WT_OA), 2048, 2048, 2048}; pg8::StaticOrder S; S.init(T, D, F.G, (int)blockIdx.x);
        EpiGate E{WSP(bf16_t, WS_P), WSP(bf16_t, WS_MIXIN)}; pg8::gemm_phase(F.lds, g, S, E); });
    PH(9, { pg8::Gemm g{WSP(bf16_t, WS_MIXIN), WSP(bf16_t, WS_WT_OUT), D, D, D}; pg8::StaticOrder S; S.init(T, D, F.G, (int)blockIdx.x);
        EpiMix<2> E{nullptr, WSP(float, WS_H1PRE), nullptr, F.in(0), D}; pg8::gemm_phase(F.lds, g, S, E); });
    PH(10, { p8_ln1(F); });
    PH(11, { pg8::Gemm g{WSP(bf16_t, WS_HR), WSP(bf16_t, WS_WT_R), HRK, HRK, HRK}; pg8::StaticOrder S; S.init(T, NE, F.G, (int)blockIdx.x);
        EpiMix<3> E{nullptr, WSP(float, WS_LOGITS), nullptr, nullptr, NE}; pg8::gemm_phase(F.lds, g, S, E); });
    PH(12, { p10_route(F); });
    PH(13, { p11_place(F); });
    PH(14, { pg8::Gemm g{WSP(bf16_t, WS_HR), WSP(bf16_t, WS_WT_GU), D, HRK, D};
        pg8::GroupedOrder<true> S{F.ctl + CW_BLKE, WSP(int, WS_ROWTOK), (int)__builtin_amdgcn_readfirstlane(ld_u32_sc1(F.ctl + CW_NBLK)), 2, F.G, (int)blockIdx.x, (size_t)512 * 1024 * 2};
        EpiAct E{WSP(bf16_t, WS_ACT)}; pg8::gemm_phase(F.lds, g, S, E); });
    PH(15, { pg8::Gemm g{WSP(bf16_t, WS_ACT), WSP(bf16_t, WS_WT_DN), 256, 256, 256};
        pg8::GroupedOrder<false> S{F.ctl + CW_BLKE, WSP(int, WS_ROWTOK), (int)__builtin_amdgcn_readfirstlane(ld_u32_sc1(F.ctl + CW_NBLK)), 4, F.G, (int)blockIdx.x, (size_t)1024 * 256 * 2};
        EpiDown E{WSP(bf16_t, WS_YR), WSP(float, WS_ROWGATE)}; pg8::gemm_phase(F.lds, g, S, E); });
    PH(16, { p14_combine(F); });
#undef PH
#undef IN
#undef SEAM
}

extern "C" void kernel_launch(void* const* d_in, const int* in_sizes, int n_in, void* d_out, int out_size, void* d_ws, size_t ws_size, hipStream_t stream) {
    static int grid = 0;
    if (grid == 0) {
        if (n_in != 30 || out_size != T * D || ws_size < WS_END) { fprintf(stderr, "kernel_launch: unexpected shapes: n_in %d out %d ws %zu (need %zu)\n", n_in, out_size, ws_size, (size_t)WS_END); grid = -1; return; }
        int dev = 0, cus = 0, per_cu = 0;
        if (hipGetDevice(&dev) != hipSuccess || hipDeviceGetAttribute(&cus, hipDeviceAttributeMultiprocessorCount, dev) != hipSuccess) { grid = -1; return; }
        if (hipFuncSetAttribute((const void*)mk_fwd, hipFuncAttributeMaxDynamicSharedMemorySize, LDS_BYTES) != hipSuccess) { fprintf(stderr, "kernel_launch: hipFuncSetAttribute failed\n"); grid = -1; return; }
        if (hipOccupancyMaxActiveBlocksPerMultiprocessor(&per_cu, (const void*)mk_fwd, 512, LDS_BYTES) != hipSuccess || per_cu < 1) { fprintf(stderr, "kernel_launch: occupancy query says %d\n", per_cu); }
        (void)hipGetLastError();
        grid = cus;
        if (grid > 1024) grid = 1024;
    }
    if (grid < 0) return;
    (void)hipMemsetAsync((char*)d_ws + WS_CTL, 0, CTL_ZERO_BYTES, stream);
    Args a{};
    for (int i = 0; i < 30; ++i) a.in[i] = (const float*)d_in[i];
    a.out = (float*)d_out; a.ws = (unsigned char*)d_ws;
#if MK_SPLIT
    for (int p = 0; p < N_PHASES; ++p) { a.ph_lo = p; a.ph_hi = p + 1; hipLaunchKernelGGL(mk_fwd, dim3(grid), dim3(512), LDS_BYTES, stream, a); }
#else
    a.ph_lo = 0; a.ph_hi = N_PHASES; hipLaunchKernelGGL(mk_fwd, dim3(grid), dim3(512), LDS_BYTES, stream, a);
#endif
}
```
